# Optimizing an MI355X kernel written in HIP

```python
import math
import jax, jax.numpy as jnp
from jax import lax
import numpy as np

D_MODEL = 1024
BATCH = 16
SEQ = 2048
DEPTH = 2

EPS = 1e-6
POOL_WINDOWS = (2, 4, 8, 16)
POOL_GROUPS = 4
POOL_DH = D_MODEL // 8
POOL_WIDTH = POOL_GROUPS * POOL_DH
CONV_WIDTH = D_MODEL // 2
CONV_K = 3
AB_IN = POOL_WIDTH + 3 * CONV_WIDTH
AB_OUT = POOL_WIDTH + CONV_WIDTH
SGU_CHUNK = 128
SGU_GROUPS = 4
SGU_DH = D_MODEL // 8
SGU_WIDTH = SGU_GROUPS * SGU_DH
SB_HEADS = 8
SB_DH = 64
SB_WIDTH = SB_HEADS * SB_DH
SB_BLOCK = 128
CD_IN = 2 * SGU_WIDTH + 3 * SB_WIDTH
CD_OUT = SGU_WIDTH + SB_WIDTH
D_FF = 4 * D_MODEL
N_AB = (DEPTH + 1) // 2
N_CD = DEPTH // 2

kernel_name = 'hybrid_pool_conv_sgu_stickbreak_trunk'


def rmsnorm(x, g):
    xf = x.astype(jnp.float32)
    y = xf * lax.rsqrt(jnp.mean(xf * xf, axis=-1, keepdims=True) + EPS)
    return (y * g.astype(jnp.float32)).astype(x.dtype)


def layernorm(x, g, b):
    xf = x.astype(jnp.float32)
    mu = jnp.mean(xf, axis=-1, keepdims=True)
    xc = xf - mu
    y = xc * lax.rsqrt(jnp.mean(xc * xc, axis=-1, keepdims=True) + EPS)
    return (y * g.astype(jnp.float32) + b.astype(jnp.float32)).astype(x.dtype)


def pool_mixer(a, w, scale):
    T = a.shape[1]
    af = a.astype(jnp.float32)
    cs = jnp.pad(jnp.cumsum(af, axis=1), ((0, 0), (1, 0), (0, 0), (0, 0)))
    win = jnp.array(POOL_WINDOWS, dtype=jnp.int32)
    pos = jnp.arange(T, dtype=jnp.int32)
    start = jnp.maximum(pos[:, None] + 1 - win[None, :], 0)
    count = jnp.minimum(pos[:, None] + 1, win[None, :]).astype(jnp.float32)
    grp = jnp.arange(POOL_GROUPS, dtype=jnp.int32)
    window_sum = cs[:, 1:] - cs[:, start, grp[None, :], :]
    pooled = (window_sum / count[None, :, :, None] - af).astype(a.dtype)
    mixed = jnp.einsum('btgc,gcd->btgd', pooled, w)
    return mixed * scale


def short_conv(h, w, b):
    T = h.shape[1]
    hp = jnp.pad(h, ((0, 0), (CONV_K - 1, 0), (0, 0)))
    y = hp[:, 0:T] * w[0]
    for k in range(1, CONV_K):
        y = y + hp[:, k:k + T] * w[k]
    return y + b


def spatial_gating(u, v, g, beta, w_s, b_s):
    B, T, _ = v.shape
    v = layernorm(v, g, beta)
    vc = v.reshape(B, T // SGU_CHUNK, SGU_CHUNK, SGU_GROUPS, SGU_DH)
    causal = jnp.tril(jnp.ones((SGU_CHUNK, SGU_CHUNK), dtype=bool))
    w = jnp.where(causal[None], w_s, 0)
    s = jnp.einsum('gts,bnsgc->bntgc', w, vc) + b_s.T[:, :, None]
    return u * s.reshape(B, T, SGU_WIDTH)


def stick_breaking_attention(q, k, v):
    B, T, H, dh = q.shape
    q = q.transpose(0, 2, 1, 3)
    k = k.transpose(0, 2, 1, 3)
    v = v.transpose(0, 2, 1, 3)
    scale = 1.0 / math.sqrt(dh)
    outs = []
    for i in range(T // SB_BLOCK):
        q0 = i * SB_BLOCK
        kend = q0 + SB_BLOCK
        qb = q[:, :, q0:kend]
        kb = k[:, :, :kend]
        vb = v[:, :, :kend]
        z = jnp.einsum('bhqd,bhkd->bhqk', qb, kb,
                       preferred_element_type=jnp.float32) * scale
        qpos = q0 + jnp.arange(SB_BLOCK, dtype=jnp.int32)
        kpos = jnp.arange(kend, dtype=jnp.int32)
        mask = kpos[None, :] < qpos[:, None]
        log_keep = jnp.where(mask, jax.nn.log_sigmoid(-z), 0.0)
        suffix = lax.cumsum(log_keep, axis=3, reverse=True) - log_keep
        weights = jnp.where(mask, jnp.exp(jax.nn.log_sigmoid(z) + suffix), 0.0)
        outs.append(jnp.einsum('bhqk,bhkd->bhqd', weights.astype(vb.dtype), vb))
    o = jnp.concatenate(outs, axis=2)
    return o.transpose(0, 2, 1, 3).reshape(B, T, H * dh)


def setup_inputs(seed: int = 0) -> dict:
    key = jax.random.key(seed)
    ks = jax.random.split(key, 20)
    nrm = jax.random.normal
    f32 = jnp.float32
    res_scale = 1.0 / math.sqrt(2 * DEPTH)
    return {
        'x': nrm(ks[0], (BATCH, SEQ, D_MODEL), f32),
        'mix_norm_g': 1.0 + 0.01 * nrm(ks[1], (DEPTH, D_MODEL), f32),
        'mlp_norm_g': 1.0 + 0.01 * nrm(ks[2], (DEPTH, D_MODEL), f32),
        'ab_w_in': nrm(ks[3], (N_AB, D_MODEL, AB_IN), f32) * D_MODEL ** -0.5,
        'pool_w': nrm(ks[4], (N_AB, POOL_GROUPS, POOL_DH, POOL_DH), f32) * POOL_DH ** -0.5,
        'pool_scale': 1.0 + 0.02 * nrm(ks[5], (N_AB, POOL_GROUPS, POOL_DH), f32),
        'conv_w': nrm(ks[6], (N_AB, CONV_K, CONV_WIDTH), f32) * CONV_K ** -0.5,
        'conv_b': 0.01 * nrm(ks[7], (N_AB, CONV_WIDTH), f32),
        'ab_w_out': nrm(ks[8], (N_AB, AB_OUT, D_MODEL), f32) * AB_OUT ** -0.5 * res_scale,
        'cd_w_in': nrm(ks[9], (N_CD, D_MODEL, CD_IN), f32) * D_MODEL ** -0.5,
        'sgu_norm_g': 1.0 + 0.01 * nrm(ks[10], (N_CD, SGU_WIDTH), f32),
        'sgu_norm_b': 0.01 * nrm(ks[11], (N_CD, SGU_WIDTH), f32),
        'sgu_w': nrm(ks[12], (N_CD, SGU_GROUPS, SGU_CHUNK, SGU_CHUNK), f32) * SGU_CHUNK ** -0.5,
        'sgu_b': 1.0 + 0.01 * nrm(ks[13], (N_CD, SGU_GROUPS, SGU_CHUNK), f32),
        'cd_w_out': nrm(ks[14], (N_CD, CD_OUT, D_MODEL), f32) * CD_OUT ** -0.5 * res_scale,
        'mlp_w1': nrm(ks[15], (DEPTH, D_MODEL, D_FF), f32) * D_MODEL ** -0.5,
        'mlp_w2': nrm(ks[16], (DEPTH, D_FF, D_MODEL), f32) * D_FF ** -0.5 * res_scale,
        'final_norm_g': 1.0 + 0.01 * nrm(ks[17], (D_MODEL,), f32),
    }


def reference(x, mix_norm_g, mlp_norm_g, ab_w_in, pool_w, pool_scale, conv_w, conv_b,
              ab_w_out, cd_w_in, sgu_norm_g, sgu_norm_b, sgu_w, sgu_b, cd_w_out,
              mlp_w1, mlp_w2, final_norm_g):
    B, T, _ = x.shape
    h = x
    for layer in range(DEPTH):
        xn = rmsnorm(h, mix_norm_g[layer])
        if layer % 2 == 0:
            i = layer // 2
            p = xn @ ab_w_in[i]
            a, xb, gate_b, gate_c = jnp.split(
                p, [POOL_WIDTH, POOL_WIDTH + CONV_WIDTH, POOL_WIDTH + 2 * CONV_WIDTH], axis=-1)
            a_out = pool_mixer(a.reshape(B, T, POOL_GROUPS, POOL_DH),
                               pool_w[i], pool_scale[i]).reshape(B, T, POOL_WIDTH)
            b_out = gate_b * short_conv(gate_c * xb, conv_w[i], conv_b[i])
            mix = jnp.concatenate([a_out, b_out], axis=-1) @ ab_w_out[i]
        else:
            i = layer // 2
            p = xn @ cd_w_in[i]
            uv = jax.nn.gelu(p[..., :2 * SGU_WIDTH], approximate=False)
            u, v = jnp.split(uv, 2, axis=-1)
            c_out = spatial_gating(u, v, sgu_norm_g[i], sgu_norm_b[i], sgu_w[i], sgu_b[i])
            qkv = p[..., 2 * SGU_WIDTH:].reshape(B, T, 3, SB_HEADS, SB_DH)
            d_out = stick_breaking_attention(qkv[:, :, 0], qkv[:, :, 1], qkv[:, :, 2])
            mix = jnp.concatenate([c_out, d_out], axis=-1) @ cd_w_out[i]
        h = h + mix
        hn = rmsnorm(h, mlp_norm_g[layer])
        h = h + jnp.square(jax.nn.relu(hn @ mlp_w1[layer])) @ mlp_w2[layer]
    return rmsnorm(h, final_norm_g)
```

```cpp
#include <hip/hip_runtime.h>
#include <cstdio>
#include <cstdint>
namespace pg8 {
#define PG8_LAS __attribute__((address_space(3)))
typedef unsigned short bf16_t;
typedef short bf16x8 __attribute__((ext_vector_type(8)));
typedef float f32x4 __attribute__((ext_vector_type(4)));
typedef unsigned u32x4 __attribute__((ext_vector_type(4)));
constexpr int BM = 256, BK = 64, HALF = 128, HTB = HALF * BK * 2  , STAGE_BYTES = 8 * HTB, NXCD = 8, WGM = 8;

__host__ __device__ __forceinline__ int lds_byte(int r, int c) { const int st = (r >> 4) * 2 + (c >> 5), rr = r & 15, cc = c & 31, ob = rr * 64 + cc * 2; return st * 1024 + (ob ^ (((ob >> 9) & 1) << 5)); }
__host__ __device__ __forceinline__ void stage_rc(int b, int& R, int& C) { const int st = b / 1024, sb = b % 1024, swz = sb ^ (((sb >> 9) & 1) << 5); R = (st >> 1) * 16 + swz / 64; C = (st & 1) * 32 + (swz % 64) / 2; }
__host__ __device__ __forceinline__ int perm32(int rho) { const int n = rho >> 4, i = rho & 15; return 8 * (i >> 2) + 4 * n + (i & 3); }

struct Unit { int pm, pn; };
struct Gemm { const bf16_t* A; const bf16_t* Bt; int M, N, K; };

struct StaticOrder {
    int nM, nN, nwg, G, c;
    __host__ __device__ void init(int M, int N, int G_, int c_) { nM = M / BM; nN = N / BM; nwg = nM * nN; G = G_; c = c_; }
    __host__ __device__ bool next(int i, Unit& u) const {
        const long L = (long)i * G + c; if (L >= nwg) return false;
        int wgid = (int)L; { const int q = nwg / NXCD, r = nwg % NXCD, xcd = wgid % NXCD, off = wgid / NXCD; wgid = (xcd < r ? xcd * (q + 1) : r * (q + 1) + (xcd - r) * q) + off; }
        const int nig = WGM * nN, gid = wgid / nig, fm = gid * WGM, gsz = (nM - fm) < WGM ? (nM - fm) : WGM;
        u.pm = fm + ((wgid % nig) % gsz); u.pn = (wgid % nig) / gsz; return true;
    }
    __device__ __forceinline__ void a_ready(const Unit&) const {}
    __device__ __forceinline__ void done(const Unit&) const {}
};

__device__ __forceinline__ unsigned cvt_pk_bf16(float lo, float hi) { unsigned r; asm volatile("v_cvt_pk_bf16_f32 %0, %1, %2" : "=v"(r) : "v"(lo), "v"(hi)); return r; }
typedef float f32x2 __attribute__((ext_vector_type(2)));
__device__ __forceinline__ f32x2 gelu_pk(f32x2 v) {
    const f32x2 av = __builtin_elementwise_abs(v), d = av * 0.2316418882f + 1.0f;
    f32x2 t; t.x = __builtin_amdgcn_rcpf(d.x); t.y = __builtin_amdgcn_rcpf(d.y);
    f32x2 q = t * 0.5307027145f + (-0.7265760135f); q = q * t + 0.7107068705f; q = q * t + (-0.142248368f); q = q * t + 0.127414796f; q = q * t;
    const f32x2 s = (v * v) * (-0.72134752044f);
    f32x2 e; e.x = __builtin_amdgcn_exp2f(s.x); e.y = __builtin_amdgcn_exp2f(s.y);
    const f32x2 m = v * (q * e), r = v - m;
    f32x2 o; o.x = v.x < 0.f ? m.x : r.x; o.y = v.y < 0.f ? m.y : r.y; return o;
}
typedef unsigned u32x2 __attribute__((ext_vector_type(2)));
struct EpiStore {
    static constexpr bool PERM = true, AFTER_DRAIN = false;
    bf16_t* O; int ldc;
    __device__ __forceinline__ void operator()(const f32x4 (&acc)[2][2][4][2], const Unit& u, int wr, int wc, int fr, int fq) const {
        const int row0 = u.pm * BM + wr * 64 + fr, col0 = u.pn * BM + wc * 32 + 8 * fq;
#pragma unroll
        for (int ai = 0; ai < 2; ++ai)
#pragma unroll
            for (int m = 0; m < 4; ++m) { bf16_t* rowp = O + (size_t)(row0 + ai * HALF + m * 16) * ldc + col0;
#pragma unroll
                for (int bj = 0; bj < 2; ++bj) { const f32x4 v0 = acc[ai][bj][m][0], v1 = acc[ai][bj][m][1];
                    u32x4 w; w.x = cvt_pk_bf16(v0[0], v0[1]); w.y = cvt_pk_bf16(v0[2], v0[3]); w.z = cvt_pk_bf16(v1[0], v1[1]); w.w = cvt_pk_bf16(v1[2], v1[3]);
                    *(u32x4*)(rowp + bj * HALF) = w; } }
    }
};
template <bool WRITE_HB> struct EpiResid {
    static constexpr bool PERM = false, AFTER_DRAIN = false;
    const float* base; float* out; bf16_t* hb; float* ss;
    __device__ __forceinline__ void operator()(const f32x4 (&acc)[2][2][4][2], const Unit& u, int wr, int wc, int fr, int fq) const {
        const int row0 = u.pm * BM + wr * 64 + fr, col0 = u.pn * BM + wc * 32 + 4 * fq;
#pragma unroll
        for (int ai = 0; ai < 2; ++ai)
#pragma unroll
            for (int m = 0; m < 4; ++m) { const int row = row0 + ai * HALF + m * 16; const size_t off = (size_t)row * 1024 + col0;
                f32x4 b[2][2];
#pragma unroll
                for (int bj = 0; bj < 2; ++bj)
#pragma unroll
                    for (int n = 0; n < 2; ++n) b[bj][n] = *(const f32x4*)(base + off + bj * HALF + n * 16);
                float s = 0.f;
#pragma unroll
                for (int bj = 0; bj < 2; ++bj)
#pragma unroll
                    for (int n = 0; n < 2; ++n) { const f32x4 v = b[bj][n] + acc[ai][bj][m][n]; *(f32x4*)(out + off + bj * HALF + n * 16) = v;
                        if (WRITE_HB) { u32x2 w; w.x = cvt_pk_bf16(v[0], v[1]); w.y = cvt_pk_bf16(v[2], v[3]); *(u32x2*)(hb + off + bj * HALF + n * 16) = w;
                            s += (v[0] * v[0] + v[1] * v[1]) + (v[2] * v[2] + v[3] * v[3]); } }
                if (WRITE_HB) { s += __shfl_xor(s, 16); s += __shfl_xor(s, 32); if (fq == 0) ss[(size_t)row * 16 + u.pn * 4 + wc] = s; }
                asm volatile("" ::: "memory"); }
    }
};
__device__ __forceinline__ float row_rstd(const float* ss, int row, int fq) {
    const f32x4 p = *(const f32x4*)(ss + (size_t)row * 16 + 4 * fq); float s = (p[0] + p[1]) + (p[2] + p[3]);
    s += __shfl_xor(s, 16); s += __shfl_xor(s, 32);
    return 1.0f / sqrtf(s * (1.0f / 1024.0f) + 1e-6f);
}
struct EpiUp {
    static constexpr bool PERM = true, AFTER_DRAIN = false;
    bf16_t* O; const float* ss;
    __device__ __forceinline__ void operator()(const f32x4 (&acc)[2][2][4][2], const Unit& u, int wr, int wc, int fr, int fq) const {
        const int row0 = u.pm * BM + wr * 64 + fr, col0 = u.pn * BM + wc * 32 + 8 * fq;
#pragma unroll
        for (int ai = 0; ai < 2; ++ai)
#pragma unroll
            for (int m = 0; m < 4; ++m) { const int row = row0 + ai * HALF + m * 16; const float rs = row_rstd(ss, row, fq);
                bf16_t* rowp = O + (size_t)row * 4096 + col0;
#pragma unroll
                for (int bj = 0; bj < 2; ++bj) { f32x4 v0 = acc[ai][bj][m][0] * rs, v1 = acc[ai][bj][m][1] * rs;
#pragma unroll
                    for (int e = 0; e < 4; ++e) { const float a = fmaxf(v0[e], 0.f), b = fmaxf(v1[e], 0.f); v0[e] = a * a; v1[e] = b * b; }
                    u32x4 w; w.x = cvt_pk_bf16(v0[0], v0[1]); w.y = cvt_pk_bf16(v0[2], v0[3]); w.z = cvt_pk_bf16(v1[0], v1[1]); w.w = cvt_pk_bf16(v1[2], v1[3]);
                    *(u32x4*)(rowp + bj * HALF) = w; } }
    }
};
struct EpiCdIn {
    static constexpr bool PERM = true, AFTER_DRAIN = false;
    bf16_t* UV; bf16_t* QKV; const float* ss; float qscale;
    __device__ __forceinline__ void operator()(const f32x4 (&acc)[2][2][4][2], const Unit& u, int wr, int wc, int fr, int fq) const {
        const int row0 = u.pm * BM + wr * 64 + fr; const bool isuv = u.pn < 4;
        const int colt = isuv ? u.pn * BM : (u.pn - 4) * BM; const int ldc = isuv ? 1024 : 1536; bf16_t* base = isuv ? UV : QKV;
        const float sc = (!isuv && u.pn < 6) ? qscale : 1.0f;
        const int col0 = colt + wc * 32 + 8 * fq;
#pragma unroll
        for (int ai = 0; ai < 2; ++ai)
#pragma unroll
            for (int m = 0; m < 4; ++m) { const int row = row0 + ai * HALF + m * 16; const float rs = row_rstd(ss, row, fq) * sc;
                bf16_t* rowp = base + (size_t)row * ldc + col0;
#pragma unroll
                for (int bj = 0; bj < 2; ++bj) { f32x4 v0 = acc[ai][bj][m][0] * rs, v1 = acc[ai][bj][m][1] * rs;
                    if (isuv) { f32x2 a = gelu_pk((f32x2){v0[0], v0[1]}), b = gelu_pk((f32x2){v0[2], v0[3]}), c = gelu_pk((f32x2){v1[0], v1[1]}), d = gelu_pk((f32x2){v1[2], v1[3]});
                        v0 = (f32x4){a.x, a.y, b.x, b.y}; v1 = (f32x4){c.x, c.y, d.x, d.y}; }
                    u32x4 w; w.x = cvt_pk_bf16(v0[0], v0[1]); w.y = cvt_pk_bf16(v0[2], v0[3]); w.z = cvt_pk_bf16(v1[0], v1[1]); w.w = cvt_pk_bf16(v1[2], v1[3]);
                    *(u32x4*)(rowp + bj * HALF) = w; } }
    }
};
template <class Epi, class Sched, bool ALIGN_EPI = false, bool SP2 = false>
__device__ __forceinline__ void gemm_phase(PG8_LAS unsigned char* lds, const Gemm g, const Sched& S, const Epi& E) {
    const int tid = threadIdx.x, wid = __builtin_amdgcn_readfirstlane(tid >> 6), lane = tid & 63, wr = wid >> 2, wc = wid & 3, fr = lane & 15, fq = lane >> 4;
    const int K = g.K, nt = K / BK;
    unsigned voffA[2], voffB[2];
#pragma unroll
    for (int i = 0; i < 2; ++i) { int R, C; stage_rc(tid * 16 + i * 8192, R, C); const int Rb = Epi::PERM ? ((R & ~31) + perm32(R & 31)) : R;
        voffA[i] = (unsigned)(R * K + C) * 2u; voffB[i] = (unsigned)(Rb * K + C) * 2u; }
    const size_t kstep = (size_t)(BK * 2);
    const size_t hstep = (size_t)HALF * K * 2;
    const size_t tstep = 2 * hstep;
    const unsigned ldsw = (unsigned)wid * 1024u;
    const int aoff = lds_byte(wr * 64 + fr, fq * 8), boff = lds_byte(wc * 32 + fr, fq * 8);
#define PG8_SA(b, h) (((b) * 2 + (h)) * HTB)
#define PG8_SB(b, h) ((4 + (b) * 2 + (h)) * HTB)
#define PG8_STAGE(bufoff, gbase, voff) do { _Pragma("unroll") for (int _i = 0; _i < 2; ++_i) \
        __builtin_amdgcn_global_load_lds((const unsigned*)((const char*)(gbase) + (voff)[_i]), (PG8_LAS unsigned*)(lds + (bufoff) + ldsw + _i * 8192), 16, 0, 0); } while (0)
#define PG8_LDA(dst, b, h) do { _Pragma("unroll") for (int m = 0; m < 4; ++m) _Pragma("unroll") for (int k = 0; k < 2; ++k) dst[m][k] = *(const PG8_LAS bf16x8*)(lds + PG8_SA(b, h) + aoff + m * 2048 + k * 1024); } while (0)
#define PG8_LDB(dst, b, h) do { _Pragma("unroll") for (int n = 0; n < 2; ++n) _Pragma("unroll") for (int k = 0; k < 2; ++k) dst[n][k] = *(const PG8_LAS bf16x8*)(lds + PG8_SB(b, h) + boff + n * 2048 + k * 1024); } while (0)
#define PG8_MMA(ai, bj, At, Bt) do { __builtin_amdgcn_s_setprio(1); _Pragma("unroll") for (int m = 0; m < 4; ++m) _Pragma("unroll") for (int n = 0; n < 2; ++n) _Pragma("unroll") for (int k = 0; k < 2; ++k) \
        acc[ai][bj][m][n] = __builtin_amdgcn_mfma_f32_16x16x32_bf16(Bt[n][k], At[m][k], acc[ai][bj][m][n], 0, 0, 0); __builtin_amdgcn_s_setprio(0); } while (0)
#define PG8_WAIT_V(n) asm volatile("s_waitcnt vmcnt(" #n ")" ::: "memory")
#define PG8_WAIT_L(n) asm volatile("s_waitcnt lgkmcnt(" #n ")" ::: "memory")
#define PG8_BAR __builtin_amdgcn_s_barrier()
#define PG8_SCHED __builtin_amdgcn_sched_barrier(0)
    Unit cur, nxt; int ui = 0;
    if (!S.next(0, cur)) return;
    f32x4 acc[2][2][4][2];
#pragma unroll
    for (int a = 0; a < 2; ++a)
#pragma unroll
        for (int b = 0; b < 2; ++b)
#pragma unroll
            for (int m = 0; m < 4; ++m)
#pragma unroll
                for (int n = 0; n < 2; ++n) acc[a][b][m][n] = (f32x4){0.f, 0.f, 0.f, 0.f};
    bf16x8 At[4][2], B0[2][2], B1[2][2];
    const char* cA = (const char*)g.A + (size_t)cur.pm * tstep; const char* cB = (const char*)g.Bt + (size_t)cur.pn * tstep;
    S.a_ready(cur);
    if constexpr (SP2) {
        PG8_STAGE(PG8_SB(0, 0), cB, voffB); PG8_STAGE(PG8_SB(0, 1), cB + hstep, voffB); PG8_STAGE(PG8_SA(0, 0), cA, voffA); PG8_STAGE(PG8_SA(0, 1), cA + hstep, voffA);
        if (wr == 1) PG8_BAR;
        PG8_WAIT_V(2); PG8_BAR;
        PG8_STAGE(PG8_SB(1, 0), cB + kstep, voffB); PG8_STAGE(PG8_SA(1, 0), cA + kstep, voffA); PG8_STAGE(PG8_SB(1, 1), cB + hstep + kstep, voffB);
        PG8_WAIT_V(6); PG8_BAR;
    } else {
        PG8_STAGE(PG8_SB(0, 0), cB, voffB); PG8_STAGE(PG8_SA(0, 0), cA, voffA); PG8_STAGE(PG8_SB(0, 1), cB + hstep, voffB); PG8_STAGE(PG8_SA(0, 1), cA + hstep, voffA);
        if (wr == 1) PG8_BAR;
        PG8_WAIT_V(4); PG8_BAR;
        PG8_STAGE(PG8_SB(1, 0), cB + kstep, voffB); PG8_STAGE(PG8_SA(1, 0), cA + kstep, voffA); PG8_STAGE(PG8_SB(1, 1), cB + hstep + kstep, voffB);
        PG8_WAIT_V(6); PG8_BAR;
    }
    for (;;) {
        const bool has_next = S.next(ui + 1, nxt);
        const char* nA = has_next ? (const char*)g.A + (size_t)nxt.pm * tstep : cA; const char* nB = has_next ? (const char*)g.Bt + (size_t)nxt.pn * tstep : cB;
        for (int t = 0; t < nt; t += 2) {
            const bool last = (t == nt - 2);
            const char* a1 = cA + (size_t)(t + 1) * kstep;
            const char* a2 = last ? nA : cA + (size_t)(t + 2) * kstep; const char* b2 = last ? nB : cB + (size_t)(t + 2) * kstep;
            const char* a3 = a2 + kstep; const char* b3 = b2 + kstep;
            if (last && has_next) S.a_ready(nxt);
            if constexpr (SP2) {
            PG8_LDB(B0, 0, 0); PG8_LDB(B1, 0, 1); PG8_SCHED; PG8_LDA(At, 0, 0); PG8_STAGE(PG8_SA(1, 1), a1 + hstep, voffA);
            PG8_WAIT_V(8); PG8_WAIT_L(0); PG8_BAR; PG8_MMA(0, 0, At, B0); PG8_MMA(0, 1, At, B1); PG8_BAR; PG8_SCHED;
            PG8_LDA(At, 0, 1); PG8_STAGE(PG8_SB(0, 0), b2, voffB); PG8_STAGE(PG8_SB(0, 1), b2 + hstep, voffB); PG8_STAGE(PG8_SA(0, 0), a2, voffA);
            PG8_WAIT_V(8); PG8_WAIT_L(0); PG8_BAR; PG8_MMA(1, 0, At, B0); PG8_MMA(1, 1, At, B1); PG8_BAR; PG8_SCHED;
            PG8_LDB(B0, 1, 0); PG8_LDB(B1, 1, 1); PG8_SCHED; PG8_LDA(At, 1, 0); PG8_STAGE(PG8_SA(0, 1), a2 + hstep, voffA);
            PG8_WAIT_V(8); PG8_WAIT_L(0); PG8_BAR; PG8_MMA(0, 0, At, B0); PG8_MMA(0, 1, At, B1); PG8_BAR; PG8_SCHED;
            PG8_LDA(At, 1, 1); PG8_STAGE(PG8_SB(1, 0), b3, voffB); PG8_STAGE(PG8_SB(1, 1), b3 + hstep, voffB); PG8_STAGE(PG8_SA(1, 0), a3, voffA);
            PG8_WAIT_V(8); PG8_WAIT_L(0); PG8_BAR; PG8_MMA(1, 0, At, B0); PG8_MMA(1, 1, At, B1); PG8_BAR; PG8_SCHED;
            } else {
            PG8_LDB(B0, 0, 0); PG8_SCHED; PG8_LDA(At, 0, 0); PG8_STAGE(PG8_SA(1, 1), a1 + hstep, voffA);
            PG8_WAIT_L(8); PG8_BAR; PG8_WAIT_L(0); PG8_MMA(0, 0, At, B0); PG8_BAR; PG8_SCHED;
            PG8_LDB(B1, 0, 1); PG8_STAGE(PG8_SB(0, 0), b2, voffB);
            PG8_BAR; PG8_WAIT_L(0); PG8_MMA(0, 1, At, B1); PG8_BAR;
            PG8_LDA(At, 0, 1); PG8_STAGE(PG8_SA(0, 0), a2, voffA);
            PG8_BAR; PG8_WAIT_L(0); PG8_MMA(1, 0, At, B0); PG8_BAR; PG8_SCHED;
            PG8_STAGE(PG8_SB(0, 1), b2 + hstep, voffB);
            PG8_WAIT_V(6); PG8_BAR; PG8_MMA(1, 1, At, B1); PG8_BAR;
            PG8_LDB(B0, 1, 0); PG8_SCHED; PG8_LDA(At, 1, 0); PG8_STAGE(PG8_SA(0, 1), a2 + hstep, voffA);
            PG8_WAIT_L(8); PG8_BAR; PG8_WAIT_L(0); PG8_MMA(0, 0, At, B0); PG8_BAR; PG8_SCHED;
            PG8_LDB(B1, 1, 1); PG8_STAGE(PG8_SB(1, 0), b3, voffB);
            PG8_BAR; PG8_WAIT_L(0); PG8_MMA(0, 1, At, B1); PG8_BAR;
            PG8_LDA(At, 1, 1); PG8_STAGE(PG8_SA(1, 0), a3, voffA);
            PG8_BAR; PG8_WAIT_L(0); PG8_MMA(1, 0, At, B0); PG8_BAR; PG8_SCHED;
            PG8_STAGE(PG8_SB(1, 1), b3 + hstep, voffB);
            PG8_WAIT_V(6); PG8_BAR; PG8_MMA(1, 1, At, B1); PG8_BAR;
            }
        }
        if constexpr (ALIGN_EPI) { if (wr == 0) PG8_BAR; }
        if constexpr (!Epi::AFTER_DRAIN) { E(acc, cur, wr, wc, fr, fq); S.done(cur); }
        if (!has_next) break;
#pragma unroll
        for (int a = 0; a < 2; ++a)
#pragma unroll
            for (int b = 0; b < 2; ++b)
#pragma unroll
                for (int m = 0; m < 4; ++m)
#pragma unroll
                    for (int n = 0; n < 2; ++n) acc[a][b][m][n] = (f32x4){0.f, 0.f, 0.f, 0.f};
        cur = nxt; cA = nA; cB = nB; ++ui;
        if constexpr (ALIGN_EPI) { if (wr == 1) PG8_BAR; }
    }
    PG8_WAIT_V(0);
    if constexpr (!ALIGN_EPI) { if (wr == 0) PG8_BAR; }
    PG8_BAR;
    if constexpr (Epi::AFTER_DRAIN) { E.fused(acc, cur, wr, wc, fr, fq, lds, wid, lane); S.done(cur); }
#undef PG8_SA
#undef PG8_SB
#undef PG8_STAGE
#undef PG8_LDA
#undef PG8_LDB
#undef PG8_MMA
#undef PG8_WAIT_V
#undef PG8_WAIT_L
#undef PG8_BAR
#undef PG8_SCHED
}
}
constexpr int NWAVES = 8;
#ifndef MK_N_LAUNCHES
#define MK_N_LAUNCHES 12
#endif
constexpr int N_PHASES = 12;
constexpr int N_LAUNCHES = MK_N_LAUNCHES;
constexpr int BATCH = 16, SEQ = 2048, DM = 1024, M = BATCH * SEQ, FF = 4096, AB_IN = 2048, CD_IN = 2560;
constexpr float EPS = 1e-6f;
constexpr float QSCALE = 0.125f * 1.4426950408889634f;
constexpr size_t MiB = 1u << 20;
constexpr size_t WS_CTL = 0, CTL_ZERO_BYTES = 1 * MiB;
constexpr size_t WS_WABIN = 2 * MiB, WS_WABOUT = 6 * MiB, WS_W1 = 8 * MiB  , WS_W2 = 24 * MiB  , WS_WCDIN = 40 * MiB, WS_WCDOUT = 46 * MiB, WS_WSGU = 48 * MiB;
constexpr size_t WS_TMPF = 50 * MiB;
constexpr size_t WS_SS = 52 * MiB;
constexpr size_t WS_XN = 56 * MiB;
constexpr size_t WS_MIX = 120 * MiB;
constexpr size_t WS_BIG = 184 * MiB;
constexpr size_t WS_QKV = WS_BIG + 64 * MiB;
constexpr size_t WS_END = 440 * MiB;
constexpr int CW_BAR = 4096;
constexpr int RING_OFF = 0, RING_BYTES = 131072;
constexpr int LDSCTL_OFF = RING_BYTES, MISC_OFF = LDSCTL_OFF + 320;
constexpr int LDS_BYTES = 147456;
#define GAS __attribute__((address_space(1)))
#define LAS __attribute__((address_space(3)))
typedef unsigned short bf16;
typedef unsigned v4u __attribute__((ext_vector_type(4)));
typedef float f32x4 __attribute__((ext_vector_type(4)));
typedef short bf16x8 __attribute__((ext_vector_type(8)));
typedef GAS unsigned gu32;
typedef GAS unsigned long long gu64;
#define RLX_AGENT __ATOMIC_RELAXED, __HIP_MEMORY_SCOPE_AGENT
#define LDS_WAIT() asm volatile("s_waitcnt lgkmcnt(0)" ::: "memory")
#define VM_WAIT() asm volatile("s_waitcnt vmcnt(0)" ::: "memory")
__device__ __forceinline__ unsigned long long rt() { return __builtin_amdgcn_s_memrealtime(); }
__device__ __forceinline__ unsigned f2bf(float f) { unsigned u = __builtin_bit_cast(unsigned, f); return (u + 0x7fffu + ((u >> 16) & 1u)) >> 16; }
__device__ __forceinline__ unsigned pk2(float lo, float hi) { return f2bf(lo) | (f2bf(hi) << 16); }
#define XB_TMO      128
#define XB_XCNT(j)  (256  + 64 * (j))
#define XB_XSUB(j)  (1280 + 64 * (j))
#define XB_XGEN(j)  (2304 + 64 * (j))
#define XB_TOP      3328
#define XB_TOPGEN   3392
#define XCD_BAR_WORDS 3456
#define XB_SPIN_CAP (1u << 18)

__device__ __forceinline__ unsigned xb_ld(unsigned* p)              { return __hip_atomic_load(p, __ATOMIC_RELAXED, __HIP_MEMORY_SCOPE_AGENT); }
__device__ __forceinline__ unsigned xb_add(unsigned* p, unsigned v) { return __hip_atomic_fetch_add(p, v, __ATOMIC_RELAXED, __HIP_MEMORY_SCOPE_AGENT); }
__device__ __forceinline__ unsigned xb_xcc_id() { return (unsigned)__builtin_amdgcn_s_getreg((3 << 11) | 20) & 0xFu; }
#define XB_SPIN(cond, bar) do { unsigned _sp = 0; while (cond) { __builtin_amdgcn_s_sleep(1); \
    if ((++_sp & 255u) == 0u) { if (xb_ld(&(bar)[XB_TMO])) break; if (_sp > XB_SPIN_CAP) { atomicAdd(&(bar)[XB_TMO], 1u); break; } } } } while (0)

struct XcdBarrier {
    unsigned* bar; unsigned x;
    volatile LAS unsigned* st;
};

__device__ __forceinline__ XcdBarrier xcd_barrier_post(unsigned* bar, volatile LAS unsigned* st) {
    XcdBarrier b; b.bar = bar; b.x = xb_xcc_id(); b.st = st;
    if (threadIdx.x == 0) (void)xb_add(&bar[XB_XCNT(b.x)], 1u);
    return b;
}
__device__ __forceinline__ void xcd_barrier_complete(unsigned* bar, unsigned x, unsigned& nloc, unsigned& nx) {
    const unsigned G = gridDim.x * gridDim.y * gridDim.z;
    unsigned sum, cnt, mine, sp = 0u;
    for (;;) {
        sum = 0u; cnt = 0u; mine = 0u;
#pragma unroll
        for (unsigned j = 0; j < 16; ++j) { const unsigned c = xb_ld(&bar[XB_XCNT(j)]); sum += c; cnt += (c > 0u) ? 1u : 0u; mine = (j == x) ? c : mine; }
        if (sum == G) break;
        __builtin_amdgcn_s_sleep(1);
        if ((++sp & 255u) == 0u) { if (xb_ld(&bar[XB_TMO])) break; if (sp > XB_SPIN_CAP) { atomicAdd(&bar[XB_TMO], 1u); break; } }
    }
    nloc = mine > 0u ? mine : 1u; nx = cnt > 0u ? cnt : 1u;
}

__device__ __forceinline__ void xcd_barrier(const XcdBarrier& b) {
    asm volatile("s_waitcnt vmcnt(0)" ::: "memory");
    __syncthreads();
    if (threadIdx.x == 0) {
        unsigned* bar = b.bar;
        __builtin_amdgcn_s_waitcnt(0);
        unsigned nloc = b.st[0], nx = b.st[1];
        if (nloc == 0u) { xcd_barrier_complete(bar, b.x, nloc, nx); b.st[0] = nloc; b.st[1] = nx; }
        const unsigned old = xb_add(&bar[XB_XSUB(b.x)], 1u);
        const unsigned gen = old / nloc;
        if (old + 1u == (gen + 1u) * nloc) {
            __builtin_amdgcn_fence(__ATOMIC_RELEASE, "agent");
            asm volatile("s_waitcnt vmcnt(0)" ::: "memory");
            const unsigned og = xb_add(&bar[XB_TOP], 1u);
            const unsigned tg = og / nx;
            if (og + 1u == (tg + 1u) * nx) xb_add(&bar[XB_TOPGEN], 1u);
            else XB_SPIN(xb_ld(&bar[XB_TOPGEN]) == tg, bar);
            __builtin_amdgcn_fence(__ATOMIC_ACQUIRE, "agent");
            xb_add(&bar[XB_XGEN(b.x)], 1u);
            asm volatile("s_waitcnt vmcnt(0)" ::: "memory");
        } else {
            XB_SPIN(xb_ld(&bar[XB_XGEN(b.x)]) == gen, bar);
            __builtin_amdgcn_fence(__ATOMIC_ACQUIRE, "agent");
            asm volatile("s_waitcnt vmcnt(0)" ::: "memory");
        }
    }
    __syncthreads();
}
struct Frame {
    LAS unsigned char* lds;
    volatile LAS unsigned* MISC;
    gu32* ctl;
    int tid, lane, wave;
    int vcu, G;
    const float* in[18]; float* out; unsigned char* ws;
};
__device__ __forceinline__ float bf2f(unsigned short b) { return __builtin_bit_cast(float, (unsigned)b << 16); }
__device__ __forceinline__ float wave_sum(float v) {
#pragma unroll
    for (int o = 1; o < 64; o <<= 1) v += __shfl_xor(v, o);
    return v;
}
__device__ __forceinline__ void unpack8(const v4u r, float* f) {
    f[0] = __builtin_bit_cast(float, r.x << 16); f[1] = __builtin_bit_cast(float, r.x & 0xffff0000u);
    f[2] = __builtin_bit_cast(float, r.y << 16); f[3] = __builtin_bit_cast(float, r.y & 0xffff0000u);
    f[4] = __builtin_bit_cast(float, r.z << 16); f[5] = __builtin_bit_cast(float, r.z & 0xffff0000u);
    f[6] = __builtin_bit_cast(float, r.w << 16); f[7] = __builtin_bit_cast(float, r.w & 0xffff0000u);
}
__device__ __forceinline__ v4u pack8(const float* f) { v4u o; o.x = pk2(f[0], f[1]); o.y = pk2(f[2], f[3]); o.z = pk2(f[4], f[5]); o.w = pk2(f[6], f[7]); return o; }

__device__ __forceinline__ void transpose_item(const float* W, const float* gk, int K, int N, bf16* WT, LAS float* scr, int item, int lane) {
    const int nblk = N / 32, kb = item / nblk, nb = item % nblk, k0 = 64 * kb, n0 = 32 * nb;
#pragma unroll 8
    for (int i = 0; i < 32; ++i) { const int kk = 2 * i + (lane >> 5); const float g = gk ? gk[k0 + kk] : 1.0f; scr[kk * 33 + (lane & 31)] = W[(size_t)(k0 + kk) * N + n0 + (lane & 31)] * g; }
    LDS_WAIT(); asm volatile("" ::: "memory");
    const int c = lane & 7;
#pragma unroll
    for (int j = 0; j < 4; ++j) { const int n = (lane >> 3) + 8 * j; const LAS float* s = scr + (8 * c) * 33 + n;
        v4u o; o.x = pk2(s[0 * 33], s[1 * 33]); o.y = pk2(s[2 * 33], s[3 * 33]); o.z = pk2(s[4 * 33], s[5 * 33]); o.w = pk2(s[6 * 33], s[7 * 33]);
        *(GAS v4u*)(WT + (size_t)(n0 + n) * K + k0 + 8 * c) = o; }
    LDS_WAIT(); asm volatile("" ::: "memory");
}

__device__ __forceinline__ void p0_prologue(Frame& F) {
    LAS float* scr = (LAS float*)(F.lds + RING_OFF + F.wave * 16384);
    const int gw = F.vcu * NWAVES + F.wave, NGW = F.G * NWAVES;
    const float* mixg = F.in[1]; const float* mlpg = F.in[2];
    constexpr int I_ABIN = (DM / 64) * (AB_IN / 32), I_W1 = (DM / 64) * (FF / 32), I_W2 = (FF / 64) * (DM / 32), I_CDIN = (DM / 64) * (CD_IN / 32), I_CDOUT = (DM / 64) * (DM / 32);
    constexpr int NITEMS = I_ABIN + 2 * I_W1 + 2 * I_W2 + I_CDIN + I_CDOUT;
    for (int it = gw; it < NITEMS; it += NGW) {
        int r = it;
        if (r < I_ABIN) { transpose_item(F.in[3], nullptr, DM, AB_IN, (bf16*)(F.ws + WS_WABIN), scr, r, F.lane); continue; } r -= I_ABIN;
        if (r < I_W1) { transpose_item(F.in[15], mlpg, DM, FF, (bf16*)(F.ws + WS_W1), scr, r, F.lane); continue; } r -= I_W1;
        if (r < I_W1) { transpose_item(F.in[15] + (size_t)DM * FF, mlpg + DM, DM, FF, (bf16*)(F.ws + WS_W1 + 8 * MiB), scr, r, F.lane); continue; } r -= I_W1;
        if (r < I_W2) { transpose_item(F.in[16], nullptr, FF, DM, (bf16*)(F.ws + WS_W2), scr, r, F.lane); continue; } r -= I_W2;
        if (r < I_W2) { transpose_item(F.in[16] + (size_t)FF * DM, nullptr, FF, DM, (bf16*)(F.ws + WS_W2 + 8 * MiB), scr, r, F.lane); continue; } r -= I_W2;
        if (r < I_CDIN) { transpose_item(F.in[9], mixg + DM, DM, CD_IN, (bf16*)(F.ws + WS_WCDIN), scr, r, F.lane); continue; } r -= I_CDIN;
        transpose_item(F.in[14], nullptr, DM, DM, (bf16*)(F.ws + WS_WCDOUT), scr, r, F.lane);
    }
    { const float* pw = F.in[4]; const float* psc = F.in[5]; const float* wo = F.in[8]; float* tmp = (float*)(F.ws + WS_TMPF);
      for (int it = gw; it < 512 * 16; it += NGW) { const int k = it >> 4, n = (it & 15) * 64 + F.lane, g = k >> 7;
          const float* pwr = pw + (size_t)k * 128; const float* scr_ = psc + g * 128; const float* wor = wo + (size_t)(g * 128) * DM + n; float a = 0.f;
#pragma unroll 8
          for (int d = 0; d < 128; ++d) a += (pwr[d] * scr_[d]) * wor[(size_t)d * DM];
          tmp[(size_t)k * DM + n] = a; } }
    { const float* x = F.in[0]; bf16* xn = (bf16*)(F.ws + WS_XN);
      for (int m = gw; m < M; m += NGW) { const GAS f32x4* xr = (const GAS f32x4*)(x + (size_t)m * DM) + F.lane; const GAS f32x4* gr = (const GAS f32x4*)mixg + F.lane;
          f32x4 v[4]; float s = 0.f;
#pragma unroll
          for (int j = 0; j < 4; ++j) { v[j] = xr[64 * j]; s += (v[j].x * v[j].x + v[j].y * v[j].y) + (v[j].z * v[j].z + v[j].w * v[j].w); }
          const float rstd = 1.0f / sqrtf(wave_sum(s) * (1.f / DM) + EPS);
          GAS unsigned long long* o8 = (GAS unsigned long long*)(xn + (size_t)m * DM) + F.lane;
#pragma unroll
          for (int j = 0; j < 4; ++j) { const f32x4 g = gr[64 * j]; o8[64 * j] = (unsigned long long)pk2(v[j].x * rstd * g.x, v[j].y * rstd * g.y) | ((unsigned long long)pk2(v[j].z * rstd * g.z, v[j].w * rstd * g.w) << 32); } } }
}

__device__ __forceinline__ void p2_mixer_ab(Frame& F) {
    { LAS float* scr = (LAS float*)(F.lds + RING_OFF + F.wave * 16384); const int gw = F.vcu * NWAVES + F.wave, NGW = F.G * NWAVES;
      bf16* wt = (bf16*)(F.ws + WS_WABOUT);
      for (int it = gw; it < (DM / 64) * (DM / 32); it += NGW) {
          const int kb = it / (DM / 32);
          transpose_item(kb < 8 ? (const float*)(F.ws + WS_TMPF) : F.in[8], nullptr, DM, DM, wt, scr, it, F.lane); } }
    const bf16* P = (const bf16*)(F.ws + WS_BIG); bf16* MX = (bf16*)(F.ws + WS_MIX);
    const float* cw = F.in[6]; const float* cb = F.in[7];
    const int tl = F.tid >> 7, ch = F.tid & 127;
    for (int u = F.vcu; u < BATCH * 32; u += F.G) {
        const int b = u >> 5, seg = u & 31, t0 = seg * 64 + tl * 16; const size_t rb = (size_t)b * SEQ;
        if (ch < 64) {
            const int c0 = ch * 8, g = ch >> 4, w = 2 << g; float sum[8], a[8];
#pragma unroll
            for (int e = 0; e < 8; ++e) sum[e] = 0.f;
            for (int j = (t0 - w + 1 > 0 ? t0 - w + 1 : 0); j < t0; ++j) { unpack8(*(const GAS v4u*)(P + (rb + j) * AB_IN + c0), a);
#pragma unroll
                for (int e = 0; e < 8; ++e) sum[e] += a[e]; }
            for (int i = 0; i < 16; ++i) { const int t = t0 + i; unpack8(*(const GAS v4u*)(P + (rb + t) * AB_IN + c0), a);
                const float inv = 1.0f / (float)(t + 1 < w ? t + 1 : w); float o[8];
#pragma unroll
                for (int e = 0; e < 8; ++e) { sum[e] += a[e]; o[e] = sum[e] * inv - a[e]; }
                *(GAS v4u*)(MX + (rb + t) * DM + c0) = pack8(o);
                if (t - w + 1 >= 0) { unpack8(*(const GAS v4u*)(P + (rb + t - w + 1) * AB_IN + c0), a);
#pragma unroll
                    for (int e = 0; e < 8; ++e) sum[e] -= a[e]; } }
        } else {
            const int cc = (ch - 64) * 8; float w0[8], w1[8], w2[8], bb[8], g1[8], g2[8], xb[8], gb[8], gc[8];
#pragma unroll
            for (int e = 0; e < 8; ++e) { w0[e] = cw[cc + e]; w1[e] = cw[512 + cc + e]; w2[e] = cw[1024 + cc + e]; bb[e] = cb[cc + e]; g1[e] = 0.f; g2[e] = 0.f; }
            if (t0 >= 1) { unpack8(*(const GAS v4u*)(P + (rb + t0 - 1) * AB_IN + 512 + cc), xb); unpack8(*(const GAS v4u*)(P + (rb + t0 - 1) * AB_IN + 1536 + cc), gc);
#pragma unroll
                for (int e = 0; e < 8; ++e) g1[e] = gc[e] * xb[e]; }
            if (t0 >= 2) { unpack8(*(const GAS v4u*)(P + (rb + t0 - 2) * AB_IN + 512 + cc), xb); unpack8(*(const GAS v4u*)(P + (rb + t0 - 2) * AB_IN + 1536 + cc), gc);
#pragma unroll
                for (int e = 0; e < 8; ++e) g2[e] = gc[e] * xb[e]; }
            for (int i = 0; i < 16; ++i) { const int t = t0 + i; const bf16* pr = P + (rb + t) * AB_IN;
                unpack8(*(const GAS v4u*)(pr + 512 + cc), xb); unpack8(*(const GAS v4u*)(pr + 1024 + cc), gb); unpack8(*(const GAS v4u*)(pr + 1536 + cc), gc); float o[8];
#pragma unroll
                for (int e = 0; e < 8; ++e) { const float g0 = gc[e] * xb[e]; o[e] = gb[e] * (w0[e] * g2[e] + w1[e] * g1[e] + w2[e] * g0 + bb[e]); g2[e] = g1[e]; g1[e] = g0; }
                *(GAS v4u*)(MX + (rb + t) * DM + 512 + cc) = pack8(o); }
        }
    }
}
__device__ __forceinline__ void p7_attention(Frame& F) {
    typedef float f4 __attribute__((ext_vector_type(4)));
    LAS f4* Ks = (LAS f4*)(F.lds + RING_OFF); LAS f4* Vs = Ks + 1024;
    const bf16* QKV = (const bf16*)(F.ws + WS_QKV); bf16* MX = (bf16*)(F.ws + WS_MIX);
    for (int u = F.vcu; u < 512; u += F.G) {
        const int bh = (u & 255) >> 1, q01 = u & 1, qq = (u >> 8) ? 3 - q01 : q01, b = bh >> 3, h = bh & 7;
        const int t = 512 * qq + F.tid; const size_t rb = (size_t)b * SEQ;
        float q[64], o[64];
        { const bf16* qp = QKV + (rb + t) * 1536 + h * 64;
#pragma unroll
          for (int c = 0; c < 8; ++c) unpack8(*(const GAS v4u*)(qp + c * 8), q + c * 8); }
#pragma unroll
        for (int d = 0; d < 64; ++d) o[d] = 0.f;
        float carry = 0.f;
        const int wave_tmax = 512 * qq + 64 * F.wave + 63;
        for (int tt = 8 * qq + 7; tt >= 0; --tt) {
            __syncthreads();
            { const int kk = F.tid >> 3, c8 = F.tid & 7; const bf16* kp = QKV + (rb + tt * 64 + kk) * 1536 + 512 + h * 64 + c8 * 8; float f[8];
              unpack8(*(const GAS v4u*)kp, f); Ks[kk * 16 + c8 * 2] = (f4){f[0], f[1], f[2], f[3]}; Ks[kk * 16 + c8 * 2 + 1] = (f4){f[4], f[5], f[6], f[7]};
              unpack8(*(const GAS v4u*)(kp + 512), f); Vs[kk * 16 + c8 * 2] = (f4){f[0], f[1], f[2], f[3]}; Vs[kk * 16 + c8 * 2 + 1] = (f4){f[4], f[5], f[6], f[7]}; }
            __syncthreads();
            if (tt * 64 < wave_tmax) {
                for (int s = 63; s >= 0; --s) {
                    float d0 = 0.f, d1 = 0.f;
#pragma unroll
                    for (int c = 0; c < 16; c += 2) { const f4 k0 = Ks[s * 16 + c], k1 = Ks[s * 16 + c + 1];
                        d0 += q[4 * c] * k0.x + q[4 * c + 1] * k0.y + q[4 * c + 2] * k0.z + q[4 * c + 3] * k0.w;
                        d1 += q[4 * c + 4] * k1.x + q[4 * c + 5] * k1.y + q[4 * c + 6] * k1.z + q[4 * c + 7] * k1.w; }
                    const float S = d0 + d1; const bool valid = (tt * 64 + s) < t;
                    const float e = __builtin_amdgcn_exp2f(-fabsf(S)), l = __builtin_amdgcn_logf(1.0f + e), nsp = fminf(-S, 0.f) - l, lb = S + nsp;
                    const float w = valid ? __builtin_amdgcn_exp2f(lb + carry) : 0.f; carry += valid ? nsp : 0.f;
#pragma unroll
                    for (int c = 0; c < 16; ++c) { const f4 v = Vs[s * 16 + c]; o[4 * c] += w * v.x; o[4 * c + 1] += w * v.y; o[4 * c + 2] += w * v.z; o[4 * c + 3] += w * v.w; }
                }
            }
        }
        { bf16* op = MX + (rb + t) * DM + 512 + h * 64;
#pragma unroll
          for (int c = 0; c < 8; ++c) *(GAS v4u*)(op + c * 8) = pack8(o + c * 8); }
    }
    __syncthreads();
}
__device__ __forceinline__ void p7_sgu(Frame& F) {
    LAS float* st = (LAS float*)(F.lds + RING_OFF); LAS float* VN = st + 256;
    const bf16* UV = (const bf16*)(F.ws + WS_BIG); bf16* MX = (bf16*)(F.ws + WS_MIX);
    const float* gam = F.in[10]; const float* bet = F.in[11]; const float* sw = F.in[12]; const float* sb = F.in[13];
    for (int u = F.vcu; u < 256; u += F.G) {
        const size_t row0 = (size_t)(u >> 4) * SEQ + (size_t)(u & 15) * 128;
        __syncthreads();
        for (int i = 0; i < 16; ++i) { const int s = 16 * F.wave + i; float f[8]; unpack8(*(const GAS v4u*)(UV + (row0 + s) * 1024 + 512 + F.lane * 8), f);
            float a = 0.f;
#pragma unroll
            for (int e = 0; e < 8; ++e) a += f[e];
            const float mean = wave_sum(a) * (1.0f / 512.0f); float qv = 0.f;
#pragma unroll
            for (int e = 0; e < 8; ++e) { const float d = f[e] - mean; qv += d * d; }
            const float rstd = 1.0f / sqrtf(wave_sum(qv) * (1.0f / 512.0f) + EPS);
            if (F.lane == 0) { st[s] = mean; st[128 + s] = rstd; } }
        __syncthreads();
        for (int g = 0; g < 4; ++g) {
            { const int s = F.tid >> 2, cq = F.tid & 3; const float mean = st[s], rstd = st[128 + s];
#pragma unroll
              for (int j = 0; j < 4; ++j) { const int c = cq * 32 + j * 8; float f[8]; unpack8(*(const GAS v4u*)(UV + (row0 + s) * 1024 + 512 + g * 128 + c), f);
#pragma unroll
                  for (int e = 0; e < 8; ++e) VN[s * 128 + c + e] = (f[e] - mean) * rstd * gam[g * 128 + c + e] + bet[g * 128 + c + e]; } }
            __syncthreads();
            { const int c = F.tid & 127, tq = F.tid >> 7;
              for (int i = 0; i < 32; ++i) { const int t = tq * 32 + i; const float* wr = sw + ((size_t)g * 128 + t) * 128; float a = 0.f;
                  for (int s = 0; s <= t; ++s) a += wr[s] * VN[s * 128 + c];
                  const float uu = bf2f(UV[(row0 + t) * 1024 + g * 128 + c]);
                  MX[(row0 + t) * DM + g * 128 + c] = (bf16)f2bf(uu * (a + sb[g * 128 + t])); } }
            __syncthreads();
        }
    }
}
__device__ __forceinline__ void p11_final(Frame& F) {
    const int gw = F.vcu * NWAVES + F.wave, NGW = F.G * NWAVES; const GAS f32x4* gr = (const GAS f32x4*)F.in[17] + F.lane;
    for (int m = gw; m < M; m += NGW) { GAS f32x4* xr = (GAS f32x4*)(F.out + (size_t)m * DM) + F.lane; f32x4 v[4]; float s = 0.f;
#pragma unroll
        for (int j = 0; j < 4; ++j) { v[j] = xr[64 * j]; s += (v[j].x * v[j].x + v[j].y * v[j].y) + (v[j].z * v[j].z + v[j].w * v[j].w); }
        const float rstd = 1.0f / sqrtf(wave_sum(s) * (1.f / DM) + EPS);
#pragma unroll
        for (int j = 0; j < 4; ++j) { const f32x4 g = gr[64 * j]; xr[64 * j] = (f32x4){v[j].x * rstd * g.x, v[j].y * rstd * g.y, v[j].z * rstd * g.z, v[j].w * rstd * g.w}; } }
}

struct Args { const float* in[18]; float* out; unsigned char* ws; int ph_lo, ph_hi, li, pad; };
__global__ void __launch_bounds__(NWAVES * 64, 2) trunk_fwd(Args args) {
    extern __shared__ __attribute__((aligned(16))) unsigned char lds[];
    Frame F;
    F.lds = (LAS unsigned char*)lds;
    F.MISC = (volatile LAS unsigned*)(F.lds + MISC_OFF);
    F.tid = threadIdx.x; F.lane = F.tid & 63; F.wave = __builtin_amdgcn_readfirstlane(F.tid >> 6);
    F.G = gridDim.x; { const int bx = blockIdx.x; F.vcu = (F.G % 8 == 0) ? (bx % 8) * (F.G / 8) + bx / 8 : bx; }
#pragma unroll
    for (int i = 0; i < 18; ++i) F.in[i] = args.in[i];
    F.out = args.out; F.ws = args.ws; F.ctl = (gu32*)(args.ws + WS_CTL);
    for (int u = F.tid; u < (LDS_BYTES - LDSCTL_OFF) / 4; u += NWAVES * 64) ((LAS unsigned*)(F.lds + LDSCTL_OFF))[u] = 0u;
    __syncthreads();
    XcdBarrier bar; bar.bar = (unsigned*)(F.ctl + CW_BAR); bar.x = 0; bar.st = nullptr;
    if (N_LAUNCHES == 1) bar = xcd_barrier_post((unsigned*)(F.ctl + CW_BAR), F.MISC + 8);
    const int lo = args.ph_lo, hi = args.ph_hi;
#define IN(k) (lo <= (k) && (k) < hi)
#define SEAM(k) do { if (IN(k) && IN((k) + 1)) xcd_barrier(bar); } while (0)
    bf16* XN = (bf16*)(F.ws + WS_XN); bf16* MIX = (bf16*)(F.ws + WS_MIX); bf16* BIG = (bf16*)(F.ws + WS_BIG); bf16* QKV = (bf16*)(F.ws + WS_QKV); float* SS = (float*)(F.ws + WS_SS);
    if (IN(0)) { p0_prologue(F); SEAM(0); }
    if (IN(1)) { pg8::Gemm g{XN, (const bf16*)(F.ws + WS_WABIN), M, AB_IN, DM}; pg8::StaticOrder S; S.init(M, AB_IN, F.G, (int)blockIdx.x);
        pg8::EpiStore E{BIG, AB_IN};
        pg8::gemm_phase<pg8::EpiStore, pg8::StaticOrder, true, true>(F.lds + RING_OFF, g, S, E); SEAM(1); }
    if (IN(2)) { p2_mixer_ab(F); SEAM(2); }
    if (IN(3)) { pg8::Gemm g{MIX, (const bf16*)(F.ws + WS_WABOUT), M, DM, DM}; pg8::StaticOrder S; S.init(M, DM, F.G, (int)blockIdx.x);
        pg8::EpiResid<true> E{F.in[0], F.out, XN, SS};
        pg8::gemm_phase<pg8::EpiResid<true>, pg8::StaticOrder, true, true>(F.lds + RING_OFF, g, S, E); SEAM(3); }
    if (IN(4)) { pg8::Gemm g{XN, (const bf16*)(F.ws + WS_W1), M, FF, DM}; pg8::StaticOrder S; S.init(M, FF, F.G, (int)blockIdx.x);
        pg8::EpiUp E{BIG, SS};
        pg8::gemm_phase<pg8::EpiUp, pg8::StaticOrder, true, true>(F.lds + RING_OFF, g, S, E); SEAM(4); }
    if (IN(5)) { pg8::Gemm g{BIG, (const bf16*)(F.ws + WS_W2), M, DM, FF}; pg8::StaticOrder S; S.init(M, DM, F.G, (int)blockIdx.x);
        pg8::EpiResid<true> E{F.out, F.out, XN, SS};
        pg8::gemm_phase<pg8::EpiResid<true>, pg8::StaticOrder, true, true>(F.lds + RING_OFF, g, S, E); SEAM(5); }
    if (IN(6)) { pg8::Gemm g{XN, (const bf16*)(F.ws + WS_WCDIN), M, CD_IN, DM}; pg8::StaticOrder S; S.init(M, CD_IN, F.G, (int)blockIdx.x);
        pg8::EpiCdIn E{BIG, QKV, SS, QSCALE};
        pg8::gemm_phase<pg8::EpiCdIn, pg8::StaticOrder, true, true>(F.lds + RING_OFF, g, S, E); SEAM(6); }
    if (IN(7)) { p7_attention(F); p7_sgu(F); SEAM(7); }
    if (IN(8)) { pg8::Gemm g{MIX, (const bf16*)(F.ws + WS_WCDOUT), M, DM, DM}; pg8::StaticOrder S; S.init(M, DM, F.G, (int)blockIdx.x);
        pg8::EpiResid<true> E{F.out, F.out, XN, SS};
        pg8::gemm_phase<pg8::EpiResid<true>, pg8::StaticOrder, true, true>(F.lds + RING_OFF, g, S, E); SEAM(8); }
    if (IN(9)) { pg8::Gemm g{XN, (const bf16*)(F.ws + WS_W1 + 8 * MiB), M, FF, DM}; pg8::StaticOrder S; S.init(M, FF, F.G, (int)blockIdx.x);
        pg8::EpiUp E{BIG, SS};
        pg8::gemm_phase<pg8::EpiUp, pg8::StaticOrder, true, true>(F.lds + RING_OFF, g, S, E); SEAM(9); }
    if (IN(10)) { pg8::Gemm g{BIG, (const bf16*)(F.ws + WS_W2 + 8 * MiB), M, DM, FF}; pg8::StaticOrder S; S.init(M, DM, F.G, (int)blockIdx.x);
        pg8::EpiResid<false> E{F.out, F.out, XN, SS};
        pg8::gemm_phase<pg8::EpiResid<false>, pg8::StaticOrder, true, true>(F.lds + RING_OFF, g, S, E); SEAM(10); }
    if (IN(11)) { p11_final(F); }
#undef IN
#undef SEAM
}

extern "C" void kernel_launch(void* const* d_in, const int* in_sizes, int n_in, void* d_out, int out_size, void* d_ws, size_t ws_size, hipStream_t stream) {
    static int grid = 0;
    if (grid == 0) {
        if (n_in != 18 || in_sizes[0] != M * DM || out_size != M * DM || ws_size < WS_END) { fprintf(stderr, "kernel_launch: unexpected shapes (n_in %d in0 %d out %d ws %zu); nothing launched\n", n_in, n_in > 0 ? in_sizes[0] : -1, out_size, ws_size); grid = -1; return; }
        int dev = 0, cus = 0, per_cu = 0;
        if (hipGetDevice(&dev) != hipSuccess || hipDeviceGetAttribute(&cus, hipDeviceAttributeMultiprocessorCount, dev) != hipSuccess) { grid = -1; return; }
        if (hipFuncSetAttribute((const void*)trunk_fwd, hipFuncAttributeMaxDynamicSharedMemorySize, LDS_BYTES) != hipSuccess) { fprintf(stderr, "kernel_launch: hipFuncSetAttribute failed\n"); grid = -1; return; }
        if (hipOccupancyMaxActiveBlocksPerMultiprocessor(&per_cu, (const void*)trunk_fwd, NWAVES * 64, LDS_BYTES) != hipSuccess || per_cu < 1) { fprintf(stderr, "kernel_launch: occupancy query reports %d workgroups per CU\n", per_cu); }
        (void)hipGetLastError();
        grid = cus;
    }
    if (grid < 0) return;
    if (hipMemsetAsync((char*)d_ws + WS_CTL, 0, CTL_ZERO_BYTES, stream) != hipSuccess) return;
    Args a{};
    for (int i = 0; i < 18; ++i) a.in[i] = (const float*)d_in[i];
    a.out = (float*)d_out; a.ws = (unsigned char*)d_ws;
    for (int li = 0; li < N_LAUNCHES; ++li) {
        a.ph_lo = (N_LAUNCHES == 1) ? 0 : li; a.ph_hi = (N_LAUNCHES == 1) ? N_PHASES : li + 1; a.li = li;
        hipLaunchKernelGGL(trunk_fwd, dim3(grid), dim3(NWAVES * 64), LDS_BYTES, stream, a);
    }
}
```

```cpp
#include <hip/hip_runtime.h>
#include <cstdio>
#include <cstdint>
namespace pg8 {
#define PG8_LAS __attribute__((address_space(3)))
typedef unsigned short bf16_t;
typedef short bf16x8 __attribute__((ext_vector_type(8)));
typedef float f32x4 __attribute__((ext_vector_type(4)));
typedef unsigned u32x4 __attribute__((ext_vector_type(4)));
constexpr int BM = 256, BK = 64, HALF = 128, HTB = HALF * BK * 2  , STAGE_BYTES = 8 * HTB, NXCD = 8, WGM = 8;

__host__ __device__ __forceinline__ int lds_byte(int r, int c) { const int st = (r >> 4) * 2 + (c >> 5), rr = r & 15, cc = c & 31, ob = rr * 64 + cc * 2; return st * 1024 + (ob ^ (((ob >> 9) & 1) << 5)); }
__host__ __device__ __forceinline__ void stage_rc(int b, int& R, int& C) { const int st = b / 1024, sb = b % 1024, swz = sb ^ (((sb >> 9) & 1) << 5); R = (st >> 1) * 16 + swz / 64; C = (st & 1) * 32 + (swz % 64) / 2; }
__host__ __device__ __forceinline__ int perm32(int rho) { const int n = rho >> 4, i = rho & 15; return 8 * (i >> 2) + 4 * n + (i & 3); }

struct Unit { int pm, pn; };
struct Gemm { const bf16_t* A; const bf16_t* Bt; int M, N, K; };

struct StaticOrder {
    int nM, nN, nwg, G, c;
    __host__ __device__ void init(int M, int N, int G_, int c_) { nM = M / BM; nN = N / BM; nwg = nM * nN; G = G_; c = c_; }
    __host__ __device__ bool next(int i, Unit& u) const {
        const long L = (long)i * G + c; if (L >= nwg) return false;
        int wgid = (int)L; { const int q = nwg / NXCD, r = nwg % NXCD, xcd = wgid % NXCD, off = wgid / NXCD; wgid = (xcd < r ? xcd * (q + 1) : r * (q + 1) + (xcd - r) * q) + off; }
        const int nig = WGM * nN, gid = wgid / nig, fm = gid * WGM, gsz = (nM - fm) < WGM ? (nM - fm) : WGM;
        u.pm = fm + ((wgid % nig) % gsz); u.pn = (wgid % nig) / gsz; return true;
    }
    __device__ __forceinline__ void a_ready(const Unit&) const {}
    __device__ __forceinline__ void done(const Unit&) const {}
};

__device__ __forceinline__ unsigned cvt_pk_bf16(float lo, float hi) { unsigned r; asm volatile("v_cvt_pk_bf16_f32 %0, %1, %2" : "=v"(r) : "v"(lo), "v"(hi)); return r; }
typedef float f32x2 __attribute__((ext_vector_type(2)));
__device__ __forceinline__ f32x2 gelu_pk(f32x2 v) {
    const f32x2 av = __builtin_elementwise_abs(v), d = av * 0.2316418882f + 1.0f;
    f32x2 t; t.x = __builtin_amdgcn_rcpf(d.x); t.y = __builtin_amdgcn_rcpf(d.y);
    f32x2 q = t * 0.5307027145f + (-0.7265760135f); q = q * t + 0.7107068705f; q = q * t + (-0.142248368f); q = q * t + 0.127414796f; q = q * t;
    const f32x2 s = (v * v) * (-0.72134752044f);
    f32x2 e; e.x = __builtin_amdgcn_exp2f(s.x); e.y = __builtin_amdgcn_exp2f(s.y);
    const f32x2 m = v * (q * e), r = v - m;
    f32x2 o; o.x = v.x < 0.f ? m.x : r.x; o.y = v.y < 0.f ? m.y : r.y; return o;
}
typedef unsigned u32x2 __attribute__((ext_vector_type(2)));
struct EpiStore {
    static constexpr bool PERM = true, AFTER_DRAIN = false;
    bf16_t* O; int ldc;
    __device__ __forceinline__ void operator()(const f32x4 (&acc)[2][2][4][2], const Unit& u, int wr, int wc, int fr, int fq) const {
        const int row0 = u.pm * BM + wr * 64 + fr, col0 = u.pn * BM + wc * 32 + 8 * fq;
#pragma unroll
        for (int ai = 0; ai < 2; ++ai)
#pragma unroll
            for (int m = 0; m < 4; ++m) { bf16_t* rowp = O + (size_t)(row0 + ai * HALF + m * 16) * ldc + col0;
#pragma unroll
                for (int bj = 0; bj < 2; ++bj) { const f32x4 v0 = acc[ai][bj][m][0], v1 = acc[ai][bj][m][1];
                    u32x4 w; w.x = cvt_pk_bf16(v0[0], v0[1]); w.y = cvt_pk_bf16(v0[2], v0[3]); w.z = cvt_pk_bf16(v1[0], v1[1]); w.w = cvt_pk_bf16(v1[2], v1[3]);
                    *(u32x4*)(rowp + bj * HALF) = w; } }
    }
};
template <bool WRITE_HB> struct EpiResid {
    static constexpr bool PERM = false, AFTER_DRAIN = false;
    const float* base; float* out; bf16_t* hb; float* ss;
    __device__ __forceinline__ void operator()(const f32x4 (&acc)[2][2][4][2], const Unit& u, int wr, int wc, int fr, int fq) const {
        const int row0 = u.pm * BM + wr * 64 + fr, col0 = u.pn * BM + wc * 32 + 4 * fq;
#pragma unroll
        for (int ai = 0; ai < 2; ++ai)
#pragma unroll
            for (int m = 0; m < 4; ++m) { const int row = row0 + ai * HALF + m * 16; const size_t off = (size_t)row * 1024 + col0;
                f32x4 b[2][2];
#pragma unroll
                for (int bj = 0; bj < 2; ++bj)
#pragma unroll
                    for (int n = 0; n < 2; ++n) b[bj][n] = *(const f32x4*)(base + off + bj * HALF + n * 16);
                float s = 0.f;
#pragma unroll
                for (int bj = 0; bj < 2; ++bj)
#pragma unroll
                    for (int n = 0; n < 2; ++n) { const f32x4 v = b[bj][n] + acc[ai][bj][m][n]; *(f32x4*)(out + off + bj * HALF + n * 16) = v;
                        if (WRITE_HB) { u32x2 w; w.x = cvt_pk_bf16(v[0], v[1]); w.y = cvt_pk_bf16(v[2], v[3]); *(u32x2*)(hb + off + bj * HALF + n * 16) = w;
                            s += (v[0] * v[0] + v[1] * v[1]) + (v[2] * v[2] + v[3] * v[3]); } }
                if (WRITE_HB) { s += __shfl_xor(s, 16); s += __shfl_xor(s, 32); if (fq == 0) ss[(size_t)row * 16 + u.pn * 4 + wc] = s; }
                asm volatile("" ::: "memory"); }
    }
};
__device__ __forceinline__ float row_rstd(const float* ss, int row, int fq) {
    const f32x4 p = *(const f32x4*)(ss + (size_t)row * 16 + 4 * fq); float s = (p[0] + p[1]) + (p[2] + p[3]);
    s += __shfl_xor(s, 16); s += __shfl_xor(s, 32);
    return 1.0f / sqrtf(s * (1.0f / 1024.0f) + 1e-6f);
}
struct EpiUp {
    static constexpr bool PERM = true, AFTER_DRAIN = false;
    bf16_t* O; const float* ss;
    __device__ __forceinline__ void operator()(const f32x4 (&acc)[2][2][4][2], const Unit& u, int wr, int wc, int fr, int fq) const {
        const int row0 = u.pm * BM + wr * 64 + fr, col0 = u.pn * BM + wc * 32 + 8 * fq;
#pragma unroll
        for (int ai = 0; ai < 2; ++ai)
#pragma unroll
            for (int m = 0; m < 4; ++m) { const int row = row0 + ai * HALF + m * 16; const float rs = row_rstd(ss, row, fq);
                bf16_t* rowp = O + (size_t)row * 4096 + col0;
#pragma unroll
                for (int bj = 0; bj < 2; ++bj) { f32x4 v0 = acc[ai][bj][m][0] * rs, v1 = acc[ai][bj][m][1] * rs;
#pragma unroll
                    for (int e = 0; e < 4; ++e) { const float a = fmaxf(v0[e], 0.f), b = fmaxf(v1[e], 0.f); v0[e] = a * a; v1[e] = b * b; }
                    u32x4 w; w.x = cvt_pk_bf16(v0[0], v0[1]); w.y = cvt_pk_bf16(v0[2], v0[3]); w.z = cvt_pk_bf16(v1[0], v1[1]); w.w = cvt_pk_bf16(v1[2], v1[3]);
                    *(u32x4*)(rowp + bj * HALF) = w; } }
    }
};
struct EpiCdIn {
    static constexpr bool PERM = true, AFTER_DRAIN = false;
    bf16_t* UV; bf16_t* QKV; const float* ss; float qscale;
    __device__ __forceinline__ void operator()(const f32x4 (&acc)[2][2][4][2], const Unit& u, int wr, int wc, int fr, int fq) const {
        const int row0 = u.pm * BM + wr * 64 + fr; const bool isuv = u.pn < 4;
        const int colt = isuv ? u.pn * BM : (u.pn - 4) * BM; const int ldc = isuv ? 1024 : 1536; bf16_t* base = isuv ? UV : QKV;
        const float sc = (!isuv && u.pn < 6) ? qscale : 1.0f;
        const int col0 = colt + wc * 32 + 8 * fq;
#pragma unroll
        for (int ai = 0; ai < 2; ++ai)
#pragma unroll
            for (int m = 0; m < 4; ++m) { const int row = row0 + ai * HALF + m * 16; const float rs = row_rstd(ss, row, fq) * sc;
                bf16_t* rowp = base + (size_t)row * ldc + col0;
#pragma unroll
                for (int bj = 0; bj < 2; ++bj) { f32x4 v0 = acc[ai][bj][m][0] * rs, v1 = acc[ai][bj][m][1] * rs;
                    if (isuv) { f32x2 a = gelu_pk((f32x2){v0[0], v0[1]}), b = gelu_pk((f32x2){v0[2], v0[3]}), c = gelu_pk((f32x2){v1[0], v1[1]}), d = gelu_pk((f32x2){v1[2], v1[3]});
                        v0 = (f32x4){a.x, a.y, b.x, b.y}; v1 = (f32x4){c.x, c.y, d.x, d.y}; }
                    u32x4 w; w.x = cvt_pk_bf16(v0[0], v0[1]); w.y = cvt_pk_bf16(v0[2], v0[3]); w.z = cvt_pk_bf16(v1[0], v1[1]); w.w = cvt_pk_bf16(v1[2], v1[3]);
                    *(u32x4*)(rowp + bj * HALF) = w; } }
    }
};
template <class Epi, class Sched, bool ALIGN_EPI = false, bool SP2 = false>
__device__ __forceinline__ void gemm_phase(PG8_LAS unsigned char* lds, const Gemm g, const Sched& S, const Epi& E) {
    const int tid = threadIdx.x, wid = __builtin_amdgcn_readfirstlane(tid >> 6), lane = tid & 63, wr = wid >> 2, wc = wid & 3, fr = lane & 15, fq = lane >> 4;
    const int K = g.K, nt = K / BK;
    unsigned voffA[2], voffB[2];
#pragma unroll
    for (int i = 0; i < 2; ++i) { int R, C; stage_rc(tid * 16 + i * 8192, R, C); const int Rb = Epi::PERM ? ((R & ~31) + perm32(R & 31)) : R;
        voffA[i] = (unsigned)(R * K + C) * 2u; voffB[i] = (unsigned)(Rb * K + C) * 2u; }
    const size_t kstep = (size_t)(BK * 2);
    const size_t hstep = (size_t)HALF * K * 2;
    const size_t tstep = 2 * hstep;
    const unsigned ldsw = (unsigned)wid * 1024u;
    const int aoff = lds_byte(wr * 64 + fr, fq * 8), boff = lds_byte(wc * 32 + fr, fq * 8);
#define PG8_SA(b, h) (((b) * 2 + (h)) * HTB)
#define PG8_SB(b, h) ((4 + (b) * 2 + (h)) * HTB)
#define PG8_STAGE(bufoff, gbase, voff) do { _Pragma("unroll") for (int _i = 0; _i < 2; ++_i) \
        __builtin_amdgcn_global_load_lds((const unsigned*)((const char*)(gbase) + (voff)[_i]), (PG8_LAS unsigned*)(lds + (bufoff) + ldsw + _i * 8192), 16, 0, 0); } while (0)
#define PG8_LDA(dst, b, h) do { _Pragma("unroll") for (int m = 0; m < 4; ++m) _Pragma("unroll") for (int k = 0; k < 2; ++k) dst[m][k] = *(const PG8_LAS bf16x8*)(lds + PG8_SA(b, h) + aoff + m * 2048 + k * 1024); } while (0)
#define PG8_LDB(dst, b, h) do { _Pragma("unroll") for (int n = 0; n < 2; ++n) _Pragma("unroll") for (int k = 0; k < 2; ++k) dst[n][k] = *(const PG8_LAS bf16x8*)(lds + PG8_SB(b, h) + boff + n * 2048 + k * 1024); } while (0)
#define PG8_MMA(ai, bj, At, Bt) do { __builtin_amdgcn_s_setprio(1); _Pragma("unroll") for (int m = 0; m < 4; ++m) _Pragma("unroll") for (int n = 0; n < 2; ++n) _Pragma("unroll") for (int k = 0; k < 2; ++k) \
        acc[ai][bj][m][n] = __builtin_amdgcn_mfma_f32_16x16x32_bf16(Bt[n][k], At[m][k], acc[ai][bj][m][n], 0, 0, 0); __builtin_amdgcn_s_setprio(0); } while (0)
#define PG8_WAIT_V(n) asm volatile("s_waitcnt vmcnt(" #n ")" ::: "memory")
#define PG8_WAIT_L(n) asm volatile("s_waitcnt lgkmcnt(" #n ")" ::: "memory")
#define PG8_BAR __builtin_amdgcn_s_barrier()
#define PG8_SCHED __builtin_amdgcn_sched_barrier(0)
    Unit cur, nxt; int ui = 0;
    if (!S.next(0, cur)) return;
    f32x4 acc[2][2][4][2];
#pragma unroll
    for (int a = 0; a < 2; ++a)
#pragma unroll
        for (int b = 0; b < 2; ++b)
#pragma unroll
            for (int m = 0; m < 4; ++m)
#pragma unroll
                for (int n = 0; n < 2; ++n) acc[a][b][m][n] = (f32x4){0.f, 0.f, 0.f, 0.f};
    bf16x8 At[4][2], B0[2][2], B1[2][2];
    const char* cA = (const char*)g.A + (size_t)cur.pm * tstep; const char* cB = (const char*)g.Bt + (size_t)cur.pn * tstep;
    S.a_ready(cur);
    if constexpr (SP2) {
        PG8_STAGE(PG8_SB(0, 0), cB, voffB); PG8_STAGE(PG8_SB(0, 1), cB + hstep, voffB); PG8_STAGE(PG8_SA(0, 0), cA, voffA); PG8_STAGE(PG8_SA(0, 1), cA + hstep, voffA);
        if (wr == 1) PG8_BAR;
        PG8_WAIT_V(2); PG8_BAR;
        PG8_STAGE(PG8_SB(1, 0), cB + kstep, voffB); PG8_STAGE(PG8_SA(1, 0), cA + kstep, voffA); PG8_STAGE(PG8_SB(1, 1), cB + hstep + kstep, voffB);
        PG8_WAIT_V(6); PG8_BAR;
    } else {
        PG8_STAGE(PG8_SB(0, 0), cB, voffB); PG8_STAGE(PG8_SA(0, 0), cA, voffA); PG8_STAGE(PG8_SB(0, 1), cB + hstep, voffB); PG8_STAGE(PG8_SA(0, 1), cA + hstep, voffA);
        if (wr == 1) PG8_BAR;
        PG8_WAIT_V(4); PG8_BAR;
        PG8_STAGE(PG8_SB(1, 0), cB + kstep, voffB); PG8_STAGE(PG8_SA(1, 0), cA + kstep, voffA); PG8_STAGE(PG8_SB(1, 1), cB + hstep + kstep, voffB);
        PG8_WAIT_V(6); PG8_BAR;
    }
    for (;;) {
        const bool has_next = S.next(ui + 1, nxt);
        const char* nA = has_next ? (const char*)g.A + (size_t)nxt.pm * tstep : cA; const char* nB = has_next ? (const char*)g.Bt + (size_t)nxt.pn * tstep : cB;
        for (int t = 0; t < nt; t += 2) {
            const bool last = (t == nt - 2);
            const char* a1 = cA + (size_t)(t + 1) * kstep;
            const char* a2 = last ? nA : cA + (size_t)(t + 2) * kstep; const char* b2 = last ? nB : cB + (size_t)(t + 2) * kstep;
            const char* a3 = a2 + kstep; const char* b3 = b2 + kstep;
            if (last && has_next) S.a_ready(nxt);
            if constexpr (SP2) {
            PG8_LDB(B0, 0, 0); PG8_LDB(B1, 0, 1); PG8_SCHED; PG8_LDA(At, 0, 0); PG8_STAGE(PG8_SA(1, 1), a1 + hstep, voffA);
            PG8_WAIT_V(8); PG8_WAIT_L(0); PG8_BAR; PG8_MMA(0, 0, At, B0); PG8_MMA(0, 1, At, B1); PG8_BAR; PG8_SCHED;
            PG8_LDA(At, 0, 1); PG8_STAGE(PG8_SB(0, 0), b2, voffB); PG8_STAGE(PG8_SB(0, 1), b2 + hstep, voffB); PG8_STAGE(PG8_SA(0, 0), a2, voffA);
            PG8_WAIT_V(8); PG8_WAIT_L(0); PG8_BAR; PG8_MMA(1, 0, At, B0); PG8_MMA(1, 1, At, B1); PG8_BAR; PG8_SCHED;
            PG8_LDB(B0, 1, 0); PG8_LDB(B1, 1, 1); PG8_SCHED; PG8_LDA(At, 1, 0); PG8_STAGE(PG8_SA(0, 1), a2 + hstep, voffA);
            PG8_WAIT_V(8); PG8_WAIT_L(0); PG8_BAR; PG8_MMA(0, 0, At, B0); PG8_MMA(0, 1, At, B1); PG8_BAR; PG8_SCHED;
            PG8_LDA(At, 1, 1); PG8_STAGE(PG8_SB(1, 0), b3, voffB); PG8_STAGE(PG8_SB(1, 1), b3 + hstep, voffB); PG8_STAGE(PG8_SA(1, 0), a3, voffA);
            PG8_WAIT_V(8); PG8_WAIT_L(0); PG8_BAR; PG8_MMA(1, 0, At, B0); PG8_MMA(1, 1, At, B1); PG8_BAR; PG8_SCHED;
            } else {
            PG8_LDB(B0, 0, 0); PG8_SCHED; PG8_LDA(At, 0, 0); PG8_STAGE(PG8_SA(1, 1), a1 + hstep, voffA);
            PG8_WAIT_L(8); PG8_BAR; PG8_WAIT_L(0); PG8_MMA(0, 0, At, B0); PG8_BAR; PG8_SCHED;
            PG8_LDB(B1, 0, 1); PG8_STAGE(PG8_SB(0, 0), b2, voffB);
            PG8_BAR; PG8_WAIT_L(0); PG8_MMA(0, 1, At, B1); PG8_BAR;
            PG8_LDA(At, 0, 1); PG8_STAGE(PG8_SA(0, 0), a2, voffA);
            PG8_BAR; PG8_WAIT_L(0); PG8_MMA(1, 0, At, B0); PG8_BAR; PG8_SCHED;
            PG8_STAGE(PG8_SB(0, 1), b2 + hstep, voffB);
            PG8_WAIT_V(6); PG8_BAR; PG8_MMA(1, 1, At, B1); PG8_BAR;
            PG8_LDB(B0, 1, 0); PG8_SCHED; PG8_LDA(At, 1, 0); PG8_STAGE(PG8_SA(0, 1), a2 + hstep, voffA);
            PG8_WAIT_L(8); PG8_BAR; PG8_WAIT_L(0); PG8_MMA(0, 0, At, B0); PG8_BAR; PG8_SCHED;
            PG8_LDB(B1, 1, 1); PG8_STAGE(PG8_SB(1, 0), b3, voffB);
            PG8_BAR; PG8_WAIT_L(0); PG8_MMA(0, 1, At, B1); PG8_BAR;
            PG8_LDA(At, 1, 1); PG8_STAGE(PG8_SA(1, 0), a3, voffA);
            PG8_BAR; PG8_WAIT_L(0); PG8_MMA(1, 0, At, B0); PG8_BAR; PG8_SCHED;
            PG8_STAGE(PG8_SB(1, 1), b3 + hstep, voffB);
            PG8_WAIT_V(6); PG8_BAR; PG8_MMA(1, 1, At, B1); PG8_BAR;
            }
        }
        if constexpr (ALIGN_EPI) { if (wr == 0) PG8_BAR; }
        if constexpr (!Epi::AFTER_DRAIN) { E(acc, cur, wr, wc, fr, fq); S.done(cur); }
        if (!has_next) break;
#pragma unroll
        for (int a = 0; a < 2; ++a)
#pragma unroll
            for (int b = 0; b < 2; ++b)
#pragma unroll
                for (int m = 0; m < 4; ++m)
#pragma unroll
                    for (int n = 0; n < 2; ++n) acc[a][b][m][n] = (f32x4){0.f, 0.f, 0.f, 0.f};
        cur = nxt; cA = nA; cB = nB; ++ui;
        if constexpr (ALIGN_EPI) { if (wr == 1) PG8_BAR; }
    }
    PG8_WAIT_V(0);
    if constexpr (!ALIGN_EPI) { if (wr == 0) PG8_BAR; }
    PG8_BAR;
    if constexpr (Epi::AFTER_DRAIN) { E.fused(acc, cur, wr, wc, fr, fq, lds, wid, lane); S.done(cur); }
#undef PG8_SA
#undef PG8_SB
#undef PG8_STAGE
#undef PG8_LDA
#undef PG8_LDB
#undef PG8_MMA
#undef PG8_WAIT_V
#undef PG8_WAIT_L
#undef PG8_BAR
#undef PG8_SCHED
}
}
constexpr int NWAVES = 8;
#ifndef MK_N_LAUNCHES
#define MK_N_LAUNCHES 1
#endif
constexpr int N_PHASES = 12;
constexpr int N_LAUNCHES = MK_N_LAUNCHES;
constexpr int BATCH = 16, SEQ = 2048, DM = 1024, M = BATCH * SEQ, FF = 4096, AB_IN = 2048, CD_IN = 2560;
constexpr float EPS = 1e-6f;
constexpr float QSCALE = 0.125f * 1.4426950408889634f;
constexpr size_t MiB = 1u << 20;
constexpr size_t WS_CTL = 0, CTL_ZERO_BYTES = 1 * MiB;
constexpr size_t WS_WABIN = 2 * MiB, WS_WABOUT = 6 * MiB, WS_W1 = 8 * MiB  , WS_W2 = 24 * MiB  , WS_WCDIN = 40 * MiB, WS_WCDOUT = 46 * MiB, WS_WSGU = 48 * MiB;
constexpr size_t WS_TMPF = 50 * MiB;
constexpr size_t WS_SS = 52 * MiB;
constexpr size_t WS_XN = 56 * MiB;
constexpr size_t WS_MIX = 120 * MiB;
constexpr size_t WS_BIG = 184 * MiB;
constexpr size_t WS_QKV = WS_BIG + 64 * MiB;
constexpr size_t WS_END = 440 * MiB;
constexpr int CW_BAR = 4096;
constexpr int RING_OFF = 0, RING_BYTES = 131072;
constexpr int LDSCTL_OFF = RING_BYTES, MISC_OFF = LDSCTL_OFF + 320;
constexpr int LDS_BYTES = 147456;
#define GAS __attribute__((address_space(1)))
#define LAS __attribute__((address_space(3)))
typedef unsigned short bf16;
typedef unsigned v4u __attribute__((ext_vector_type(4)));
typedef float f32x4 __attribute__((ext_vector_type(4)));
typedef short bf16x8 __attribute__((ext_vector_type(8)));
typedef GAS unsigned gu32;
typedef GAS unsigned long long gu64;
#define RLX_AGENT __ATOMIC_RELAXED, __HIP_MEMORY_SCOPE_AGENT
#define LDS_WAIT() asm volatile("s_waitcnt lgkmcnt(0)" ::: "memory")
#define VM_WAIT() asm volatile("s_waitcnt vmcnt(0)" ::: "memory")
__device__ __forceinline__ unsigned long long rt() { return __builtin_amdgcn_s_memrealtime(); }
__device__ __forceinline__ unsigned f2bf(float f) { unsigned u = __builtin_bit_cast(unsigned, f); return (u + 0x7fffu + ((u >> 16) & 1u)) >> 16; }
__device__ __forceinline__ unsigned pk2(float lo, float hi) { return f2bf(lo) | (f2bf(hi) << 16); }
#define XB_TMO      128
#define XB_XCNT(j)  (256  + 64 * (j))
#define XB_XSUB(j)  (1280 + 64 * (j))
#define XB_XGEN(j)  (2304 + 64 * (j))
#define XB_TOP      3328
#define XB_TOPGEN   3392
#define XCD_BAR_WORDS 3456
#define XB_SPIN_CAP (1u << 18)

__device__ __forceinline__ unsigned xb_ld(unsigned* p)              { return __hip_atomic_load(p, __ATOMIC_RELAXED, __HIP_MEMORY_SCOPE_AGENT); }
__device__ __forceinline__ unsigned xb_add(unsigned* p, unsigned v) { return __hip_atomic_fetch_add(p, v, __ATOMIC_RELAXED, __HIP_MEMORY_SCOPE_AGENT); }
__device__ __forceinline__ unsigned xb_xcc_id() { return (unsigned)__builtin_amdgcn_s_getreg((3 << 11) | 20) & 0xFu; }
#define XB_SPIN(cond, bar) do { unsigned _sp = 0; while (cond) { __builtin_amdgcn_s_sleep(1); \
    if ((++_sp & 255u) == 0u) { if (xb_ld(&(bar)[XB_TMO])) break; if (_sp > XB_SPIN_CAP) { atomicAdd(&(bar)[XB_TMO], 1u); break; } } } } while (0)

struct XcdBarrier {
    unsigned* bar; unsigned x;
    volatile LAS unsigned* st;
};

__device__ __forceinline__ XcdBarrier xcd_barrier_post(unsigned* bar, volatile LAS unsigned* st) {
    XcdBarrier b; b.bar = bar; b.x = xb_xcc_id(); b.st = st;
    if (threadIdx.x == 0) (void)xb_add(&bar[XB_XCNT(b.x)], 1u);
    return b;
}
__device__ __forceinline__ void xcd_barrier_complete(unsigned* bar, unsigned x, unsigned& nloc, unsigned& nx) {
    const unsigned G = gridDim.x * gridDim.y * gridDim.z;
    unsigned sum, cnt, mine, sp = 0u;
    for (;;) {
        sum = 0u; cnt = 0u; mine = 0u;
#pragma unroll
        for (unsigned j = 0; j < 16; ++j) { const unsigned c = xb_ld(&bar[XB_XCNT(j)]); sum += c; cnt += (c > 0u) ? 1u : 0u; mine = (j == x) ? c : mine; }
        if (sum == G) break;
        __builtin_amdgcn_s_sleep(1);
        if ((++sp & 255u) == 0u) { if (xb_ld(&bar[XB_TMO])) break; if (sp > XB_SPIN_CAP) { atomicAdd(&bar[XB_TMO], 1u); break; } }
    }
    nloc = mine > 0u ? mine : 1u; nx = cnt > 0u ? cnt : 1u;
}

__device__ __forceinline__ void xcd_barrier(const XcdBarrier& b) {
    asm volatile("s_waitcnt vmcnt(0)" ::: "memory");
    __syncthreads();
    if (threadIdx.x == 0) {
        unsigned* bar = b.bar;
        __builtin_amdgcn_s_waitcnt(0);
        unsigned nloc = b.st[0], nx = b.st[1];
        if (nloc == 0u) { xcd_barrier_complete(bar, b.x, nloc, nx); b.st[0] = nloc; b.st[1] = nx; }
        const unsigned old = xb_add(&bar[XB_XSUB(b.x)], 1u);
        const unsigned gen = old / nloc;
        if (old + 1u == (gen + 1u) * nloc) {
            __builtin_amdgcn_fence(__ATOMIC_RELEASE, "agent");
            asm volatile("s_waitcnt vmcnt(0)" ::: "memory");
            const unsigned og = xb_add(&bar[XB_TOP], 1u);
            const unsigned tg = og / nx;
            if (og + 1u == (tg + 1u) * nx) xb_add(&bar[XB_TOPGEN], 1u);
            else XB_SPIN(xb_ld(&bar[XB_TOPGEN]) == tg, bar);
            __builtin_amdgcn_fence(__ATOMIC_ACQUIRE, "agent");
            xb_add(&bar[XB_XGEN(b.x)], 1u);
            asm volatile("s_waitcnt vmcnt(0)" ::: "memory");
        } else {
            XB_SPIN(xb_ld(&bar[XB_XGEN(b.x)]) == gen, bar);
            __builtin_amdgcn_fence(__ATOMIC_ACQUIRE, "agent");
            asm volatile("s_waitcnt vmcnt(0)" ::: "memory");
        }
    }
    __syncthreads();
}
struct Frame {
    LAS unsigned char* lds;
    volatile LAS unsigned* MISC;
    gu32* ctl;
    int tid, lane, wave;
    int vcu, G;
    const float* in[18]; float* out; unsigned char* ws;
};
__device__ __forceinline__ float bf2f(unsigned short b) { return __builtin_bit_cast(float, (unsigned)b << 16); }
__device__ __forceinline__ float wave_sum(float v) {
#pragma unroll
    for (int o = 1; o < 64; o <<= 1) v += __shfl_xor(v, o);
    return v;
}
__device__ __forceinline__ void unpack8(const v4u r, float* f) {
    f[0] = __builtin_bit_cast(float, r.x << 16); f[1] = __builtin_bit_cast(float, r.x & 0xffff0000u);
    f[2] = __builtin_bit_cast(float, r.y << 16); f[3] = __builtin_bit_cast(float, r.y & 0xffff0000u);
    f[4] = __builtin_bit_cast(float, r.z << 16); f[5] = __builtin_bit_cast(float, r.z & 0xffff0000u);
    f[6] = __builtin_bit_cast(float, r.w << 16); f[7] = __builtin_bit_cast(float, r.w & 0xffff0000u);
}
__device__ __forceinline__ v4u pack8(const float* f) { v4u o; o.x = pk2(f[0], f[1]); o.y = pk2(f[2], f[3]); o.z = pk2(f[4], f[5]); o.w = pk2(f[6], f[7]); return o; }

__device__ __forceinline__ void transpose_item(const float* W, const float* gk, int K, int N, bf16* WT, LAS float* scr, int item, int lane) {
    const int nblk = N / 32, kb = item / nblk, nb = item % nblk, k0 = 64 * kb, n0 = 32 * nb;
#pragma unroll 8
    for (int i = 0; i < 32; ++i) { const int kk = 2 * i + (lane >> 5); const float g = gk ? gk[k0 + kk] : 1.0f; scr[kk * 33 + (lane & 31)] = W[(size_t)(k0 + kk) * N + n0 + (lane & 31)] * g; }
    LDS_WAIT(); asm volatile("" ::: "memory");
    const int c = lane & 7;
#pragma unroll
    for (int j = 0; j < 4; ++j) { const int n = (lane >> 3) + 8 * j; const LAS float* s = scr + (8 * c) * 33 + n;
        v4u o; o.x = pk2(s[0 * 33], s[1 * 33]); o.y = pk2(s[2 * 33], s[3 * 33]); o.z = pk2(s[4 * 33], s[5 * 33]); o.w = pk2(s[6 * 33], s[7 * 33]);
        *(GAS v4u*)(WT + (size_t)(n0 + n) * K + k0 + 8 * c) = o; }
    LDS_WAIT(); asm volatile("" ::: "memory");
}

__device__ __forceinline__ void p0_prologue(Frame& F) {
    LAS float* scr = (LAS float*)(F.lds + RING_OFF + F.wave * 16384);
    const int gw = F.vcu * NWAVES + F.wave, NGW = F.G * NWAVES;
    const float* mixg = F.in[1]; const float* mlpg = F.in[2];
    constexpr int I_ABIN = (DM / 64) * (AB_IN / 32), I_W1 = (DM / 64) * (FF / 32), I_W2 = (FF / 64) * (DM / 32), I_CDIN = (DM / 64) * (CD_IN / 32), I_CDOUT = (DM / 64) * (DM / 32);
    constexpr int NITEMS = I_ABIN + 2 * I_W1 + 2 * I_W2 + I_CDIN + I_CDOUT;
    for (int it = gw; it < NITEMS; it += NGW) {
        int r = it;
        if (r < I_ABIN) { transpose_item(F.in[3], nullptr, DM, AB_IN, (bf16*)(F.ws + WS_WABIN), scr, r, F.lane); continue; } r -= I_ABIN;
        if (r < I_W1) { transpose_item(F.in[15], mlpg, DM, FF, (bf16*)(F.ws + WS_W1), scr, r, F.lane); continue; } r -= I_W1;
        if (r < I_W1) { transpose_item(F.in[15] + (size_t)DM * FF, mlpg + DM, DM, FF, (bf16*)(F.ws + WS_W1 + 8 * MiB), scr, r, F.lane); continue; } r -= I_W1;
        if (r < I_W2) { transpose_item(F.in[16], nullptr, FF, DM, (bf16*)(F.ws + WS_W2), scr, r, F.lane); continue; } r -= I_W2;
        if (r < I_W2) { transpose_item(F.in[16] + (size_t)FF * DM, nullptr, FF, DM, (bf16*)(F.ws + WS_W2 + 8 * MiB), scr, r, F.lane); continue; } r -= I_W2;
        if (r < I_CDIN) { transpose_item(F.in[9], mixg + DM, DM, CD_IN, (bf16*)(F.ws + WS_WCDIN), scr, r, F.lane); continue; } r -= I_CDIN;
        transpose_item(F.in[14], nullptr, DM, DM, (bf16*)(F.ws + WS_WCDOUT), scr, r, F.lane);
    }
    { const float* pw = F.in[4]; const float* psc = F.in[5]; const float* wo = F.in[8]; float* tmp = (float*)(F.ws + WS_TMPF);
      for (int it = gw; it < 512 * 16; it += NGW) { const int k = it >> 4, n = (it & 15) * 64 + F.lane, g = k >> 7;
          const float* pwr = pw + (size_t)k * 128; const float* scr_ = psc + g * 128; const float* wor = wo + (size_t)(g * 128) * DM + n; float a = 0.f;
#pragma unroll 8
          for (int d = 0; d < 128; ++d) a += (pwr[d] * scr_[d]) * wor[(size_t)d * DM];
          tmp[(size_t)k * DM + n] = a; } }
    { const float* sw = F.in[12]; bf16* wc = (bf16*)(F.ws + WS_WSGU);
      for (int it = gw * 64 + F.lane; it < 4 * 128 * 16; it += NGW * 64) { const int tt = (it >> 4) & 127, s0 = (it & 15) * 8; float f[8];
#pragma unroll
          for (int e = 0; e < 8; ++e) f[e] = (s0 + e <= tt) ? sw[(size_t)it * 8 + e] : 0.f;
          *(GAS v4u*)(wc + (size_t)it * 8) = pack8(f); } }
    { const float* x = F.in[0]; bf16* xn = (bf16*)(F.ws + WS_XN);
      for (int m = gw; m < M; m += NGW) { const GAS f32x4* xr = (const GAS f32x4*)(x + (size_t)m * DM) + F.lane; const GAS f32x4* gr = (const GAS f32x4*)mixg + F.lane;
          f32x4 v[4]; float s = 0.f;
#pragma unroll
          for (int j = 0; j < 4; ++j) { v[j] = xr[64 * j]; s += (v[j].x * v[j].x + v[j].y * v[j].y) + (v[j].z * v[j].z + v[j].w * v[j].w); }
          const float rstd = 1.0f / sqrtf(wave_sum(s) * (1.f / DM) + EPS);
          GAS unsigned long long* o8 = (GAS unsigned long long*)(xn + (size_t)m * DM) + F.lane;
#pragma unroll
          for (int j = 0; j < 4; ++j) { const f32x4 g = gr[64 * j]; o8[64 * j] = (unsigned long long)pk2(v[j].x * rstd * g.x, v[j].y * rstd * g.y) | ((unsigned long long)pk2(v[j].z * rstd * g.z, v[j].w * rstd * g.w) << 32); } } }
}

__device__ __forceinline__ void p2_mixer_ab(Frame& F) {
    { LAS float* scr = (LAS float*)(F.lds + RING_OFF + F.wave * 16384); const int gw = F.vcu * NWAVES + F.wave, NGW = F.G * NWAVES;
      bf16* wt = (bf16*)(F.ws + WS_WABOUT);
      for (int it = gw; it < (DM / 64) * (DM / 32); it += NGW) {
          const int kb = it / (DM / 32);
          transpose_item(kb < 8 ? (const float*)(F.ws + WS_TMPF) : F.in[8], nullptr, DM, DM, wt, scr, it, F.lane); } }
    const bf16* P = (const bf16*)(F.ws + WS_BIG); bf16* MX = (bf16*)(F.ws + WS_MIX);
    const float* cw = F.in[6]; const float* cb = F.in[7];
    const int tl = F.tid >> 7, ch = F.tid & 127;
    for (int u = F.vcu; u < BATCH * 32; u += F.G) {
        const int b = u >> 5, seg = u & 31, t0 = seg * 64 + tl * 16; const size_t rb = (size_t)b * SEQ;
        if (ch < 64) {
            const int c0 = ch * 8, g = ch >> 4, w = 2 << g; float sum[8], a[8];
#pragma unroll
            for (int e = 0; e < 8; ++e) sum[e] = 0.f;
            for (int j = (t0 - w + 1 > 0 ? t0 - w + 1 : 0); j < t0; ++j) { unpack8(*(const GAS v4u*)(P + (rb + j) * AB_IN + c0), a);
#pragma unroll
                for (int e = 0; e < 8; ++e) sum[e] += a[e]; }
            for (int i = 0; i < 16; ++i) { const int t = t0 + i; unpack8(*(const GAS v4u*)(P + (rb + t) * AB_IN + c0), a);
                const float inv = 1.0f / (float)(t + 1 < w ? t + 1 : w); float o[8];
#pragma unroll
                for (int e = 0; e < 8; ++e) { sum[e] += a[e]; o[e] = sum[e] * inv - a[e]; }
                *(GAS v4u*)(MX + (rb + t) * DM + c0) = pack8(o);
                if (t - w + 1 >= 0) { unpack8(*(const GAS v4u*)(P + (rb + t - w + 1) * AB_IN + c0), a);
#pragma unroll
                    for (int e = 0; e < 8; ++e) sum[e] -= a[e]; } }
        } else {
            const int cc = (ch - 64) * 8; float w0[8], w1[8], w2[8], bb[8], g1[8], g2[8], xb[8], gb[8], gc[8];
#pragma unroll
            for (int e = 0; e < 8; ++e) { w0[e] = cw[cc + e]; w1[e] = cw[512 + cc + e]; w2[e] = cw[1024 + cc + e]; bb[e] = cb[cc + e]; g1[e] = 0.f; g2[e] = 0.f; }
            if (t0 >= 1) { unpack8(*(const GAS v4u*)(P + (rb + t0 - 1) * AB_IN + 512 + cc), xb); unpack8(*(const GAS v4u*)(P + (rb + t0 - 1) * AB_IN + 1536 + cc), gc);
#pragma unroll
                for (int e = 0; e < 8; ++e) g1[e] = gc[e] * xb[e]; }
            if (t0 >= 2) { unpack8(*(const GAS v4u*)(P + (rb + t0 - 2) * AB_IN + 512 + cc), xb); unpack8(*(const GAS v4u*)(P + (rb + t0 - 2) * AB_IN + 1536 + cc), gc);
#pragma unroll
                for (int e = 0; e < 8; ++e) g2[e] = gc[e] * xb[e]; }
            for (int i = 0; i < 16; ++i) { const int t = t0 + i; const bf16* pr = P + (rb + t) * AB_IN;
                unpack8(*(const GAS v4u*)(pr + 512 + cc), xb); unpack8(*(const GAS v4u*)(pr + 1024 + cc), gb); unpack8(*(const GAS v4u*)(pr + 1536 + cc), gc); float o[8];
#pragma unroll
                for (int e = 0; e < 8; ++e) { const float g0 = gc[e] * xb[e]; o[e] = gb[e] * (w0[e] * g2[e] + w1[e] * g1[e] + w2[e] * g0 + bb[e]); g2[e] = g1[e]; g1[e] = g0; }
                *(GAS v4u*)(MX + (rb + t) * DM + 512 + cc) = pack8(o); }
        }
    }
}
namespace sba {
using bf16x8 = __attribute__((ext_vector_type(8))) short;
using f16x8 = __attribute__((ext_vector_type(8))) _Float16;
using s16x4 = __attribute__((ext_vector_type(4))) short;
using f32x16 = __attribute__((ext_vector_type(16))) float;
using u32x4 = __attribute__((ext_vector_type(4))) unsigned;
typedef short v4i16_t __attribute__((ext_vector_type(4)));
typedef float f32x2_t __attribute__((ext_vector_type(2))); typedef __bf16 bf16x2_t __attribute__((ext_vector_type(2))); typedef _Float16 f16x2_t __attribute__((ext_vector_type(2)));
typedef __attribute__((address_space(3))) const char* lds_cptr;
typedef __attribute__((address_space(3))) char* lds_ptr;
__device__ __forceinline__ unsigned pk_bf16(float lo, float hi) { f32x2_t v = {lo, hi}; bf16x2_t b = __builtin_convertvector(v, bf16x2_t); return __builtin_bit_cast(unsigned, b); }
__device__ __forceinline__ unsigned pk_f16(float lo, float hi) { f32x2_t v = {lo, hi}; f16x2_t b = __builtin_convertvector(v, f16x2_t); return __builtin_bit_cast(unsigned, b); }
__device__ __forceinline__ s16x4 vtr(lds_cptr p) { return __builtin_bit_cast(s16x4, __builtin_amdgcn_ds_read_tr16_b64_v4i16((__attribute__((address_space(3))) v4i16_t*)p)); }
#define SB_MFMA_BF16(a, b, c) __builtin_amdgcn_mfma_f32_32x32x16_bf16((a), (b), (c), 0, 0, 0)
#define SB_MFMA_F16(a, b, c) __builtin_amdgcn_mfma_f32_32x32x16_f16((a), (b), (c), 0, 0, 0)
constexpr int KV = 64, SLOT = 16384;

template <bool DIAG>
__device__ __forceinline__ void tile(lds_cptr Kb, lds_cptr Vb, const bf16x8 (&qf)[4], f32x16& o0, f32x16& o1, f32x16& carry,
                                     const f16x8 T0, const f16x8 T1, const f16x8 ONES, int r, int hi, int lane, int limA) {
    f32x16 p0, p1;
#pragma unroll
    for (int i = 0; i < 16; ++i) { p0[i] = 0.f; p1[i] = 0.f; }
    const lds_cptr kp = Kb + hi * 1024 + r * 16;
#pragma unroll
    for (int d0 = 0; d0 < 4; ++d0) {
        const bf16x8 a0 = *(const __attribute__((address_space(3))) bf16x8*)(kp + d0 * 2048);
        const bf16x8 a1 = *(const __attribute__((address_space(3))) bf16x8*)(kp + d0 * 2048 + 512);
        p0 = SB_MFMA_BF16(a0, qf[d0], p0); p1 = SB_MFMA_BF16(a1, qf[d0], p1); }
    unsigned l0p[8], l1p[8];
#pragma unroll
    for (int i = 0; i < 16; i += 2) {
        float n0[2], n1[2];
#pragma unroll
        for (int e = 0; e < 2; ++e) { const int ci = ((i + e) & 3) + 8 * ((i + e) >> 2);
            { const float S = p0[i + e]; const float ex = __builtin_amdgcn_exp2f(-__builtin_fabsf(S)), l = __builtin_amdgcn_logf(1.0f + ex); float nsp = __builtin_fminf(-S, 0.f) - l;
              if (DIAG) nsp = (ci < limA) ? nsp : 0.f; n0[e] = nsp; p0[i + e] = S + nsp; }
            { const float S = p1[i + e]; const float ex = __builtin_amdgcn_exp2f(-__builtin_fabsf(S)), l = __builtin_amdgcn_logf(1.0f + ex); float nsp = __builtin_fminf(-S, 0.f) - l;
              if (DIAG) nsp = (ci + 32 < limA) ? nsp : 0.f; n1[e] = nsp; p1[i + e] = S + nsp; } }
        l0p[i >> 1] = pk_f16(n0[0], n0[1]); l1p[i >> 1] = pk_f16(n1[0], n1[1]); }
    const f16x8 l0a = __builtin_bit_cast(f16x8, (u32x4){l0p[0], l0p[1], l0p[2], l0p[3]}), l0b = __builtin_bit_cast(f16x8, (u32x4){l0p[4], l0p[5], l0p[6], l0p[7]});
    const f16x8 l1a = __builtin_bit_cast(f16x8, (u32x4){l1p[0], l1p[1], l1p[2], l1p[3]}), l1b = __builtin_bit_cast(f16x8, (u32x4){l1p[4], l1p[5], l1p[6], l1p[7]});
    f32x16 u1 = SB_MFMA_F16(ONES, l1a, carry); u1 = SB_MFMA_F16(ONES, l1b, u1);
    f32x16 y0 = SB_MFMA_F16(T0, l0a, u1); y0 = SB_MFMA_F16(T1, l0b, y0);
    f32x16 y1 = SB_MFMA_F16(T0, l1a, carry); y1 = SB_MFMA_F16(T1, l1b, y1);
    carry = SB_MFMA_F16(ONES, l0a, u1); carry = SB_MFMA_F16(ONES, l0b, carry);
    unsigned w0p[8], w1p[8];
#pragma unroll
    for (int i = 0; i < 16; i += 2) {
        float a[2], b[2];
#pragma unroll
        for (int e = 0; e < 2; ++e) { const int ci = ((i + e) & 3) + 8 * ((i + e) >> 2);
            a[e] = __builtin_amdgcn_exp2f(p0[i + e] + y0[i + e]); b[e] = __builtin_amdgcn_exp2f(p1[i + e] + y1[i + e]);
            if (DIAG) { a[e] = (ci < limA) ? a[e] : 0.f; b[e] = (ci + 32 < limA) ? b[e] : 0.f; } }
        w0p[i >> 1] = pk_bf16(a[0], a[1]); w1p[i >> 1] = pk_bf16(b[0], b[1]); }
    const bf16x8 pa0 = __builtin_bit_cast(bf16x8, (u32x4){w0p[0], w0p[1], w0p[2], w0p[3]}), pa1 = __builtin_bit_cast(bf16x8, (u32x4){w0p[4], w0p[5], w0p[6], w0p[7]});
    const bf16x8 pa2 = __builtin_bit_cast(bf16x8, (u32x4){w1p[0], w1p[1], w1p[2], w1p[3]}), pa3 = __builtin_bit_cast(bf16x8, (u32x4){w1p[4], w1p[5], w1p[6], w1p[7]});
    const lds_cptr vp = Vb + ((lane >> 4) & 1) * 32 + (lane & 3) * 8 + (4 * hi + ((lane & 15) >> 2)) * 64;
#pragma unroll
    for (int d0 = 0; d0 < 2; ++d0) {
        s16x4 lo[4], hh[4];
#pragma unroll
        for (int ks = 0; ks < 4; ++ks) { lo[ks] = vtr(vp + d0 * 4096 + ks * 1024); hh[ks] = vtr(vp + d0 * 4096 + ks * 1024 + 512); }
#define SB_PK(k) (bf16x8){lo[k][0], lo[k][1], lo[k][2], lo[k][3], hh[k][0], hh[k][1], hh[k][2], hh[k][3]}
        f32x16 o = d0 == 0 ? o0 : o1;
        o = SB_MFMA_BF16(pa0, SB_PK(0), o); o = SB_MFMA_BF16(pa1, SB_PK(1), o); o = SB_MFMA_BF16(pa2, SB_PK(2), o); o = SB_MFMA_BF16(pa3, SB_PK(3), o);
        if (d0 == 0) o0 = o; else o1 = o;
#undef SB_PK
    }
}
}

__device__ __forceinline__ void p7_attention_mfma(Frame& F) {
    using namespace sba;
    const bf16* QKV = (const bf16*)(F.ws + WS_QKV); bf16* MX = (bf16*)(F.ws + WS_MIX);
    const lds_ptr L = (lds_ptr)(F.lds + RING_OFF);
    const int lane = F.lane, r = lane & 31, hi = lane >> 5, w = F.wave;
    unsigned t0w[4], t1w[4];
#pragma unroll
    for (int jj = 0; jj < 4; ++jj) { const int j = 2 * jj; const int k0 = 8 * (j >> 2) + 4 * hi + (j & 3), k1 = k0 + 1;
        t0w[jj] = (k0 > r ? 0x3C00u : 0u) | (k1 > r ? 0x3C000000u : 0u); t1w[jj] = (k0 + 16 > r ? 0x3C00u : 0u) | (k1 + 16 > r ? 0x3C000000u : 0u); }
    const f16x8 T0 = __builtin_bit_cast(f16x8, (u32x4){t0w[0], t0w[1], t0w[2], t0w[3]}), T1 = __builtin_bit_cast(f16x8, (u32x4){t1w[0], t1w[1], t1w[2], t1w[3]});
    const f16x8 ONES = __builtin_bit_cast(f16x8, (u32x4){0x3C003C00u, 0x3C003C00u, 0x3C003C00u, 0x3C003C00u});
    const int limA = 32 * (w & 1) + r - 4 * hi;
    const int skv = F.tid & 63, sch = F.tid >> 6;
    const int kdst = sch * 1024 + skv * 16, vdst = 8192 + (sch >> 2) * 4096 + skv * 64 + (sch & 3) * 16;
    for (int u = F.vcu; u < 1024; u += F.G) {
        const int bh = (u & 255) >> 1, ii = (u >> 8) & 3, odd = u & 1;
        const int qb = odd ? (ii == 0 ? 1 : ii == 1 ? 6 : ii == 2 ? 2 : 5) : (ii == 0 ? 0 : ii == 1 ? 7 : ii == 2 ? 3 : 4);
        const int b = bh >> 3, h = bh & 7; const size_t rb = (size_t)b * SEQ;
        const bf16* kbase = QKV + rb * 1536 + 512 + h * 64 + sch * 8;
        bf16x8 qf[4];
        { const bf16* qp = QKV + (rb + 256 * qb + 32 * w + r) * 1536 + h * 64 + hi * 8;
#pragma unroll
          for (int d0 = 0; d0 < 4; ++d0) qf[d0] = *(const bf16x8*)(qp + d0 * 16); }
        f32x16 o0, o1, carry;
#pragma unroll
        for (int i = 0; i < 16; ++i) { o0[i] = 0.f; o1[i] = 0.f; carry[i] = 0.f; }
        const int ttd = 4 * qb + (w >> 1), ntile = 4 * qb + 4;
        __syncthreads();
        { const bf16* kp = kbase + (size_t)((ntile - 1) * KV + skv) * 1536; const v4u kr = *(const GAS v4u*)kp, vr = *(const GAS v4u*)(kp + 512);
          *(__attribute__((address_space(3))) v4u*)(L + kdst) = kr; *(__attribute__((address_space(3))) v4u*)(L + vdst) = vr; }
        __syncthreads();
        int cur = 0;
        for (int tt = ntile - 1; tt >= 0; --tt) {
            v4u kr, vr;
            if (tt > 0) { const bf16* kp = kbase + (size_t)((tt - 1) * KV + skv) * 1536; kr = *(const GAS v4u*)kp; vr = *(const GAS v4u*)(kp + 512); }
            const lds_cptr Kb = (lds_cptr)(L + cur * SLOT), Vb = Kb + 8192;
            if (tt < ttd) tile<false>(Kb, Vb, qf, o0, o1, carry, T0, T1, ONES, r, hi, lane, limA);
            else if (tt == ttd) tile<true>(Kb, Vb, qf, o0, o1, carry, T0, T1, ONES, r, hi, lane, limA);
            if (tt > 0) { *(__attribute__((address_space(3))) v4u*)(L + (cur ^ 1) * SLOT + kdst) = kr; *(__attribute__((address_space(3))) v4u*)(L + (cur ^ 1) * SLOT + vdst) = vr; }
            __syncthreads();
            cur ^= 1;
        }
        { bf16* op = MX + (rb + 256 * qb + 32 * w) * DM + 512 + h * 64 + r;
#pragma unroll
          for (int i = 0; i < 16; ++i) { const int q = (i & 3) + 8 * (i >> 2) + 4 * hi;
              op[(size_t)q * DM] = (bf16)f2bf(o0[i]); op[(size_t)q * DM + 32] = (bf16)f2bf(o1[i]); } }
    }
    __syncthreads();
}

__device__ __forceinline__ void p7_attention(Frame& F) {
    typedef float f4 __attribute__((ext_vector_type(4)));
    LAS f4* Ks = (LAS f4*)(F.lds + RING_OFF); LAS f4* Vs = Ks + 1024;
    const bf16* QKV = (const bf16*)(F.ws + WS_QKV); bf16* MX = (bf16*)(F.ws + WS_MIX);
    for (int u = F.vcu; u < 512; u += F.G) {
        const int bh = (u & 255) >> 1, q01 = u & 1, qq = (u >> 8) ? 3 - q01 : q01, b = bh >> 3, h = bh & 7;
        const int t = 512 * qq + F.tid; const size_t rb = (size_t)b * SEQ;
        float q[64], o[64];
        { const bf16* qp = QKV + (rb + t) * 1536 + h * 64;
#pragma unroll
          for (int c = 0; c < 8; ++c) unpack8(*(const GAS v4u*)(qp + c * 8), q + c * 8); }
#pragma unroll
        for (int d = 0; d < 64; ++d) o[d] = 0.f;
        float carry = 0.f;
        const int wave_tmax = 512 * qq + 64 * F.wave + 63;
        for (int tt = 8 * qq + 7; tt >= 0; --tt) {
            __syncthreads();
            { const int kk = F.tid >> 3, c8 = F.tid & 7; const bf16* kp = QKV + (rb + tt * 64 + kk) * 1536 + 512 + h * 64 + c8 * 8; float f[8];
              unpack8(*(const GAS v4u*)kp, f); Ks[kk * 16 + c8 * 2] = (f4){f[0], f[1], f[2], f[3]}; Ks[kk * 16 + c8 * 2 + 1] = (f4){f[4], f[5], f[6], f[7]};
              unpack8(*(const GAS v4u*)(kp + 512), f); Vs[kk * 16 + c8 * 2] = (f4){f[0], f[1], f[2], f[3]}; Vs[kk * 16 + c8 * 2 + 1] = (f4){f[4], f[5], f[6], f[7]}; }
            __syncthreads();
            if (tt * 64 < wave_tmax) {
                for (int s = 63; s >= 0; --s) {
                    float d0 = 0.f, d1 = 0.f;
#pragma unroll
                    for (int c = 0; c < 16; c += 2) { const f4 k0 = Ks[s * 16 + c], k1 = Ks[s * 16 + c + 1];
                        d0 += q[4 * c] * k0.x + q[4 * c + 1] * k0.y + q[4 * c + 2] * k0.z + q[4 * c + 3] * k0.w;
                        d1 += q[4 * c + 4] * k1.x + q[4 * c + 5] * k1.y + q[4 * c + 6] * k1.z + q[4 * c + 7] * k1.w; }
                    const float S = d0 + d1; const bool valid = (tt * 64 + s) < t;
                    const float e = __builtin_amdgcn_exp2f(-fabsf(S)), l = __builtin_amdgcn_logf(1.0f + e), nsp = fminf(-S, 0.f) - l, lb = S + nsp;
                    const float w = valid ? __builtin_amdgcn_exp2f(lb + carry) : 0.f; carry += valid ? nsp : 0.f;
#pragma unroll
                    for (int c = 0; c < 16; ++c) { const f4 v = Vs[s * 16 + c]; o[4 * c] += w * v.x; o[4 * c + 1] += w * v.y; o[4 * c + 2] += w * v.z; o[4 * c + 3] += w * v.w; }
                }
            }
        }
        { bf16* op = MX + (rb + t) * DM + 512 + h * 64;
#pragma unroll
          for (int c = 0; c < 8; ++c) *(GAS v4u*)(op + c * 8) = pack8(o + c * 8); }
    }
    __syncthreads();
}
__device__ __forceinline__ void p7_sgu_mfma(Frame& F) {
    typedef __attribute__((address_space(3))) unsigned short lds_u16;
    constexpr int PITCH = 136;
    LAS float* st = (LAS float*)(F.lds + RING_OFF); LAS unsigned char* VT = F.lds + RING_OFF + 1024;
    const bf16* UV = (const bf16*)(F.ws + WS_BIG); bf16* MX = (bf16*)(F.ws + WS_MIX); const bf16* WC = (const bf16*)(F.ws + WS_WSGU);
    const float* gam = F.in[10]; const float* bet = F.in[11]; const float* sb = F.in[13];
    const int lane = F.lane, w = F.wave, fr = lane & 15, fq = lane >> 4;
    for (int u = F.vcu; u < 256; u += F.G) {
        const size_t row0 = (size_t)(u >> 4) * SEQ + (size_t)(u & 15) * 128;
        __syncthreads();
        for (int i = 0; i < 16; ++i) { const int s = 16 * w + i; float f[8]; unpack8(*(const GAS v4u*)(UV + (row0 + s) * 1024 + 512 + lane * 8), f);
            float a = 0.f;
#pragma unroll
            for (int e = 0; e < 8; ++e) a += f[e];
            const float mean = wave_sum(a) * (1.0f / 512.0f); float qv = 0.f;
#pragma unroll
            for (int e = 0; e < 8; ++e) { const float d = f[e] - mean; qv += d * d; }
            const float rstd = 1.0f / sqrtf(wave_sum(qv) * (1.0f / 512.0f) + EPS);
            if (lane == 0) { st[s] = mean; st[128 + s] = rstd; } }
        __syncthreads();
        for (int g = 0; g < 4; ++g) {
            { const int s = 64 * (w & 1) + lane, cq = w >> 1; const float mean = st[s], rstd = st[128 + s];
#pragma unroll
              for (int j = 0; j < 4; ++j) { const int c0 = (4 * cq + j) * 8; float f[8]; unpack8(*(const GAS v4u*)(UV + (row0 + s) * 1024 + 512 + g * 128 + c0), f);
#pragma unroll
                  for (int e = 0; e < 8; ++e) { const float vn = (f[e] - mean) * rstd * gam[g * 128 + c0 + e] + bet[g * 128 + c0 + e];
                      *(lds_u16*)(VT + ((c0 + e) * PITCH + s) * 2) = (unsigned short)f2bf(vn); } } }
            __syncthreads();
            { pg8::f32x4 acc[8];
#pragma unroll
              for (int ct = 0; ct < 8; ++ct) acc[ct] = (pg8::f32x4){0.f, 0.f, 0.f, 0.f};
              const int t = 16 * w + fr; const bf16* wrow = WC + ((size_t)g * 128 + t) * 128 + 8 * fq;
              for (int ks = 0; ks <= (w >> 1); ++ks) {
                  const bf16x8 bfr = *(const bf16x8*)(wrow + 32 * ks);
#pragma unroll
                  for (int ct = 0; ct < 8; ++ct) { const bf16x8 afr = *(const LAS bf16x8*)(VT + ((16 * ct + fr) * PITCH + 32 * ks + 8 * fq) * 2);
                      acc[ct] = __builtin_amdgcn_mfma_f32_16x16x32_bf16(afr, bfr, acc[ct], 0, 0, 0); } }
              const float bias = sb[g * 128 + t]; const size_t ro = (row0 + t) * 1024 + g * 128 + 4 * fq;
#pragma unroll
              for (int ct = 0; ct < 8; ++ct) { const unsigned long long uu = *(const GAS unsigned long long*)(UV + ro + 16 * ct);
                  const float u0 = __builtin_bit_cast(float, (unsigned)(uu << 16)), u1 = __builtin_bit_cast(float, (unsigned)uu & 0xffff0000u), u2 = __builtin_bit_cast(float, (unsigned)(uu >> 32) << 16), u3 = __builtin_bit_cast(float, (unsigned)(uu >> 32) & 0xffff0000u);
                  const unsigned long long o = (unsigned long long)pk2(u0 * (acc[ct][0] + bias), u1 * (acc[ct][1] + bias)) | ((unsigned long long)pk2(u2 * (acc[ct][2] + bias), u3 * (acc[ct][3] + bias)) << 32);
                  *(GAS unsigned long long*)(MX + ro + 16 * ct) = o; } }
            __syncthreads();
        }
    }
}

__device__ __forceinline__ void p7_sgu(Frame& F) {
    LAS float* st = (LAS float*)(F.lds + RING_OFF); LAS float* VN = st + 256;
    const bf16* UV = (const bf16*)(F.ws + WS_BIG); bf16* MX = (bf16*)(F.ws + WS_MIX);
    const float* gam = F.in[10]; const float* bet = F.in[11]; const float* sw = F.in[12]; const float* sb = F.in[13];
    for (int u = F.vcu; u < 256; u += F.G) {
        const size_t row0 = (size_t)(u >> 4) * SEQ + (size_t)(u & 15) * 128;
        __syncthreads();
        for (int i = 0; i < 16; ++i) { const int s = 16 * F.wave + i; float f[8]; unpack8(*(const GAS v4u*)(UV + (row0 + s) * 1024 + 512 + F.lane * 8), f);
            float a = 0.f;
#pragma unroll
            for (int e = 0; e < 8; ++e) a += f[e];
            const float mean = wave_sum(a) * (1.0f / 512.0f); float qv = 0.f;
#pragma unroll
            for (int e = 0; e < 8; ++e) { const float d = f[e] - mean; qv += d * d; }
            const float rstd = 1.0f / sqrtf(wave_sum(qv) * (1.0f / 512.0f) + EPS);
            if (F.lane == 0) { st[s] = mean; st[128 + s] = rstd; } }
        __syncthreads();
        for (int g = 0; g < 4; ++g) {
            { const int s = F.tid >> 2, cq = F.tid & 3; const float mean = st[s], rstd = st[128 + s];
#pragma unroll
              for (int j = 0; j < 4; ++j) { const int c = cq * 32 + j * 8; float f[8]; unpack8(*(const GAS v4u*)(UV + (row0 + s) * 1024 + 512 + g * 128 + c), f);
#pragma unroll
                  for (int e = 0; e < 8; ++e) VN[s * 128 + c + e] = (f[e] - mean) * rstd * gam[g * 128 + c + e] + bet[g * 128 + c + e]; } }
            __syncthreads();
            { const int c = F.tid & 127, tq = F.tid >> 7;
              for (int i = 0; i < 32; ++i) { const int t = tq * 32 + i; const float* wr = sw + ((size_t)g * 128 + t) * 128; float a = 0.f;
                  for (int s = 0; s <= t; ++s) a += wr[s] * VN[s * 128 + c];
                  const float uu = bf2f(UV[(row0 + t) * 1024 + g * 128 + c]);
                  MX[(row0 + t) * DM + g * 128 + c] = (bf16)f2bf(uu * (a + sb[g * 128 + t])); } }
            __syncthreads();
        }
    }
}
__device__ __forceinline__ void p11_final(Frame& F) {
    const int gw = F.vcu * NWAVES + F.wave, NGW = F.G * NWAVES; const GAS f32x4* gr = (const GAS f32x4*)F.in[17] + F.lane;
    for (int m = gw; m < M; m += NGW) { GAS f32x4* xr = (GAS f32x4*)(F.out + (size_t)m * DM) + F.lane; f32x4 v[4]; float s = 0.f;
#pragma unroll
        for (int j = 0; j < 4; ++j) { v[j] = xr[64 * j]; s += (v[j].x * v[j].x + v[j].y * v[j].y) + (v[j].z * v[j].z + v[j].w * v[j].w); }
        const float rstd = 1.0f / sqrtf(wave_sum(s) * (1.f / DM) + EPS);
#pragma unroll
        for (int j = 0; j < 4; ++j) { const f32x4 g = gr[64 * j]; xr[64 * j] = (f32x4){v[j].x * rstd * g.x, v[j].y * rstd * g.y, v[j].z * rstd * g.z, v[j].w * rstd * g.w}; } }
}

struct Args { const float* in[18]; float* out; unsigned char* ws; int ph_lo, ph_hi, li, pad; };
__global__ void __launch_bounds__(NWAVES * 64, 2) trunk_fwd(Args args) {
    extern __shared__ __attribute__((aligned(16))) unsigned char lds[];
    Frame F;
    F.lds = (LAS unsigned char*)lds;
    F.MISC = (volatile LAS unsigned*)(F.lds + MISC_OFF);
    F.tid = threadIdx.x; F.lane = F.tid & 63; F.wave = __builtin_amdgcn_readfirstlane(F.tid >> 6);
    F.G = gridDim.x; { const int bx = blockIdx.x; F.vcu = (F.G % 8 == 0) ? (bx % 8) * (F.G / 8) + bx / 8 : bx; }
#pragma unroll
    for (int i = 0; i < 18; ++i) F.in[i] = args.in[i];
    F.out = args.out; F.ws = args.ws; F.ctl = (gu32*)(args.ws + WS_CTL);
    for (int u = F.tid; u < (LDS_BYTES - LDSCTL_OFF) / 4; u += NWAVES * 64) ((LAS unsigned*)(F.lds + LDSCTL_OFF))[u] = 0u;
    __syncthreads();
    XcdBarrier bar; bar.bar = (unsigned*)(F.ctl + CW_BAR); bar.x = 0; bar.st = nullptr;
    if (N_LAUNCHES == 1) bar = xcd_barrier_post((unsigned*)(F.ctl + CW_BAR), F.MISC + 8);
    const int lo = args.ph_lo, hi = args.ph_hi;
#define IN(k) (lo <= (k) && (k) < hi)
#define SEAM(k) do { if (IN(k) && IN((k) + 1)) xcd_barrier(bar); } while (0)
    bf16* XN = (bf16*)(F.ws + WS_XN); bf16* MIX = (bf16*)(F.ws + WS_MIX); bf16* BIG = (bf16*)(F.ws + WS_BIG); bf16* QKV = (bf16*)(F.ws + WS_QKV); float* SS = (float*)(F.ws + WS_SS);
    if (IN(0)) { p0_prologue(F); SEAM(0); }
    if (IN(1)) { pg8::Gemm g{XN, (const bf16*)(F.ws + WS_WABIN), M, AB_IN, DM}; pg8::StaticOrder S; S.init(M, AB_IN, F.G, (int)blockIdx.x);
        pg8::EpiStore E{BIG, AB_IN};
        pg8::gemm_phase<pg8::EpiStore, pg8::StaticOrder, true, true>(F.lds + RING_OFF, g, S, E); SEAM(1); }
    if (IN(2)) { p2_mixer_ab(F); SEAM(2); }
    if (IN(3)) { pg8::Gemm g{MIX, (const bf16*)(F.ws + WS_WABOUT), M, DM, DM}; pg8::StaticOrder S; S.init(M, DM, F.G, (int)blockIdx.x);
        pg8::EpiResid<true> E{F.in[0], F.out, XN, SS};
        pg8::gemm_phase<pg8::EpiResid<true>, pg8::StaticOrder, true, true>(F.lds + RING_OFF, g, S, E); SEAM(3); }
    if (IN(4)) { pg8::Gemm g{XN, (const bf16*)(F.ws + WS_W1), M, FF, DM}; pg8::StaticOrder S; S.init(M, FF, F.G, (int)blockIdx.x);
        pg8::EpiUp E{BIG, SS};
        pg8::gemm_phase<pg8::EpiUp, pg8::StaticOrder, true, true>(F.lds + RING_OFF, g, S, E); SEAM(4); }
    if (IN(5)) { pg8::Gemm g{BIG, (const bf16*)(F.ws + WS_W2), M, DM, FF}; pg8::StaticOrder S; S.init(M, DM, F.G, (int)blockIdx.x);
        pg8::EpiResid<true> E{F.out, F.out, XN, SS};
        pg8::gemm_phase<pg8::EpiResid<true>, pg8::StaticOrder, true, true>(F.lds + RING_OFF, g, S, E); SEAM(5); }
    if (IN(6)) { pg8::Gemm g{XN, (const bf16*)(F.ws + WS_WCDIN), M, CD_IN, DM}; pg8::StaticOrder S; S.init(M, CD_IN, F.G, (int)blockIdx.x);
        pg8::EpiCdIn E{BIG, QKV, SS, QSCALE};
        pg8::gemm_phase<pg8::EpiCdIn, pg8::StaticOrder, true, true>(F.lds + RING_OFF, g, S, E); SEAM(6); }
    if (IN(7)) { p7_attention_mfma(F); p7_sgu_mfma(F); SEAM(7); }
    if (IN(8)) { pg8::Gemm g{MIX, (const bf16*)(F.ws + WS_WCDOUT), M, DM, DM}; pg8::StaticOrder S; S.init(M, DM, F.G, (int)blockIdx.x);
        pg8::EpiResid<true> E{F.out, F.out, XN, SS};
        pg8::gemm_phase<pg8::EpiResid<true>, pg8::StaticOrder, true, true>(F.lds + RING_OFF, g, S, E); SEAM(8); }
    if (IN(9)) { pg8::Gemm g{XN, (const bf16*)(F.ws + WS_W1 + 8 * MiB), M, FF, DM}; pg8::StaticOrder S; S.init(M, FF, F.G, (int)blockIdx.x);
        pg8::EpiUp E{BIG, SS};
        pg8::gemm_phase<pg8::EpiUp, pg8::StaticOrder, true, true>(F.lds + RING_OFF, g, S, E); SEAM(9); }
    if (IN(10)) { pg8::Gemm g{BIG, (const bf16*)(F.ws + WS_W2 + 8 * MiB), M, DM, FF}; pg8::StaticOrder S; S.init(M, DM, F.G, (int)blockIdx.x);
        pg8::EpiResid<false> E{F.out, F.out, XN, SS};
        pg8::gemm_phase<pg8::EpiResid<false>, pg8::StaticOrder, true, true>(F.lds + RING_OFF, g, S, E); SEAM(10); }
    if (IN(11)) { p11_final(F); }
#undef IN
#undef SEAM
}

extern "C" void kernel_launch(void* const* d_in, const int* in_sizes, int n_in, void* d_out, int out_size, void* d_ws, size_t ws_size, hipStream_t stream) {
    static int grid = 0;
    if (grid == 0) {
        if (n_in != 18 || in_sizes[0] != M * DM || out_size != M * DM || ws_size < WS_END) { fprintf(stderr, "kernel_launch: unexpected shapes (n_in %d in0 %d out %d ws %zu); nothing launched\n", n_in, n_in > 0 ? in_sizes[0] : -1, out_size, ws_size); grid = -1; return; }
        int dev = 0, cus = 0, per_cu = 0;
        if (hipGetDevice(&dev) != hipSuccess || hipDeviceGetAttribute(&cus, hipDeviceAttributeMultiprocessorCount, dev) != hipSuccess) { grid = -1; return; }
        if (hipFuncSetAttribute((const void*)trunk_fwd, hipFuncAttributeMaxDynamicSharedMemorySize, LDS_BYTES) != hipSuccess) { fprintf(stderr, "kernel_launch: hipFuncSetAttribute failed\n"); grid = -1; return; }
        if (hipOccupancyMaxActiveBlocksPerMultiprocessor(&per_cu, (const void*)trunk_fwd, NWAVES * 64, LDS_BYTES) != hipSuccess || per_cu < 1) { fprintf(stderr, "kernel_launch: occupancy query reports %d workgroups per CU\n", per_cu); }
        (void)hipGetLastError();
        grid = cus;
    }
    if (grid < 0) return;
    if (hipMemsetAsync((char*)d_ws + WS_CTL, 0, CTL_ZERO_BYTES, stream) != hipSuccess) return;
    Args a{};
    for (int i = 0; i < 18; ++i) a.in[i] = (const float*)d_in[i];
    a.out = (float*)d_out; a.ws = (unsigned char*)d_ws;
    for (int li = 0; li < N_LAUNCHES; ++li) {
        a.ph_lo = (N_LAUNCHES == 1) ? 0 : li; a.ph_hi = (N_LAUNCHES == 1) ? N_PHASES : li + 1; a.li = li;
        hipLaunchKernelGGL(trunk_fwd, dim3(grid), dim3(NWAVES * 64), LDS_BYTES, stream, a);
    }
}
```

```cpp
#include <hip/hip_runtime.h>
#include <cstdio>
#include <cstdint>
namespace pg8 {
#define PG8_LAS __attribute__((address_space(3)))
typedef unsigned short bf16_t;
typedef short bf16x8 __attribute__((ext_vector_type(8)));
typedef float f32x4 __attribute__((ext_vector_type(4)));
typedef unsigned u32x4 __attribute__((ext_vector_type(4)));
constexpr int BM = 256, BK = 64, HALF = 128, HTB = HALF * BK * 2  , STAGE_BYTES = 8 * HTB, NXCD = 8, WGM = 8;

__host__ __device__ __forceinline__ int lds_byte(int r, int c) { const int st = (r >> 4) * 2 + (c >> 5), rr = r & 15, cc = c & 31, ob = rr * 64 + cc * 2; return st * 1024 + (ob ^ (((ob >> 9) & 1) << 5)); }
__host__ __device__ __forceinline__ void stage_rc(int b, int& R, int& C) { const int st = b / 1024, sb = b % 1024, swz = sb ^ (((sb >> 9) & 1) << 5); R = (st >> 1) * 16 + swz / 64; C = (st & 1) * 32 + (swz % 64) / 2; }
__host__ __device__ __forceinline__ int perm32(int rho) { const int n = rho >> 4, i = rho & 15; return 8 * (i >> 2) + 4 * n + (i & 3); }

struct Unit { int pm, pn; };
struct Gemm { const bf16_t* A; const bf16_t* Bt; int M, N, K; };

struct StaticOrder {
    int nM, nN, nwg, G, c;
    __host__ __device__ void init(int M, int N, int G_, int c_) { nM = M / BM; nN = N / BM; nwg = nM * nN; G = G_; c = c_; }
    __host__ __device__ bool next(int i, Unit& u) const {
        const long L = (long)i * G + c; if (L >= nwg) return false;
        int wgid = (int)L; { const int q = nwg / NXCD, r = nwg % NXCD, xcd = wgid % NXCD, off = wgid / NXCD; wgid = (xcd < r ? xcd * (q + 1) : r * (q + 1) + (xcd - r) * q) + off; }
        const int nig = WGM * nN, gid = wgid / nig, fm = gid * WGM, gsz = (nM - fm) < WGM ? (nM - fm) : WGM;
        u.pm = fm + ((wgid % nig) % gsz); u.pn = (wgid % nig) / gsz; return true;
    }
    __device__ __forceinline__ void a_ready(const Unit&) const {}
    __device__ __forceinline__ void done(const Unit&) const {}
};

__device__ __forceinline__ unsigned cvt_pk_bf16(float lo, float hi) { unsigned r; asm volatile("v_cvt_pk_bf16_f32 %0, %1, %2" : "=v"(r) : "v"(lo), "v"(hi)); return r; }
typedef float f32x2 __attribute__((ext_vector_type(2)));
__device__ __forceinline__ f32x2 gelu_pk(f32x2 v) {
    const f32x2 av = __builtin_elementwise_abs(v), d = av * 0.2316418882f + 1.0f;
    f32x2 t; t.x = __builtin_amdgcn_rcpf(d.x); t.y = __builtin_amdgcn_rcpf(d.y);
    f32x2 q = t * 0.5307027145f + (-0.7265760135f); q = q * t + 0.7107068705f; q = q * t + (-0.142248368f); q = q * t + 0.127414796f; q = q * t;
    const f32x2 s = (v * v) * (-0.72134752044f);
    f32x2 e; e.x = __builtin_amdgcn_exp2f(s.x); e.y = __builtin_amdgcn_exp2f(s.y);
    const f32x2 m = v * (q * e), r = v - m;
    f32x2 o; o.x = v.x < 0.f ? m.x : r.x; o.y = v.y < 0.f ? m.y : r.y; return o;
}
typedef unsigned u32x2 __attribute__((ext_vector_type(2)));
struct EpiStore {
    static constexpr bool PERM = true, AFTER_DRAIN = false;
    bf16_t* O; int ldc;
    __device__ __forceinline__ void operator()(const f32x4 (&acc)[2][2][4][2], const Unit& u, int wr, int wc, int fr, int fq) const {
        const int row0 = u.pm * BM + wr * 64 + fr, col0 = u.pn * BM + wc * 32 + 8 * fq;
#pragma unroll
        for (int ai = 0; ai < 2; ++ai)
#pragma unroll
            for (int m = 0; m < 4; ++m) { bf16_t* rowp = O + (size_t)(row0 + ai * HALF + m * 16) * ldc + col0;
#pragma unroll
                for (int bj = 0; bj < 2; ++bj) { const f32x4 v0 = acc[ai][bj][m][0], v1 = acc[ai][bj][m][1];
                    u32x4 w; w.x = cvt_pk_bf16(v0[0], v0[1]); w.y = cvt_pk_bf16(v0[2], v0[3]); w.z = cvt_pk_bf16(v1[0], v1[1]); w.w = cvt_pk_bf16(v1[2], v1[3]);
                    *(u32x4*)(rowp + bj * HALF) = w; } }
    }
};
__device__ __forceinline__ float bflo(unsigned w) { return __builtin_bit_cast(float, w << 16); }
__device__ __forceinline__ float bfhi(unsigned w) { return __builtin_bit_cast(float, w & 0xffff0000u); }
template <bool XF32, bool WRITE_SS> struct EpiResid {
    static constexpr bool PERM = true, AFTER_DRAIN = false;
    const float* xf; bf16_t* hb; float* ss;
    __device__ __forceinline__ void operator()(const f32x4 (&acc)[2][2][4][2], const Unit& u, int wr, int wc, int fr, int fq) const {
        const int row0 = u.pm * BM + wr * 64 + fr, col0 = u.pn * BM + wc * 32 + 8 * fq;
#pragma unroll
        for (int ai = 0; ai < 2; ++ai) {
            f32x4 b[4][2][2];
            if (XF32) {
#pragma unroll
                for (int m = 0; m < 4; ++m)
#pragma unroll
                    for (int bj = 0; bj < 2; ++bj) { const float* p = xf + (size_t)(row0 + ai * HALF + m * 16) * 1024 + col0 + bj * HALF; b[m][bj][0] = *(const f32x4*)p; b[m][bj][1] = *(const f32x4*)(p + 4); }
            } else {
#pragma unroll
                for (int m = 0; m < 4; ++m)
#pragma unroll
                    for (int bj = 0; bj < 2; ++bj) { const u32x4 w = *(const u32x4*)(hb + (size_t)(row0 + ai * HALF + m * 16) * 1024 + col0 + bj * HALF);
                        b[m][bj][0] = (f32x4){bflo(w.x), bfhi(w.x), bflo(w.y), bfhi(w.y)}; b[m][bj][1] = (f32x4){bflo(w.z), bfhi(w.z), bflo(w.w), bfhi(w.w)}; }
            }
#pragma unroll
            for (int m = 0; m < 4; ++m) { const int row = row0 + ai * HALF + m * 16; float s = 0.f;
#pragma unroll
                for (int bj = 0; bj < 2; ++bj) { const f32x4 v0 = b[m][bj][0] + acc[ai][bj][m][0], v1 = b[m][bj][1] + acc[ai][bj][m][1];
                    u32x4 w; w.x = cvt_pk_bf16(v0[0], v0[1]); w.y = cvt_pk_bf16(v0[2], v0[3]); w.z = cvt_pk_bf16(v1[0], v1[1]); w.w = cvt_pk_bf16(v1[2], v1[3]);
                    *(u32x4*)(hb + (size_t)row * 1024 + col0 + bj * HALF) = w;
                    if (WRITE_SS) s += ((v0[0] * v0[0] + v0[1] * v0[1]) + (v0[2] * v0[2] + v0[3] * v0[3])) + ((v1[0] * v1[0] + v1[1] * v1[1]) + (v1[2] * v1[2] + v1[3] * v1[3])); }
                if (WRITE_SS) { s += __shfl_xor(s, 16); s += __shfl_xor(s, 32); if (fq == 0) ss[(size_t)row * 16 + u.pn * 4 + wc] = s; } }
            asm volatile("" ::: "memory");
        }
    }
};
__device__ __forceinline__ void rows_rstd(const float* ss, int row0, int fq, float (&rs)[2][4]) {
    f32x4 p[2][4];
#pragma unroll
    for (int ai = 0; ai < 2; ++ai)
#pragma unroll
        for (int m = 0; m < 4; ++m) p[ai][m] = *(const f32x4*)(ss + (size_t)(row0 + ai * HALF + m * 16) * 16 + 4 * fq);
#pragma unroll
    for (int ai = 0; ai < 2; ++ai)
#pragma unroll
        for (int m = 0; m < 4; ++m) { float s = (p[ai][m][0] + p[ai][m][1]) + (p[ai][m][2] + p[ai][m][3]); s += __shfl_xor(s, 16); s += __shfl_xor(s, 32); rs[ai][m] = 1.0f / sqrtf(s * (1.0f / 1024.0f) + 1e-6f); }
}
struct EpiUp {
    static constexpr bool PERM = true, AFTER_DRAIN = false;
    bf16_t* O; const float* ss;
    __device__ __forceinline__ void operator()(const f32x4 (&acc)[2][2][4][2], const Unit& u, int wr, int wc, int fr, int fq) const {
        const int row0 = u.pm * BM + wr * 64 + fr, col0 = u.pn * BM + wc * 32 + 8 * fq;
        float rs[2][4]; rows_rstd(ss, row0, fq, rs);
#pragma unroll
        for (int ai = 0; ai < 2; ++ai)
#pragma unroll
            for (int m = 0; m < 4; ++m) { const int row = row0 + ai * HALF + m * 16; const float r = rs[ai][m];
                bf16_t* rowp = O + (size_t)row * 4096 + col0;
#pragma unroll
                for (int bj = 0; bj < 2; ++bj) { f32x4 v0 = acc[ai][bj][m][0] * r, v1 = acc[ai][bj][m][1] * r;
#pragma unroll
                    for (int e = 0; e < 4; ++e) { const float a = fmaxf(v0[e], 0.f), b = fmaxf(v1[e], 0.f); v0[e] = a * a; v1[e] = b * b; }
                    u32x4 w; w.x = cvt_pk_bf16(v0[0], v0[1]); w.y = cvt_pk_bf16(v0[2], v0[3]); w.z = cvt_pk_bf16(v1[0], v1[1]); w.w = cvt_pk_bf16(v1[2], v1[3]);
                    *(u32x4*)(rowp + bj * HALF) = w; } }
    }
};
struct EpiCdIn {
    static constexpr bool PERM = true, AFTER_DRAIN = false;
    bf16_t* UV; bf16_t* QKV; const float* ss; float qscale;
    __device__ __forceinline__ void operator()(const f32x4 (&acc)[2][2][4][2], const Unit& u, int wr, int wc, int fr, int fq) const {
        const int row0 = u.pm * BM + wr * 64 + fr; const bool isuv = u.pn < 4;
        const int colt = isuv ? u.pn * BM : (u.pn - 4) * BM; const int ldc = isuv ? 1024 : 1536; bf16_t* base = isuv ? UV : QKV;
        const float sc = (!isuv && u.pn < 6) ? qscale : 1.0f;
        const int col0 = colt + wc * 32 + 8 * fq;
        float rs[2][4]; rows_rstd(ss, row0, fq, rs);
#pragma unroll
        for (int ai = 0; ai < 2; ++ai)
#pragma unroll
            for (int m = 0; m < 4; ++m) { const int row = row0 + ai * HALF + m * 16; const float r = rs[ai][m] * sc;
                bf16_t* rowp = base + (size_t)row * ldc + col0;
#pragma unroll
                for (int bj = 0; bj < 2; ++bj) { f32x4 v0 = acc[ai][bj][m][0] * r, v1 = acc[ai][bj][m][1] * r;
                    if (isuv) { f32x2 a = gelu_pk((f32x2){v0[0], v0[1]}), b = gelu_pk((f32x2){v0[2], v0[3]}), c = gelu_pk((f32x2){v1[0], v1[1]}), d = gelu_pk((f32x2){v1[2], v1[3]});
                        v0 = (f32x4){a.x, a.y, b.x, b.y}; v1 = (f32x4){c.x, c.y, d.x, d.y}; }
                    u32x4 w; w.x = cvt_pk_bf16(v0[0], v0[1]); w.y = cvt_pk_bf16(v0[2], v0[3]); w.z = cvt_pk_bf16(v1[0], v1[1]); w.w = cvt_pk_bf16(v1[2], v1[3]);
                    *(u32x4*)(rowp + bj * HALF) = w; } }
    }
};
template <class Epi, class Sched, bool ALIGN_EPI = false, bool SP2 = false>
__device__ __forceinline__ void gemm_phase(PG8_LAS unsigned char* lds, const Gemm g, const Sched& S, const Epi& E) {
    const int tid = threadIdx.x, wid = __builtin_amdgcn_readfirstlane(tid >> 6), lane = tid & 63, wr = wid >> 2, wc = wid & 3, fr = lane & 15, fq = lane >> 4;
    const int K = g.K, nt = K / BK;
    unsigned voffA[2], voffB[2];
#pragma unroll
    for (int i = 0; i < 2; ++i) { int R, C; stage_rc(tid * 16 + i * 8192, R, C); const int Rb = Epi::PERM ? ((R & ~31) + perm32(R & 31)) : R;
        voffA[i] = (unsigned)(R * K + C) * 2u; voffB[i] = (unsigned)(Rb * K + C) * 2u; }
    const size_t kstep = (size_t)(BK * 2);
    const size_t hstep = (size_t)HALF * K * 2;
    const size_t tstep = 2 * hstep;
    const unsigned ldsw = (unsigned)wid * 1024u;
    const int aoff = lds_byte(wr * 64 + fr, fq * 8), boff = lds_byte(wc * 32 + fr, fq * 8);
#define PG8_SA(b, h) (((b) * 2 + (h)) * HTB)
#define PG8_SB(b, h) ((4 + (b) * 2 + (h)) * HTB)
#define PG8_STAGE(bufoff, gbase, voff) do { _Pragma("unroll") for (int _i = 0; _i < 2; ++_i) \
        __builtin_amdgcn_global_load_lds((const unsigned*)((const char*)(gbase) + (voff)[_i]), (PG8_LAS unsigned*)(lds + (bufoff) + ldsw + _i * 8192), 16, 0, 0); } while (0)
#define PG8_LDA(dst, b, h) do { _Pragma("unroll") for (int m = 0; m < 4; ++m) _Pragma("unroll") for (int k = 0; k < 2; ++k) dst[m][k] = *(const PG8_LAS bf16x8*)(lds + PG8_SA(b, h) + aoff + m * 2048 + k * 1024); } while (0)
#define PG8_LDB(dst, b, h) do { _Pragma("unroll") for (int n = 0; n < 2; ++n) _Pragma("unroll") for (int k = 0; k < 2; ++k) dst[n][k] = *(const PG8_LAS bf16x8*)(lds + PG8_SB(b, h) + boff + n * 2048 + k * 1024); } while (0)
#define PG8_MMA(ai, bj, At, Bt) do { __builtin_amdgcn_s_setprio(1); _Pragma("unroll") for (int m = 0; m < 4; ++m) _Pragma("unroll") for (int n = 0; n < 2; ++n) _Pragma("unroll") for (int k = 0; k < 2; ++k) \
        acc[ai][bj][m][n] = __builtin_amdgcn_mfma_f32_16x16x32_bf16(Bt[n][k], At[m][k], acc[ai][bj][m][n], 0, 0, 0); __builtin_amdgcn_s_setprio(0); } while (0)
#define PG8_WAIT_V(n) asm volatile("s_waitcnt vmcnt(" #n ")" ::: "memory")
#define PG8_WAIT_L(n) asm volatile("s_waitcnt lgkmcnt(" #n ")" ::: "memory")
#define PG8_BAR __builtin_amdgcn_s_barrier()
#define PG8_SCHED __builtin_amdgcn_sched_barrier(0)
    Unit cur, nxt; int ui = 0;
    if (!S.next(0, cur)) return;
    f32x4 acc[2][2][4][2];
#pragma unroll
    for (int a = 0; a < 2; ++a)
#pragma unroll
        for (int b = 0; b < 2; ++b)
#pragma unroll
            for (int m = 0; m < 4; ++m)
#pragma unroll
                for (int n = 0; n < 2; ++n) acc[a][b][m][n] = (f32x4){0.f, 0.f, 0.f, 0.f};
    bf16x8 At[4][2], B0[2][2], B1[2][2];
    const char* cA = (const char*)g.A + (size_t)cur.pm * tstep; const char* cB = (const char*)g.Bt + (size_t)cur.pn * tstep;
    S.a_ready(cur);
    if constexpr (SP2) {
        PG8_STAGE(PG8_SB(0, 0), cB, voffB); PG8_STAGE(PG8_SB(0, 1), cB + hstep, voffB); PG8_STAGE(PG8_SA(0, 0), cA, voffA); PG8_STAGE(PG8_SA(0, 1), cA + hstep, voffA);
        if (wr == 1) PG8_BAR;
        PG8_WAIT_V(2); PG8_BAR;
        PG8_STAGE(PG8_SB(1, 0), cB + kstep, voffB); PG8_STAGE(PG8_SA(1, 0), cA + kstep, voffA); PG8_STAGE(PG8_SB(1, 1), cB + hstep + kstep, voffB);
        PG8_WAIT_V(6); PG8_BAR;
    } else {
        PG8_STAGE(PG8_SB(0, 0), cB, voffB); PG8_STAGE(PG8_SA(0, 0), cA, voffA); PG8_STAGE(PG8_SB(0, 1), cB + hstep, voffB); PG8_STAGE(PG8_SA(0, 1), cA + hstep, voffA);
        if (wr == 1) PG8_BAR;
        PG8_WAIT_V(4); PG8_BAR;
        PG8_STAGE(PG8_SB(1, 0), cB + kstep, voffB); PG8_STAGE(PG8_SA(1, 0), cA + kstep, voffA); PG8_STAGE(PG8_SB(1, 1), cB + hstep + kstep, voffB);
        PG8_WAIT_V(6); PG8_BAR;
    }
    for (;;) {
        const bool has_next = S.next(ui + 1, nxt);
        const char* nA = has_next ? (const char*)g.A + (size_t)nxt.pm * tstep : cA; const char* nB = has_next ? (const char*)g.Bt + (size_t)nxt.pn * tstep : cB;
        for (int t = 0; t < nt; t += 2) {
            const bool last = (t == nt - 2);
            const char* a1 = cA + (size_t)(t + 1) * kstep;
            const char* a2 = last ? nA : cA + (size_t)(t + 2) * kstep; const char* b2 = last ? nB : cB + (size_t)(t + 2) * kstep;
            const char* a3 = a2 + kstep; const char* b3 = b2 + kstep;
            if (last && has_next) S.a_ready(nxt);
            if constexpr (SP2) {
            PG8_LDB(B0, 0, 0); PG8_LDB(B1, 0, 1); PG8_SCHED; PG8_LDA(At, 0, 0); PG8_STAGE(PG8_SA(1, 1), a1 + hstep, voffA);
            PG8_WAIT_V(8); PG8_WAIT_L(0); PG8_BAR; PG8_MMA(0, 0, At, B0); PG8_MMA(0, 1, At, B1); PG8_BAR; PG8_SCHED;
            PG8_LDA(At, 0, 1); PG8_STAGE(PG8_SB(0, 0), b2, voffB); PG8_STAGE(PG8_SB(0, 1), b2 + hstep, voffB); PG8_STAGE(PG8_SA(0, 0), a2, voffA);
            PG8_WAIT_V(8); PG8_WAIT_L(0); PG8_BAR; PG8_MMA(1, 0, At, B0); PG8_MMA(1, 1, At, B1); PG8_BAR; PG8_SCHED;
            PG8_LDB(B0, 1, 0); PG8_LDB(B1, 1, 1); PG8_SCHED; PG8_LDA(At, 1, 0); PG8_STAGE(PG8_SA(0, 1), a2 + hstep, voffA);
            PG8_WAIT_V(8); PG8_WAIT_L(0); PG8_BAR; PG8_MMA(0, 0, At, B0); PG8_MMA(0, 1, At, B1); PG8_BAR; PG8_SCHED;
            PG8_LDA(At, 1, 1); PG8_STAGE(PG8_SB(1, 0), b3, voffB); PG8_STAGE(PG8_SB(1, 1), b3 + hstep, voffB); PG8_STAGE(PG8_SA(1, 0), a3, voffA);
            PG8_WAIT_V(8); PG8_WAIT_L(0); PG8_BAR; PG8_MMA(1, 0, At, B0); PG8_MMA(1, 1, At, B1); PG8_BAR; PG8_SCHED;
            } else {
            PG8_LDB(B0, 0, 0); PG8_SCHED; PG8_LDA(At, 0, 0); PG8_STAGE(PG8_SA(1, 1), a1 + hstep, voffA);
            PG8_WAIT_L(8); PG8_BAR; PG8_WAIT_L(0); PG8_MMA(0, 0, At, B0); PG8_BAR; PG8_SCHED;
            PG8_LDB(B1, 0, 1); PG8_STAGE(PG8_SB(0, 0), b2, voffB);
            PG8_BAR; PG8_WAIT_L(0); PG8_MMA(0, 1, At, B1); PG8_BAR;
            PG8_LDA(At, 0, 1); PG8_STAGE(PG8_SA(0, 0), a2, voffA);
            PG8_BAR; PG8_WAIT_L(0); PG8_MMA(1, 0, At, B0); PG8_BAR; PG8_SCHED;
            PG8_STAGE(PG8_SB(0, 1), b2 + hstep, voffB);
            PG8_WAIT_V(6); PG8_BAR; PG8_MMA(1, 1, At, B1); PG8_BAR;
            PG8_LDB(B0, 1, 0); PG8_SCHED; PG8_LDA(At, 1, 0); PG8_STAGE(PG8_SA(0, 1), a2 + hstep, voffA);
            PG8_WAIT_L(8); PG8_BAR; PG8_WAIT_L(0); PG8_MMA(0, 0, At, B0); PG8_BAR; PG8_SCHED;
            PG8_LDB(B1, 1, 1); PG8_STAGE(PG8_SB(1, 0), b3, voffB);
            PG8_BAR; PG8_WAIT_L(0); PG8_MMA(0, 1, At, B1); PG8_BAR;
            PG8_LDA(At, 1, 1); PG8_STAGE(PG8_SA(1, 0), a3, voffA);
            PG8_BAR; PG8_WAIT_L(0); PG8_MMA(1, 0, At, B0); PG8_BAR; PG8_SCHED;
            PG8_STAGE(PG8_SB(1, 1), b3 + hstep, voffB);
            PG8_WAIT_V(6); PG8_BAR; PG8_MMA(1, 1, At, B1); PG8_BAR;
            }
        }
        if constexpr (ALIGN_EPI) { if (wr == 0) PG8_BAR; }
        if constexpr (!Epi::AFTER_DRAIN) { E(acc, cur, wr, wc, fr, fq); S.done(cur); }
        if (!has_next) break;
#pragma unroll
        for (int a = 0; a < 2; ++a)
#pragma unroll
            for (int b = 0; b < 2; ++b)
#pragma unroll
                for (int m = 0; m < 4; ++m)
#pragma unroll
                    for (int n = 0; n < 2; ++n) acc[a][b][m][n] = (f32x4){0.f, 0.f, 0.f, 0.f};
        cur = nxt; cA = nA; cB = nB; ++ui;
        if constexpr (ALIGN_EPI) { if (wr == 1) PG8_BAR; }
    }
    PG8_WAIT_V(0);
    if constexpr (!ALIGN_EPI) { if (wr == 0) PG8_BAR; }
    PG8_BAR;
    if constexpr (Epi::AFTER_DRAIN) { E.fused(acc, cur, wr, wc, fr, fq, lds, wid, lane); S.done(cur); }
#undef PG8_SA
#undef PG8_SB
#undef PG8_STAGE
#undef PG8_LDA
#undef PG8_LDB
#undef PG8_MMA
#undef PG8_WAIT_V
#undef PG8_WAIT_L
#undef PG8_BAR
#undef PG8_SCHED
}
}
constexpr int NWAVES = 8;
#ifndef PROBE_REPEAT
#define PROBE_REPEAT -1
#endif
#ifndef MK_N_LAUNCHES
#define MK_N_LAUNCHES 1
#endif
constexpr int N_PHASES = 12;
constexpr int N_LAUNCHES = MK_N_LAUNCHES;
constexpr int BATCH = 16, SEQ = 2048, DM = 1024, M = BATCH * SEQ, FF = 4096, AB_IN = 2048, CD_IN = 2560;
constexpr float EPS = 1e-6f;
constexpr float QSCALE = 0.125f * 1.4426950408889634f;
constexpr size_t MiB = 1u << 20;
constexpr size_t WS_CTL = 0, CTL_ZERO_BYTES = 1 * MiB;
constexpr size_t WS_WABIN = 2 * MiB, WS_WABOUT = 6 * MiB, WS_W1 = 8 * MiB  , WS_W2 = 24 * MiB  , WS_WCDIN = 40 * MiB, WS_WCDOUT = 46 * MiB, WS_WSGU = 48 * MiB;
constexpr size_t WS_TMPF = 50 * MiB;
constexpr size_t WS_SS = 52 * MiB;
constexpr size_t WS_XN = 56 * MiB;
constexpr size_t WS_MIX = 120 * MiB;
constexpr size_t WS_BIG = 184 * MiB;
constexpr size_t WS_QKV = WS_BIG + 64 * MiB;
constexpr size_t WS_END = 440 * MiB;
constexpr int CW_BAR = 4096;
constexpr int RING_OFF = 0, RING_BYTES = 131072;
constexpr int LDSCTL_OFF = RING_BYTES, MISC_OFF = LDSCTL_OFF + 320;
constexpr int LDS_BYTES = 147456;
#define GAS __attribute__((address_space(1)))
#define LAS __attribute__((address_space(3)))
typedef unsigned short bf16;
typedef unsigned v4u __attribute__((ext_vector_type(4)));
typedef float f32x4 __attribute__((ext_vector_type(4)));
typedef short bf16x8 __attribute__((ext_vector_type(8)));
typedef GAS unsigned gu32;
typedef GAS unsigned long long gu64;
#define RLX_AGENT __ATOMIC_RELAXED, __HIP_MEMORY_SCOPE_AGENT
#define LDS_WAIT() asm volatile("s_waitcnt lgkmcnt(0)" ::: "memory")
#define VM_WAIT() asm volatile("s_waitcnt vmcnt(0)" ::: "memory")
__device__ __forceinline__ unsigned long long rt() { return __builtin_amdgcn_s_memrealtime(); }
__device__ __forceinline__ unsigned f2bf(float f) { unsigned u = __builtin_bit_cast(unsigned, f); return (u + 0x7fffu + ((u >> 16) & 1u)) >> 16; }
__device__ __forceinline__ unsigned pk2(float lo, float hi) { return f2bf(lo) | (f2bf(hi) << 16); }
#define XB_TMO      128
#define XB_XCNT(j)  (256  + 64 * (j))
#define XB_XSUB(j)  (1280 + 64 * (j))
#define XB_XGEN(j)  (2304 + 64 * (j))
#define XB_TOP      3328
#define XB_TOPGEN   3392
#define XCD_BAR_WORDS 3456
#define XB_SPIN_CAP (1u << 18)

__device__ __forceinline__ unsigned xb_ld(unsigned* p)              { return __hip_atomic_load(p, __ATOMIC_RELAXED, __HIP_MEMORY_SCOPE_AGENT); }
__device__ __forceinline__ unsigned xb_add(unsigned* p, unsigned v) { return __hip_atomic_fetch_add(p, v, __ATOMIC_RELAXED, __HIP_MEMORY_SCOPE_AGENT); }
__device__ __forceinline__ unsigned xb_xcc_id() { return (unsigned)__builtin_amdgcn_s_getreg((3 << 11) | 20) & 0xFu; }
#define XB_SPIN(cond, bar) do { unsigned _sp = 0; while (cond) { __builtin_amdgcn_s_sleep(1); \
    if ((++_sp & 255u) == 0u) { if (xb_ld(&(bar)[XB_TMO])) break; if (_sp > XB_SPIN_CAP) { atomicAdd(&(bar)[XB_TMO], 1u); break; } } } } while (0)

struct XcdBarrier {
    unsigned* bar; unsigned x;
    volatile LAS unsigned* st;
};

__device__ __forceinline__ XcdBarrier xcd_barrier_post(unsigned* bar, volatile LAS unsigned* st) {
    XcdBarrier b; b.bar = bar; b.x = xb_xcc_id(); b.st = st;
    if (threadIdx.x == 0) (void)xb_add(&bar[XB_XCNT(b.x)], 1u);
    return b;
}
__device__ __forceinline__ void xcd_barrier_complete(unsigned* bar, unsigned x, unsigned& nloc, unsigned& nx) {
    const unsigned G = gridDim.x * gridDim.y * gridDim.z;
    unsigned sum, cnt, mine, sp = 0u;
    for (;;) {
        sum = 0u; cnt = 0u; mine = 0u;
#pragma unroll
        for (unsigned j = 0; j < 16; ++j) { const unsigned c = xb_ld(&bar[XB_XCNT(j)]); sum += c; cnt += (c > 0u) ? 1u : 0u; mine = (j == x) ? c : mine; }
        if (sum == G) break;
        __builtin_amdgcn_s_sleep(1);
        if ((++sp & 255u) == 0u) { if (xb_ld(&bar[XB_TMO])) break; if (sp > XB_SPIN_CAP) { atomicAdd(&bar[XB_TMO], 1u); break; } }
    }
    nloc = mine > 0u ? mine : 1u; nx = cnt > 0u ? cnt : 1u;
}

__device__ __forceinline__ void xcd_barrier(const XcdBarrier& b) {
    asm volatile("s_waitcnt vmcnt(0)" ::: "memory");
    __syncthreads();
    if (threadIdx.x == 0) {
        unsigned* bar = b.bar;
        __builtin_amdgcn_s_waitcnt(0);
        unsigned nloc = b.st[0], nx = b.st[1];
        if (nloc == 0u) { xcd_barrier_complete(bar, b.x, nloc, nx); b.st[0] = nloc; b.st[1] = nx; }
        const unsigned old = xb_add(&bar[XB_XSUB(b.x)], 1u);
        const unsigned gen = old / nloc;
        if (old + 1u == (gen + 1u) * nloc) {
            __builtin_amdgcn_fence(__ATOMIC_RELEASE, "agent");
            asm volatile("s_waitcnt vmcnt(0)" ::: "memory");
            const unsigned og = xb_add(&bar[XB_TOP], 1u);
            const unsigned tg = og / nx;
            if (og + 1u == (tg + 1u) * nx) xb_add(&bar[XB_TOPGEN], 1u);
            else XB_SPIN(xb_ld(&bar[XB_TOPGEN]) == tg, bar);
            __builtin_amdgcn_fence(__ATOMIC_ACQUIRE, "agent");
            xb_add(&bar[XB_XGEN(b.x)], 1u);
            asm volatile("s_waitcnt vmcnt(0)" ::: "memory");
        } else {
            XB_SPIN(xb_ld(&bar[XB_XGEN(b.x)]) == gen, bar);
            __builtin_amdgcn_fence(__ATOMIC_ACQUIRE, "agent");
            asm volatile("s_waitcnt vmcnt(0)" ::: "memory");
        }
    }
    __syncthreads();
}
struct Frame {
    LAS unsigned char* lds;
    volatile LAS unsigned* MISC;
    gu32* ctl;
    int tid, lane, wave;
    int vcu, G;
    const float* in[18]; float* out; unsigned char* ws;
};
__device__ __forceinline__ float bf2f(unsigned short b) { return __builtin_bit_cast(float, (unsigned)b << 16); }
__device__ __forceinline__ float wave_sum(float v) {
#pragma unroll
    for (int o = 1; o < 64; o <<= 1) v += __shfl_xor(v, o);
    return v;
}
__device__ __forceinline__ void unpack8(const v4u r, float* f) {
    f[0] = __builtin_bit_cast(float, r.x << 16); f[1] = __builtin_bit_cast(float, r.x & 0xffff0000u);
    f[2] = __builtin_bit_cast(float, r.y << 16); f[3] = __builtin_bit_cast(float, r.y & 0xffff0000u);
    f[4] = __builtin_bit_cast(float, r.z << 16); f[5] = __builtin_bit_cast(float, r.z & 0xffff0000u);
    f[6] = __builtin_bit_cast(float, r.w << 16); f[7] = __builtin_bit_cast(float, r.w & 0xffff0000u);
}
__device__ __forceinline__ v4u pack8(const float* f) { v4u o; o.x = pk2(f[0], f[1]); o.y = pk2(f[2], f[3]); o.z = pk2(f[4], f[5]); o.w = pk2(f[6], f[7]); return o; }

__device__ __forceinline__ void transpose_item(const float* W, const float* gk, int K, int N, bf16* WT, LAS float* scr, int item, int lane) {
    const int nblk = N / 32, kb = item / nblk, nb = item % nblk, k0 = 64 * kb, n0 = 32 * nb;
#pragma unroll 8
    for (int i = 0; i < 32; ++i) { const int kk = 2 * i + (lane >> 5); const float g = gk ? gk[k0 + kk] : 1.0f; scr[kk * 33 + (lane & 31)] = W[(size_t)(k0 + kk) * N + n0 + (lane & 31)] * g; }
    LDS_WAIT(); asm volatile("" ::: "memory");
    const int c = lane & 7;
#pragma unroll
    for (int j = 0; j < 4; ++j) { const int n = (lane >> 3) + 8 * j; const LAS float* s = scr + (8 * c) * 33 + n;
        v4u o; o.x = pk2(s[0 * 33], s[1 * 33]); o.y = pk2(s[2 * 33], s[3 * 33]); o.z = pk2(s[4 * 33], s[5 * 33]); o.w = pk2(s[6 * 33], s[7 * 33]);
        *(GAS v4u*)(WT + (size_t)(n0 + n) * K + k0 + 8 * c) = o; }
    LDS_WAIT(); asm volatile("" ::: "memory");
}

__device__ __forceinline__ void p0_prologue(Frame& F) {
    LAS float* scr = (LAS float*)(F.lds + RING_OFF + F.wave * 16384);
    const int gw = F.vcu * NWAVES + F.wave, NGW = F.G * NWAVES;
    const float* mixg = F.in[1]; const float* mlpg = F.in[2];
    constexpr int I_ABIN = (DM / 64) * (AB_IN / 32), I_W1 = (DM / 64) * (FF / 32), I_W2 = (FF / 64) * (DM / 32), I_CDIN = (DM / 64) * (CD_IN / 32), I_CDOUT = (DM / 64) * (DM / 32);
    constexpr int NITEMS = I_ABIN + 2 * I_W1 + 2 * I_W2 + I_CDIN + I_CDOUT;
    for (int it = gw; it < NITEMS; it += NGW) {
        int r = it;
        if (r < I_ABIN) { transpose_item(F.in[3], nullptr, DM, AB_IN, (bf16*)(F.ws + WS_WABIN), scr, r, F.lane); continue; } r -= I_ABIN;
        if (r < I_W1) { transpose_item(F.in[15], mlpg, DM, FF, (bf16*)(F.ws + WS_W1), scr, r, F.lane); continue; } r -= I_W1;
        if (r < I_W1) { transpose_item(F.in[15] + (size_t)DM * FF, mlpg + DM, DM, FF, (bf16*)(F.ws + WS_W1 + 8 * MiB), scr, r, F.lane); continue; } r -= I_W1;
        if (r < I_W2) { transpose_item(F.in[16], nullptr, FF, DM, (bf16*)(F.ws + WS_W2), scr, r, F.lane); continue; } r -= I_W2;
        if (r < I_W2) { transpose_item(F.in[16] + (size_t)FF * DM, nullptr, FF, DM, (bf16*)(F.ws + WS_W2 + 8 * MiB), scr, r, F.lane); continue; } r -= I_W2;
        if (r < I_CDIN) { transpose_item(F.in[9], mixg + DM, DM, CD_IN, (bf16*)(F.ws + WS_WCDIN), scr, r, F.lane); continue; } r -= I_CDIN;
        transpose_item(F.in[14], nullptr, DM, DM, (bf16*)(F.ws + WS_WCDOUT), scr, r, F.lane);
    }
    { const float* pw = F.in[4]; const float* psc = F.in[5]; const float* wo = F.in[8]; float* tmp = (float*)(F.ws + WS_TMPF);
      for (int it = gw; it < 512 * 16; it += NGW) { const int k = it >> 4, n = (it & 15) * 64 + F.lane, g = k >> 7;
          const float* pwr = pw + (size_t)k * 128; const float* scr_ = psc + g * 128; const float* wor = wo + (size_t)(g * 128) * DM + n; float a = 0.f;
#pragma unroll 8
          for (int d = 0; d < 128; ++d) a += (pwr[d] * scr_[d]) * wor[(size_t)d * DM];
          tmp[(size_t)k * DM + n] = a; } }
    { const float* sw = F.in[12]; bf16* wc = (bf16*)(F.ws + WS_WSGU);
      for (int it = gw * 64 + F.lane; it < 4 * 128 * 16; it += NGW * 64) { const int tt = (it >> 4) & 127, s0 = (it & 15) * 8; float f[8];
#pragma unroll
          for (int e = 0; e < 8; ++e) f[e] = (s0 + e <= tt) ? sw[(size_t)it * 8 + e] : 0.f;
          *(GAS v4u*)(wc + (size_t)it * 8) = pack8(f); } }
    { const float* x = F.in[0]; bf16* xn = (bf16*)(F.ws + WS_XN);
      for (int m = gw; m < M; m += NGW) { const GAS f32x4* xr = (const GAS f32x4*)(x + (size_t)m * DM) + F.lane; const GAS f32x4* gr = (const GAS f32x4*)mixg + F.lane;
          f32x4 v[4]; float s = 0.f;
#pragma unroll
          for (int j = 0; j < 4; ++j) { v[j] = xr[64 * j]; s += (v[j].x * v[j].x + v[j].y * v[j].y) + (v[j].z * v[j].z + v[j].w * v[j].w); }
          const float rstd = 1.0f / sqrtf(wave_sum(s) * (1.f / DM) + EPS);
          GAS unsigned long long* o8 = (GAS unsigned long long*)(xn + (size_t)m * DM) + F.lane;
#pragma unroll
          for (int j = 0; j < 4; ++j) { const f32x4 g = gr[64 * j]; o8[64 * j] = (unsigned long long)pk2(v[j].x * rstd * g.x, v[j].y * rstd * g.y) | ((unsigned long long)pk2(v[j].z * rstd * g.z, v[j].w * rstd * g.w) << 32); } } }
}

__device__ __forceinline__ void p2_mixer_ab(Frame& F) {
    { LAS float* scr = (LAS float*)(F.lds + RING_OFF + F.wave * 16384); const int gw = F.vcu * NWAVES + F.wave, NGW = F.G * NWAVES;
      bf16* wt = (bf16*)(F.ws + WS_WABOUT);
      for (int it = gw; it < (DM / 64) * (DM / 32); it += NGW) {
          const int kb = it / (DM / 32);
          transpose_item(kb < 8 ? (const float*)(F.ws + WS_TMPF) : F.in[8], nullptr, DM, DM, wt, scr, it, F.lane); } }
    const bf16* P = (const bf16*)(F.ws + WS_BIG); bf16* MX = (bf16*)(F.ws + WS_MIX);
    const float* cw = F.in[6]; const float* cb = F.in[7];
    const int tl = F.tid >> 7, ch = F.tid & 127;
    for (int u = F.vcu; u < BATCH * 32; u += F.G) {
        const int b = u >> 5, seg = u & 31, t0 = seg * 64 + tl * 16; const size_t rb = (size_t)b * SEQ;
        if (ch < 64) {
            const int c0 = ch * 8, g = ch >> 4, w = 2 << g; float sum[8], a[8];
#pragma unroll
            for (int e = 0; e < 8; ++e) sum[e] = 0.f;
            for (int j = (t0 - w + 1 > 0 ? t0 - w + 1 : 0); j < t0; ++j) { unpack8(*(const GAS v4u*)(P + (rb + j) * AB_IN + c0), a);
#pragma unroll
                for (int e = 0; e < 8; ++e) sum[e] += a[e]; }
            for (int i = 0; i < 16; ++i) { const int t = t0 + i; unpack8(*(const GAS v4u*)(P + (rb + t) * AB_IN + c0), a);
                const float inv = 1.0f / (float)(t + 1 < w ? t + 1 : w); float o[8];
#pragma unroll
                for (int e = 0; e < 8; ++e) { sum[e] += a[e]; o[e] = sum[e] * inv - a[e]; }
                *(GAS v4u*)(MX + (rb + t) * DM + c0) = pack8(o);
                if (t - w + 1 >= 0) { unpack8(*(const GAS v4u*)(P + (rb + t - w + 1) * AB_IN + c0), a);
#pragma unroll
                    for (int e = 0; e < 8; ++e) sum[e] -= a[e]; } }
        } else {
            const int cc = (ch - 64) * 8; float w0[8], w1[8], w2[8], bb[8], g1[8], g2[8], xb[8], gb[8], gc[8];
#pragma unroll
            for (int e = 0; e < 8; ++e) { w0[e] = cw[cc + e]; w1[e] = cw[512 + cc + e]; w2[e] = cw[1024 + cc + e]; bb[e] = cb[cc + e]; g1[e] = 0.f; g2[e] = 0.f; }
            if (t0 >= 1) { unpack8(*(const GAS v4u*)(P + (rb + t0 - 1) * AB_IN + 512 + cc), xb); unpack8(*(const GAS v4u*)(P + (rb + t0 - 1) * AB_IN + 1536 + cc), gc);
#pragma unroll
                for (int e = 0; e < 8; ++e) g1[e] = gc[e] * xb[e]; }
            if (t0 >= 2) { unpack8(*(const GAS v4u*)(P + (rb + t0 - 2) * AB_IN + 512 + cc), xb); unpack8(*(const GAS v4u*)(P + (rb + t0 - 2) * AB_IN + 1536 + cc), gc);
#pragma unroll
                for (int e = 0; e < 8; ++e) g2[e] = gc[e] * xb[e]; }
            for (int i = 0; i < 16; ++i) { const int t = t0 + i; const bf16* pr = P + (rb + t) * AB_IN;
                unpack8(*(const GAS v4u*)(pr + 512 + cc), xb); unpack8(*(const GAS v4u*)(pr + 1024 + cc), gb); unpack8(*(const GAS v4u*)(pr + 1536 + cc), gc); float o[8];
#pragma unroll
                for (int e = 0; e < 8; ++e) { const float g0 = gc[e] * xb[e]; o[e] = gb[e] * (w0[e] * g2[e] + w1[e] * g1[e] + w2[e] * g0 + bb[e]); g2[e] = g1[e]; g1[e] = g0; }
                *(GAS v4u*)(MX + (rb + t) * DM + 512 + cc) = pack8(o); }
        }
    }
}
namespace sba {
using bf16x8 = __attribute__((ext_vector_type(8))) short;
using f16x8 = __attribute__((ext_vector_type(8))) _Float16;
using s16x4 = __attribute__((ext_vector_type(4))) short;
using f32x16 = __attribute__((ext_vector_type(16))) float;
using u32x4 = __attribute__((ext_vector_type(4))) unsigned;
typedef short v4i16_t __attribute__((ext_vector_type(4)));
typedef float f32x2_t __attribute__((ext_vector_type(2))); typedef __bf16 bf16x2_t __attribute__((ext_vector_type(2))); typedef _Float16 f16x2_t __attribute__((ext_vector_type(2)));
typedef __attribute__((address_space(3))) const char* lds_cptr;
typedef __attribute__((address_space(3))) char* lds_ptr;
__device__ __forceinline__ unsigned pk_bf16(float lo, float hi) { f32x2_t v = {lo, hi}; bf16x2_t b = __builtin_convertvector(v, bf16x2_t); return __builtin_bit_cast(unsigned, b); }
__device__ __forceinline__ unsigned pk_f16(float lo, float hi) { f32x2_t v = {lo, hi}; f16x2_t b = __builtin_convertvector(v, f16x2_t); return __builtin_bit_cast(unsigned, b); }
__device__ __forceinline__ s16x4 vtr(lds_cptr p) { return __builtin_bit_cast(s16x4, __builtin_amdgcn_ds_read_tr16_b64_v4i16((__attribute__((address_space(3))) v4i16_t*)p)); }
#define SB_MFMA_BF16(a, b, c) __builtin_amdgcn_mfma_f32_32x32x16_bf16((a), (b), (c), 0, 0, 0)
#define SB_MFMA_F16(a, b, c) __builtin_amdgcn_mfma_f32_32x32x16_f16((a), (b), (c), 0, 0, 0)
constexpr int KV = 64, SLOT = 16384;

template <bool DIAG>
__device__ __forceinline__ void tile(lds_cptr Kb, lds_cptr Vb, const bf16x8 (&qf)[4], f32x16& o0, f32x16& o1, f32x16& carry,
                                     const f16x8 T0, const f16x8 T1, const f16x8 ONES, int r, int hi, int lane, int limA) {
    f32x16 p0, p1;
#pragma unroll
    for (int i = 0; i < 16; ++i) { p0[i] = 0.f; p1[i] = 0.f; }
    const lds_cptr kp = Kb + hi * 1024 + r * 16;
#pragma unroll
    for (int d0 = 0; d0 < 4; ++d0) {
        const bf16x8 a0 = *(const __attribute__((address_space(3))) bf16x8*)(kp + d0 * 2048);
        const bf16x8 a1 = *(const __attribute__((address_space(3))) bf16x8*)(kp + d0 * 2048 + 512);
        p0 = SB_MFMA_BF16(a0, qf[d0], p0); p1 = SB_MFMA_BF16(a1, qf[d0], p1); }
    unsigned l0p[8], l1p[8];
#pragma unroll
    for (int i = 0; i < 16; i += 2) {
        float n0[2], n1[2];
#pragma unroll
        for (int e = 0; e < 2; ++e) { const int ci = ((i + e) & 3) + 8 * ((i + e) >> 2);
            { const float S = p0[i + e]; const float ex = __builtin_amdgcn_exp2f(-__builtin_fabsf(S)), l = __builtin_amdgcn_logf(1.0f + ex); float nsp = __builtin_fminf(-S, 0.f) - l;
              if (DIAG) nsp = (ci < limA) ? nsp : 0.f; n0[e] = nsp; p0[i + e] = S + nsp; }
            { const float S = p1[i + e]; const float ex = __builtin_amdgcn_exp2f(-__builtin_fabsf(S)), l = __builtin_amdgcn_logf(1.0f + ex); float nsp = __builtin_fminf(-S, 0.f) - l;
              if (DIAG) nsp = (ci + 32 < limA) ? nsp : 0.f; n1[e] = nsp; p1[i + e] = S + nsp; } }
        l0p[i >> 1] = pk_f16(n0[0], n0[1]); l1p[i >> 1] = pk_f16(n1[0], n1[1]); }
    const f16x8 l0a = __builtin_bit_cast(f16x8, (u32x4){l0p[0], l0p[1], l0p[2], l0p[3]}), l0b = __builtin_bit_cast(f16x8, (u32x4){l0p[4], l0p[5], l0p[6], l0p[7]});
    const f16x8 l1a = __builtin_bit_cast(f16x8, (u32x4){l1p[0], l1p[1], l1p[2], l1p[3]}), l1b = __builtin_bit_cast(f16x8, (u32x4){l1p[4], l1p[5], l1p[6], l1p[7]});
    f32x16 u1 = SB_MFMA_F16(ONES, l1a, carry); u1 = SB_MFMA_F16(ONES, l1b, u1);
    f32x16 y0 = SB_MFMA_F16(T0, l0a, u1); y0 = SB_MFMA_F16(T1, l0b, y0);
    f32x16 y1 = SB_MFMA_F16(T0, l1a, carry); y1 = SB_MFMA_F16(T1, l1b, y1);
    carry = SB_MFMA_F16(ONES, l0a, u1); carry = SB_MFMA_F16(ONES, l0b, carry);
    unsigned w0p[8], w1p[8];
#pragma unroll
    for (int i = 0; i < 16; i += 2) {
        float a[2], b[2];
#pragma unroll
        for (int e = 0; e < 2; ++e) { const int ci = ((i + e) & 3) + 8 * ((i + e) >> 2);
            a[e] = __builtin_amdgcn_exp2f(p0[i + e] + y0[i + e]); b[e] = __builtin_amdgcn_exp2f(p1[i + e] + y1[i + e]);
            if (DIAG) { a[e] = (ci < limA) ? a[e] : 0.f; b[e] = (ci + 32 < limA) ? b[e] : 0.f; } }
        w0p[i >> 1] = pk_bf16(a[0], a[1]); w1p[i >> 1] = pk_bf16(b[0], b[1]); }
    const bf16x8 pa0 = __builtin_bit_cast(bf16x8, (u32x4){w0p[0], w0p[1], w0p[2], w0p[3]}), pa1 = __builtin_bit_cast(bf16x8, (u32x4){w0p[4], w0p[5], w0p[6], w0p[7]});
    const bf16x8 pa2 = __builtin_bit_cast(bf16x8, (u32x4){w1p[0], w1p[1], w1p[2], w1p[3]}), pa3 = __builtin_bit_cast(bf16x8, (u32x4){w1p[4], w1p[5], w1p[6], w1p[7]});
    const lds_cptr vp = Vb + ((lane >> 4) & 1) * 32 + (lane & 3) * 8 + (4 * hi + ((lane & 15) >> 2)) * 64;
#pragma unroll
    for (int d0 = 0; d0 < 2; ++d0) {
        s16x4 lo[4], hh[4];
#pragma unroll
        for (int ks = 0; ks < 4; ++ks) { lo[ks] = vtr(vp + d0 * 4096 + ks * 1024); hh[ks] = vtr(vp + d0 * 4096 + ks * 1024 + 512); }
#define SB_PK(k) (bf16x8){lo[k][0], lo[k][1], lo[k][2], lo[k][3], hh[k][0], hh[k][1], hh[k][2], hh[k][3]}
        f32x16 o = d0 == 0 ? o0 : o1;
        o = SB_MFMA_BF16(pa0, SB_PK(0), o); o = SB_MFMA_BF16(pa1, SB_PK(1), o); o = SB_MFMA_BF16(pa2, SB_PK(2), o); o = SB_MFMA_BF16(pa3, SB_PK(3), o);
        if (d0 == 0) o0 = o; else o1 = o;
#undef SB_PK
    }
}
}

__device__ __forceinline__ void p7_attention_mfma(Frame& F) {
    using namespace sba;
    const bf16* QKV = (const bf16*)(F.ws + WS_QKV); bf16* MX = (bf16*)(F.ws + WS_MIX);
    const lds_ptr L = (lds_ptr)(F.lds + RING_OFF);
    const int lane = F.lane, r = lane & 31, hi = lane >> 5, w = F.wave;
    unsigned t0w[4], t1w[4];
#pragma unroll
    for (int jj = 0; jj < 4; ++jj) { const int j = 2 * jj; const int k0 = 8 * (j >> 2) + 4 * hi + (j & 3), k1 = k0 + 1;
        t0w[jj] = (k0 > r ? 0x3C00u : 0u) | (k1 > r ? 0x3C000000u : 0u); t1w[jj] = (k0 + 16 > r ? 0x3C00u : 0u) | (k1 + 16 > r ? 0x3C000000u : 0u); }
    const f16x8 T0 = __builtin_bit_cast(f16x8, (u32x4){t0w[0], t0w[1], t0w[2], t0w[3]}), T1 = __builtin_bit_cast(f16x8, (u32x4){t1w[0], t1w[1], t1w[2], t1w[3]});
    const f16x8 ONES = __builtin_bit_cast(f16x8, (u32x4){0x3C003C00u, 0x3C003C00u, 0x3C003C00u, 0x3C003C00u});
    const int limA = 32 * (w & 1) + r - 4 * hi;
    const int skv = F.tid & 63, sch = F.tid >> 6;
    const int kdst = sch * 1024 + skv * 16, vdst = 8192 + (sch >> 2) * 4096 + skv * 64 + (sch & 3) * 16;
    for (int u = F.vcu; u < 1024; u += F.G) {
        const int bh = (u & 255) >> 1, ii = (u >> 8) & 3, odd = u & 1;
        const int qb = odd ? (ii == 0 ? 1 : ii == 1 ? 6 : ii == 2 ? 2 : 5) : (ii == 0 ? 0 : ii == 1 ? 7 : ii == 2 ? 3 : 4);
        const int b = bh >> 3, h = bh & 7; const size_t rb = (size_t)b * SEQ;
        const bf16* kbase = QKV + rb * 1536 + 512 + h * 64 + sch * 8;
        bf16x8 qf[4];
        { const bf16* qp = QKV + (rb + 256 * qb + 32 * w + r) * 1536 + h * 64 + hi * 8;
#pragma unroll
          for (int d0 = 0; d0 < 4; ++d0) qf[d0] = *(const bf16x8*)(qp + d0 * 16); }
        f32x16 o0, o1, carry;
#pragma unroll
        for (int i = 0; i < 16; ++i) { o0[i] = 0.f; o1[i] = 0.f; carry[i] = 0.f; }
        const int ttd = 4 * qb + (w >> 1), ntile = 4 * qb + 4;
        __syncthreads();
        { const bf16* kp = kbase + (size_t)((ntile - 1) * KV + skv) * 1536; const v4u kr = *(const GAS v4u*)kp, vr = *(const GAS v4u*)(kp + 512);
          *(__attribute__((address_space(3))) v4u*)(L + kdst) = kr; *(__attribute__((address_space(3))) v4u*)(L + vdst) = vr; }
        __syncthreads();
        int cur = 0;
        for (int tt = ntile - 1; tt >= 0; --tt) {
            v4u kr, vr;
            if (tt > 0) { const bf16* kp = kbase + (size_t)((tt - 1) * KV + skv) * 1536; kr = *(const GAS v4u*)kp; vr = *(const GAS v4u*)(kp + 512); }
            const lds_cptr Kb = (lds_cptr)(L + cur * SLOT), Vb = Kb + 8192;
            if (tt < ttd) tile<false>(Kb, Vb, qf, o0, o1, carry, T0, T1, ONES, r, hi, lane, limA);
            else if (tt == ttd) tile<true>(Kb, Vb, qf, o0, o1, carry, T0, T1, ONES, r, hi, lane, limA);
            if (tt > 0) { *(__attribute__((address_space(3))) v4u*)(L + (cur ^ 1) * SLOT + kdst) = kr; *(__attribute__((address_space(3))) v4u*)(L + (cur ^ 1) * SLOT + vdst) = vr; }
            __syncthreads();
            cur ^= 1;
        }
        { bf16* op = MX + (rb + 256 * qb + 32 * w) * DM + 512 + h * 64 + r;
#pragma unroll
          for (int i = 0; i < 16; ++i) { const int q = (i & 3) + 8 * (i >> 2) + 4 * hi;
              op[(size_t)q * DM] = (bf16)f2bf(o0[i]); op[(size_t)q * DM + 32] = (bf16)f2bf(o1[i]); } }
    }
    __syncthreads();
}

__device__ __forceinline__ void p7_attention(Frame& F) {
    typedef float f4 __attribute__((ext_vector_type(4)));
    LAS f4* Ks = (LAS f4*)(F.lds + RING_OFF); LAS f4* Vs = Ks + 1024;
    const bf16* QKV = (const bf16*)(F.ws + WS_QKV); bf16* MX = (bf16*)(F.ws + WS_MIX);
    for (int u = F.vcu; u < 512; u += F.G) {
        const int bh = (u & 255) >> 1, q01 = u & 1, qq = (u >> 8) ? 3 - q01 : q01, b = bh >> 3, h = bh & 7;
        const int t = 512 * qq + F.tid; const size_t rb = (size_t)b * SEQ;
        float q[64], o[64];
        { const bf16* qp = QKV + (rb + t) * 1536 + h * 64;
#pragma unroll
          for (int c = 0; c < 8; ++c) unpack8(*(const GAS v4u*)(qp + c * 8), q + c * 8); }
#pragma unroll
        for (int d = 0; d < 64; ++d) o[d] = 0.f;
        float carry = 0.f;
        const int wave_tmax = 512 * qq + 64 * F.wave + 63;
        for (int tt = 8 * qq + 7; tt >= 0; --tt) {
            __syncthreads();
            { const int kk = F.tid >> 3, c8 = F.tid & 7; const bf16* kp = QKV + (rb + tt * 64 + kk) * 1536 + 512 + h * 64 + c8 * 8; float f[8];
              unpack8(*(const GAS v4u*)kp, f); Ks[kk * 16 + c8 * 2] = (f4){f[0], f[1], f[2], f[3]}; Ks[kk * 16 + c8 * 2 + 1] = (f4){f[4], f[5], f[6], f[7]};
              unpack8(*(const GAS v4u*)(kp + 512), f); Vs[kk * 16 + c8 * 2] = (f4){f[0], f[1], f[2], f[3]}; Vs[kk * 16 + c8 * 2 + 1] = (f4){f[4], f[5], f[6], f[7]}; }
            __syncthreads();
            if (tt * 64 < wave_tmax) {
                for (int s = 63; s >= 0; --s) {
                    float d0 = 0.f, d1 = 0.f;
#pragma unroll
                    for (int c = 0; c < 16; c += 2) { const f4 k0 = Ks[s * 16 + c], k1 = Ks[s * 16 + c + 1];
                        d0 += q[4 * c] * k0.x + q[4 * c + 1] * k0.y + q[4 * c + 2] * k0.z + q[4 * c + 3] * k0.w;
                        d1 += q[4 * c + 4] * k1.x + q[4 * c + 5] * k1.y + q[4 * c + 6] * k1.z + q[4 * c + 7] * k1.w; }
                    const float S = d0 + d1; const bool valid = (tt * 64 + s) < t;
                    const float e = __builtin_amdgcn_exp2f(-fabsf(S)), l = __builtin_amdgcn_logf(1.0f + e), nsp = fminf(-S, 0.f) - l, lb = S + nsp;
                    const float w = valid ? __builtin_amdgcn_exp2f(lb + carry) : 0.f; carry += valid ? nsp : 0.f;
#pragma unroll
                    for (int c = 0; c < 16; ++c) { const f4 v = Vs[s * 16 + c]; o[4 * c] += w * v.x; o[4 * c + 1] += w * v.y; o[4 * c + 2] += w * v.z; o[4 * c + 3] += w * v.w; }
                }
            }
        }
        { bf16* op = MX + (rb + t) * DM + 512 + h * 64;
#pragma unroll
          for (int c = 0; c < 8; ++c) *(GAS v4u*)(op + c * 8) = pack8(o + c * 8); }
    }
    __syncthreads();
}
__device__ __forceinline__ void p7_sgu_mfma(Frame& F) {
    typedef __attribute__((address_space(3))) unsigned short lds_u16;
    constexpr int PITCH = 136;
    LAS float* st = (LAS float*)(F.lds + RING_OFF); LAS unsigned char* VT = F.lds + RING_OFF + 1024;
    const bf16* UV = (const bf16*)(F.ws + WS_BIG); bf16* MX = (bf16*)(F.ws + WS_MIX); const bf16* WC = (const bf16*)(F.ws + WS_WSGU);
    const float* gam = F.in[10]; const float* bet = F.in[11]; const float* sb = F.in[13];
    const int lane = F.lane, w = F.wave, fr = lane & 15, fq = lane >> 4;
    for (int u = F.vcu; u < 256; u += F.G) {
        const size_t row0 = (size_t)(u >> 4) * SEQ + (size_t)(u & 15) * 128;
        __syncthreads();
        for (int i = 0; i < 16; ++i) { const int s = 16 * w + i; float f[8]; unpack8(*(const GAS v4u*)(UV + (row0 + s) * 1024 + 512 + lane * 8), f);
            float a = 0.f;
#pragma unroll
            for (int e = 0; e < 8; ++e) a += f[e];
            const float mean = wave_sum(a) * (1.0f / 512.0f); float qv = 0.f;
#pragma unroll
            for (int e = 0; e < 8; ++e) { const float d = f[e] - mean; qv += d * d; }
            const float rstd = 1.0f / sqrtf(wave_sum(qv) * (1.0f / 512.0f) + EPS);
            if (lane == 0) { st[s] = mean; st[128 + s] = rstd; } }
        __syncthreads();
        for (int g = 0; g < 4; ++g) {
            { const int s = 64 * (w & 1) + lane, cq = w >> 1; const float mean = st[s], rstd = st[128 + s];
#pragma unroll
              for (int j = 0; j < 4; ++j) { const int c0 = (4 * cq + j) * 8; float f[8]; unpack8(*(const GAS v4u*)(UV + (row0 + s) * 1024 + 512 + g * 128 + c0), f);
#pragma unroll
                  for (int e = 0; e < 8; ++e) { const float vn = (f[e] - mean) * rstd * gam[g * 128 + c0 + e] + bet[g * 128 + c0 + e];
                      *(lds_u16*)(VT + ((c0 + e) * PITCH + s) * 2) = (unsigned short)f2bf(vn); } } }
            __syncthreads();
            { pg8::f32x4 acc[8];
#pragma unroll
              for (int ct = 0; ct < 8; ++ct) acc[ct] = (pg8::f32x4){0.f, 0.f, 0.f, 0.f};
              const int t = 16 * w + fr; const bf16* wrow = WC + ((size_t)g * 128 + t) * 128 + 8 * fq;
              for (int ks = 0; ks <= (w >> 1); ++ks) {
                  const bf16x8 bfr = *(const bf16x8*)(wrow + 32 * ks);
#pragma unroll
                  for (int ct = 0; ct < 8; ++ct) { const bf16x8 afr = *(const LAS bf16x8*)(VT + ((16 * ct + fr) * PITCH + 32 * ks + 8 * fq) * 2);
                      acc[ct] = __builtin_amdgcn_mfma_f32_16x16x32_bf16(afr, bfr, acc[ct], 0, 0, 0); } }
              const float bias = sb[g * 128 + t]; const size_t ro = (row0 + t) * 1024 + g * 128 + 4 * fq;
#pragma unroll
              for (int ct = 0; ct < 8; ++ct) { const unsigned long long uu = *(const GAS unsigned long long*)(UV + ro + 16 * ct);
                  const float u0 = __builtin_bit_cast(float, (unsigned)(uu << 16)), u1 = __builtin_bit_cast(float, (unsigned)uu & 0xffff0000u), u2 = __builtin_bit_cast(float, (unsigned)(uu >> 32) << 16), u3 = __builtin_bit_cast(float, (unsigned)(uu >> 32) & 0xffff0000u);
                  const unsigned long long o = (unsigned long long)pk2(u0 * (acc[ct][0] + bias), u1 * (acc[ct][1] + bias)) | ((unsigned long long)pk2(u2 * (acc[ct][2] + bias), u3 * (acc[ct][3] + bias)) << 32);
                  *(GAS unsigned long long*)(MX + ro + 16 * ct) = o; } }
            __syncthreads();
        }
    }
}

__device__ __forceinline__ void p7_sgu(Frame& F) {
    LAS float* st = (LAS float*)(F.lds + RING_OFF); LAS float* VN = st + 256;
    const bf16* UV = (const bf16*)(F.ws + WS_BIG); bf16* MX = (bf16*)(F.ws + WS_MIX);
    const float* gam = F.in[10]; const float* bet = F.in[11]; const float* sw = F.in[12]; const float* sb = F.in[13];
    for (int u = F.vcu; u < 256; u += F.G) {
        const size_t row0 = (size_t)(u >> 4) * SEQ + (size_t)(u & 15) * 128;
        __syncthreads();
        for (int i = 0; i < 16; ++i) { const int s = 16 * F.wave + i; float f[8]; unpack8(*(const GAS v4u*)(UV + (row0 + s) * 1024 + 512 + F.lane * 8), f);
            float a = 0.f;
#pragma unroll
            for (int e = 0; e < 8; ++e) a += f[e];
            const float mean = wave_sum(a) * (1.0f / 512.0f); float qv = 0.f;
#pragma unroll
            for (int e = 0; e < 8; ++e) { const float d = f[e] - mean; qv += d * d; }
            const float rstd = 1.0f / sqrtf(wave_sum(qv) * (1.0f / 512.0f) + EPS);
            if (F.lane == 0) { st[s] = mean; st[128 + s] = rstd; } }
        __syncthreads();
        for (int g = 0; g < 4; ++g) {
            { const int s = F.tid >> 2, cq = F.tid & 3; const float mean = st[s], rstd = st[128 + s];
#pragma unroll
              for (int j = 0; j < 4; ++j) { const int c = cq * 32 + j * 8; float f[8]; unpack8(*(const GAS v4u*)(UV + (row0 + s) * 1024 + 512 + g * 128 + c), f);
#pragma unroll
                  for (int e = 0; e < 8; ++e) VN[s * 128 + c + e] = (f[e] - mean) * rstd * gam[g * 128 + c + e] + bet[g * 128 + c + e]; } }
            __syncthreads();
            { const int c = F.tid & 127, tq = F.tid >> 7;
              for (int i = 0; i < 32; ++i) { const int t = tq * 32 + i; const float* wr = sw + ((size_t)g * 128 + t) * 128; float a = 0.f;
                  for (int s = 0; s <= t; ++s) a += wr[s] * VN[s * 128 + c];
                  const float uu = bf2f(UV[(row0 + t) * 1024 + g * 128 + c]);
                  MX[(row0 + t) * DM + g * 128 + c] = (bf16)f2bf(uu * (a + sb[g * 128 + t])); } }
            __syncthreads();
        }
    }
}
__device__ __forceinline__ void p11_final(Frame& F) {
    const int gw = F.vcu * NWAVES + F.wave, NGW = F.G * NWAVES; const bf16* HB = (const bf16*)(F.ws + WS_XN); const float* gf = F.in[17];
    f32x4 g[4];
#pragma unroll
    for (int j = 0; j < 4; ++j) g[j] = *(const GAS f32x4*)(gf + (j >> 1) * 512 + F.lane * 8 + (j & 1) * 4);
    for (int m0 = gw * 2; m0 < M; m0 += NGW * 2) {
        v4u r[2][2];
#pragma unroll
        for (int i = 0; i < 2; ++i) { r[i][0] = *(const GAS v4u*)(HB + (size_t)(m0 + i) * DM + F.lane * 8); r[i][1] = *(const GAS v4u*)(HB + (size_t)(m0 + i) * DM + 512 + F.lane * 8); }
#pragma unroll
        for (int i = 0; i < 2; ++i) { float f[16]; unpack8(r[i][0], f); unpack8(r[i][1], f + 8); float s = 0.f;
#pragma unroll
            for (int e = 0; e < 16; ++e) s += f[e] * f[e];
            const float rstd = 1.0f / sqrtf(wave_sum(s) * (1.f / DM) + EPS); float* op = F.out + (size_t)(m0 + i) * DM + F.lane * 8;
#pragma unroll
            for (int j = 0; j < 4; ++j) *(GAS f32x4*)(op + (j >> 1) * 512 + (j & 1) * 4) = (f32x4){f[4 * j] * rstd * g[j].x, f[4 * j + 1] * rstd * g[j].y, f[4 * j + 2] * rstd * g[j].z, f[4 * j + 3] * rstd * g[j].w}; } }
}

struct Args { const float* in[18]; float* out; unsigned char* ws; int ph_lo, ph_hi, li, pad; };
__global__ void __launch_bounds__(NWAVES * 64, 2) trunk_fwd(Args args) {
    extern __shared__ __attribute__((aligned(16))) unsigned char lds[];
    Frame F;
    F.lds = (LAS unsigned char*)lds;
    F.MISC = (volatile LAS unsigned*)(F.lds + MISC_OFF);
    F.tid = threadIdx.x; F.lane = F.tid & 63; F.wave = __builtin_amdgcn_readfirstlane(F.tid >> 6);
    F.G = gridDim.x; { const int bx = blockIdx.x; F.vcu = (F.G % 8 == 0) ? (bx % 8) * (F.G / 8) + bx / 8 : bx; }
#pragma unroll
    for (int i = 0; i < 18; ++i) F.in[i] = args.in[i];
    F.out = args.out; F.ws = args.ws; F.ctl = (gu32*)(args.ws + WS_CTL);
    for (int u = F.tid; u < (LDS_BYTES - LDSCTL_OFF) / 4; u += NWAVES * 64) ((LAS unsigned*)(F.lds + LDSCTL_OFF))[u] = 0u;
    __syncthreads();
    XcdBarrier bar = xcd_barrier_post((unsigned*)(F.ctl + CW_BAR) + args.li * XCD_BAR_WORDS, F.MISC + 8);
    const int lo = args.ph_lo, hi = args.ph_hi;
#define IN(k) (lo <= (k) && (k) < hi)
#define SEAM(k) do { if (IN(k) && IN((k) + 1)) xcd_barrier(bar); } while (0)
    bf16* XN = (bf16*)(F.ws + WS_XN); bf16* MIX = (bf16*)(F.ws + WS_MIX); bf16* BIG = (bf16*)(F.ws + WS_BIG); bf16* QKV = (bf16*)(F.ws + WS_QKV); float* SS = (float*)(F.ws + WS_SS);
    if (IN(0)) { p0_prologue(F); SEAM(0); }
    if (IN(1)) { pg8::Gemm g{XN, (const bf16*)(F.ws + WS_WABIN), M, AB_IN, DM}; pg8::StaticOrder S; S.init(M, AB_IN, F.G, (int)blockIdx.x);
        pg8::EpiStore E{BIG, AB_IN};
        pg8::gemm_phase<pg8::EpiStore, pg8::StaticOrder, true, true>(F.lds + RING_OFF, g, S, E); SEAM(1); }
    if (IN(2)) { p2_mixer_ab(F); SEAM(2); }
    if (IN(3)) { pg8::Gemm g{MIX, (const bf16*)(F.ws + WS_WABOUT), M, DM, DM}; pg8::StaticOrder S; S.init(M, DM, F.G, (int)blockIdx.x);
        pg8::EpiResid<true, true> E{F.in[0], XN, SS};
        pg8::gemm_phase<pg8::EpiResid<true, true>, pg8::StaticOrder, true, true>(F.lds + RING_OFF, g, S, E); SEAM(3); }
    if (IN(4)) { pg8::Gemm g{XN, (const bf16*)(F.ws + WS_W1), M, FF, DM}; pg8::StaticOrder S; S.init(M, FF, F.G, (int)blockIdx.x);
        pg8::EpiUp E{BIG, SS};
        pg8::gemm_phase<pg8::EpiUp, pg8::StaticOrder, true, true>(F.lds + RING_OFF, g, S, E); SEAM(4); }
    if (IN(5)) { pg8::Gemm g{BIG, (const bf16*)(F.ws + WS_W2), M, DM, FF}; pg8::StaticOrder S; S.init(M, DM, F.G, (int)blockIdx.x);
        pg8::EpiResid<false, true> E{nullptr, XN, SS};
        pg8::gemm_phase<pg8::EpiResid<false, true>, pg8::StaticOrder, true, true>(F.lds + RING_OFF, g, S, E); SEAM(5); }
    if (IN(6)) { pg8::Gemm g{XN, (const bf16*)(F.ws + WS_WCDIN), M, CD_IN, DM}; pg8::StaticOrder S; S.init(M, CD_IN, F.G, (int)blockIdx.x);
        pg8::EpiCdIn E{BIG, QKV, SS, QSCALE};
        pg8::gemm_phase<pg8::EpiCdIn, pg8::StaticOrder, true, true>(F.lds + RING_OFF, g, S, E); SEAM(6); }
    if (IN(7)) { p7_attention_mfma(F); p7_sgu_mfma(F); SEAM(7); }
    if (IN(8)) { pg8::Gemm g{MIX, (const bf16*)(F.ws + WS_WCDOUT), M, DM, DM}; pg8::StaticOrder S; S.init(M, DM, F.G, (int)blockIdx.x);
        pg8::EpiResid<false, true> E{nullptr, XN, SS};
        pg8::gemm_phase<pg8::EpiResid<false, true>, pg8::StaticOrder, true, true>(F.lds + RING_OFF, g, S, E); SEAM(8); }
    if (IN(9)) { pg8::Gemm g{XN, (const bf16*)(F.ws + WS_W1 + 8 * MiB), M, FF, DM}; pg8::StaticOrder S; S.init(M, FF, F.G, (int)blockIdx.x);
        pg8::EpiUp E{BIG, SS};
        pg8::gemm_phase<pg8::EpiUp, pg8::StaticOrder, true, true>(F.lds + RING_OFF, g, S, E); SEAM(9); }
    if (IN(10)) { pg8::Gemm g{BIG, (const bf16*)(F.ws + WS_W2 + 8 * MiB), M, DM, FF}; pg8::StaticOrder S; S.init(M, DM, F.G, (int)blockIdx.x);
        pg8::EpiResid<false, false> E{nullptr, XN, SS};
        pg8::gemm_phase<pg8::EpiResid<false, false>, pg8::StaticOrder, true, true>(F.lds + RING_OFF, g, S, E); SEAM(10); }
    if (IN(11)) { p11_final(F); }
#undef IN
#undef SEAM
}

extern "C" void kernel_launch(void* const* d_in, const int* in_sizes, int n_in, void* d_out, int out_size, void* d_ws, size_t ws_size, hipStream_t stream) {
    static int grid = 0;
    if (grid == 0) {
        if (n_in != 18 || in_sizes[0] != M * DM || out_size != M * DM || ws_size < WS_END) { fprintf(stderr, "kernel_launch: unexpected shapes (n_in %d in0 %d out %d ws %zu); nothing launched\n", n_in, n_in > 0 ? in_sizes[0] : -1, out_size, ws_size); grid = -1; return; }
        int dev = 0, cus = 0, per_cu = 0;
        if (hipGetDevice(&dev) != hipSuccess || hipDeviceGetAttribute(&cus, hipDeviceAttributeMultiprocessorCount, dev) != hipSuccess) { grid = -1; return; }
        if (hipFuncSetAttribute((const void*)trunk_fwd, hipFuncAttributeMaxDynamicSharedMemorySize, LDS_BYTES) != hipSuccess) { fprintf(stderr, "kernel_launch: hipFuncSetAttribute failed\n"); grid = -1; return; }
        if (hipOccupancyMaxActiveBlocksPerMultiprocessor(&per_cu, (const void*)trunk_fwd, NWAVES * 64, LDS_BYTES) != hipSuccess || per_cu < 1) { fprintf(stderr, "kernel_launch: occupancy query reports %d workgroups per CU\n", per_cu); }
        (void)hipGetLastError();
        grid = cus;
    }
    if (grid < 0) return;
    if (hipMemsetAsync((char*)d_ws + WS_CTL, 0, CTL_ZERO_BYTES, stream) != hipSuccess) return;
    Args a{};
    for (int i = 0; i < 18; ++i) a.in[i] = (const float*)d_in[i];
    a.out = (float*)d_out; a.ws = (unsigned char*)d_ws;
#if PROBE_REPEAT >= 0
    const int plan[2][2] = {{0, PROBE_REPEAT + 1}, {PROBE_REPEAT, N_PHASES}}; const int nl = 2;
#else
    const int plan[1][2] = {{0, N_PHASES}}; const int nl = 1;
#endif
    for (int li = 0; li < nl; ++li) {
        a.ph_lo = plan[li][0]; a.ph_hi = plan[li][1]; a.li = li;
        hipLaunchKernelGGL(trunk_fwd, dim3(grid), dim3(NWAVES * 64), LDS_BYTES, stream, a);
    }
}
```

```cpp
#include <hip/hip_runtime.h>
#include <cstdio>
#include <cstdint>
namespace pg8 {
#define PG8_LAS __attribute__((address_space(3)))
typedef unsigned short bf16_t;
typedef short bf16x8 __attribute__((ext_vector_type(8)));
typedef float f32x4 __attribute__((ext_vector_type(4)));
typedef unsigned u32x4 __attribute__((ext_vector_type(4)));
constexpr int BM = 256, BK = 64, HALF = 128, HTB = HALF * BK * 2  , STAGE_BYTES = 8 * HTB, NXCD = 8, WGM = 8;

__host__ __device__ __forceinline__ int lds_byte(int r, int c) { const int st = (r >> 4) * 2 + (c >> 5), rr = r & 15, cc = c & 31, ob = rr * 64 + cc * 2; return st * 1024 + (ob ^ (((ob >> 9) & 1) << 5)); }
__host__ __device__ __forceinline__ void stage_rc(int b, int& R, int& C) { const int st = b / 1024, sb = b % 1024, swz = sb ^ (((sb >> 9) & 1) << 5); R = (st >> 1) * 16 + swz / 64; C = (st & 1) * 32 + (swz % 64) / 2; }
__host__ __device__ __forceinline__ int perm32(int rho) { const int n = rho >> 4, i = rho & 15; return 8 * (i >> 2) + 4 * n + (i & 3); }

struct Unit { int pm, pn; };
struct Gemm { const bf16_t* A; const bf16_t* Bt; int M, N, K; };

struct StaticOrder {
    int nM, nN, nwg, G, c;
    __host__ __device__ void init(int M, int N, int G_, int c_) { nM = M / BM; nN = N / BM; nwg = nM * nN; G = G_; c = c_; }
    __host__ __device__ bool next(int i, Unit& u) const {
        const long L = (long)i * G + c; if (L >= nwg) return false;
        int wgid = (int)L; { const int q = nwg / NXCD, r = nwg % NXCD, xcd = wgid % NXCD, off = wgid / NXCD; wgid = (xcd < r ? xcd * (q + 1) : r * (q + 1) + (xcd - r) * q) + off; }
        const int nig = WGM * nN, gid = wgid / nig, fm = gid * WGM, gsz = (nM - fm) < WGM ? (nM - fm) : WGM;
        u.pm = fm + ((wgid % nig) % gsz); u.pn = (wgid % nig) / gsz; return true;
    }
    __device__ __forceinline__ void a_ready(const Unit&) const {}
    __device__ __forceinline__ void done(const Unit&) const {}
};

__device__ __forceinline__ unsigned cvt_pk_bf16(float lo, float hi) { unsigned r; asm volatile("v_cvt_pk_bf16_f32 %0, %1, %2" : "=v"(r) : "v"(lo), "v"(hi)); return r; }
typedef float f32x2 __attribute__((ext_vector_type(2)));
__device__ __forceinline__ f32x2 gelu_pk(f32x2 v) {
    const f32x2 av = __builtin_elementwise_abs(v), d = av * 0.2316418882f + 1.0f;
    f32x2 t; t.x = __builtin_amdgcn_rcpf(d.x); t.y = __builtin_amdgcn_rcpf(d.y);
    f32x2 q = t * 0.5307027145f + (-0.7265760135f); q = q * t + 0.7107068705f; q = q * t + (-0.142248368f); q = q * t + 0.127414796f; q = q * t;
    const f32x2 s = (v * v) * (-0.72134752044f);
    f32x2 e; e.x = __builtin_amdgcn_exp2f(s.x); e.y = __builtin_amdgcn_exp2f(s.y);
    const f32x2 m = v * (q * e), r = v - m;
    f32x2 o; o.x = v.x < 0.f ? m.x : r.x; o.y = v.y < 0.f ? m.y : r.y; return o;
}
typedef unsigned u32x2 __attribute__((ext_vector_type(2)));
struct EpiStore {
    static constexpr bool PERM = true, AFTER_DRAIN = false;
    bf16_t* O; int ldc;
    __device__ __forceinline__ void operator()(const f32x4 (&acc)[2][2][4][2], const Unit& u, int wr, int wc, int fr, int fq) const {
        const int row0 = u.pm * BM + wr * 64 + fr, col0 = u.pn * BM + wc * 32 + 8 * fq;
#pragma unroll
        for (int ai = 0; ai < 2; ++ai)
#pragma unroll
            for (int m = 0; m < 4; ++m) { bf16_t* rowp = O + (size_t)(row0 + ai * HALF + m * 16) * ldc + col0;
#pragma unroll
                for (int bj = 0; bj < 2; ++bj) { const f32x4 v0 = acc[ai][bj][m][0], v1 = acc[ai][bj][m][1];
                    u32x4 w; w.x = cvt_pk_bf16(v0[0], v0[1]); w.y = cvt_pk_bf16(v0[2], v0[3]); w.z = cvt_pk_bf16(v1[0], v1[1]); w.w = cvt_pk_bf16(v1[2], v1[3]);
                    *(u32x4*)(rowp + bj * HALF) = w; } }
    }
};
__device__ __forceinline__ float bflo(unsigned w) { return __builtin_bit_cast(float, w << 16); }
__device__ __forceinline__ float bfhi(unsigned w) { return __builtin_bit_cast(float, w & 0xffff0000u); }
template <bool XF32, bool WRITE_SS> struct EpiResid {
    static constexpr bool PERM = true, AFTER_DRAIN = false;
    const float* xf; bf16_t* hb; float* ss;
    __device__ __forceinline__ void operator()(const f32x4 (&acc)[2][2][4][2], const Unit& u, int wr, int wc, int fr, int fq) const {
        const int row0 = u.pm * BM + wr * 64 + fr, col0 = u.pn * BM + wc * 32 + 8 * fq;
#pragma unroll
        for (int ai = 0; ai < 2; ++ai) {
            f32x4 b[4][2][2];
            if (XF32) {
#pragma unroll
                for (int m = 0; m < 4; ++m)
#pragma unroll
                    for (int bj = 0; bj < 2; ++bj) { const float* p = xf + (size_t)(row0 + ai * HALF + m * 16) * 1024 + col0 + bj * HALF; b[m][bj][0] = *(const f32x4*)p; b[m][bj][1] = *(const f32x4*)(p + 4); }
            } else {
#pragma unroll
                for (int m = 0; m < 4; ++m)
#pragma unroll
                    for (int bj = 0; bj < 2; ++bj) { const u32x4 w = *(const u32x4*)(hb + (size_t)(row0 + ai * HALF + m * 16) * 1024 + col0 + bj * HALF);
                        b[m][bj][0] = (f32x4){bflo(w.x), bfhi(w.x), bflo(w.y), bfhi(w.y)}; b[m][bj][1] = (f32x4){bflo(w.z), bfhi(w.z), bflo(w.w), bfhi(w.w)}; }
            }
#pragma unroll
            for (int m = 0; m < 4; ++m) { const int row = row0 + ai * HALF + m * 16; float s = 0.f;
#pragma unroll
                for (int bj = 0; bj < 2; ++bj) { const f32x4 v0 = b[m][bj][0] + acc[ai][bj][m][0], v1 = b[m][bj][1] + acc[ai][bj][m][1];
                    u32x4 w; w.x = cvt_pk_bf16(v0[0], v0[1]); w.y = cvt_pk_bf16(v0[2], v0[3]); w.z = cvt_pk_bf16(v1[0], v1[1]); w.w = cvt_pk_bf16(v1[2], v1[3]);
                    *(u32x4*)(hb + (size_t)row * 1024 + col0 + bj * HALF) = w;
                    if (WRITE_SS) s += ((v0[0] * v0[0] + v0[1] * v0[1]) + (v0[2] * v0[2] + v0[3] * v0[3])) + ((v1[0] * v1[0] + v1[1] * v1[1]) + (v1[2] * v1[2] + v1[3] * v1[3])); }
                if (WRITE_SS) { s += __shfl_xor(s, 16); s += __shfl_xor(s, 32); if (fq == 0) ss[(size_t)row * 16 + u.pn * 4 + wc] = s; } }
            asm volatile("" ::: "memory");
        }
    }
};
__device__ __forceinline__ void rows_rstd(const float* ss, int row0, int fq, float (&rs)[2][4]) {
    f32x4 p[2][4];
#pragma unroll
    for (int ai = 0; ai < 2; ++ai)
#pragma unroll
        for (int m = 0; m < 4; ++m) p[ai][m] = *(const f32x4*)(ss + (size_t)(row0 + ai * HALF + m * 16) * 16 + 4 * fq);
#pragma unroll
    for (int ai = 0; ai < 2; ++ai)
#pragma unroll
        for (int m = 0; m < 4; ++m) { float s = (p[ai][m][0] + p[ai][m][1]) + (p[ai][m][2] + p[ai][m][3]); s += __shfl_xor(s, 16); s += __shfl_xor(s, 32); rs[ai][m] = 1.0f / sqrtf(s * (1.0f / 1024.0f) + 1e-6f); }
}
struct EpiUp {
    static constexpr bool PERM = true, AFTER_DRAIN = false;
    bf16_t* O; const float* ss;
    __device__ __forceinline__ void operator()(const f32x4 (&acc)[2][2][4][2], const Unit& u, int wr, int wc, int fr, int fq) const {
        const int row0 = u.pm * BM + wr * 64 + fr, col0 = u.pn * BM + wc * 32 + 8 * fq;
        float rs[2][4]; rows_rstd(ss, row0, fq, rs);
#pragma unroll
        for (int ai = 0; ai < 2; ++ai)
#pragma unroll
            for (int m = 0; m < 4; ++m) { const int row = row0 + ai * HALF + m * 16; const float r = rs[ai][m];
                bf16_t* rowp = O + (size_t)row * 4096 + col0;
#pragma unroll
                for (int bj = 0; bj < 2; ++bj) { f32x4 v0 = acc[ai][bj][m][0] * r, v1 = acc[ai][bj][m][1] * r;
#pragma unroll
                    for (int e = 0; e < 4; ++e) { const float a = fmaxf(v0[e], 0.f), b = fmaxf(v1[e], 0.f); v0[e] = a * a; v1[e] = b * b; }
                    u32x4 w; w.x = cvt_pk_bf16(v0[0], v0[1]); w.y = cvt_pk_bf16(v0[2], v0[3]); w.z = cvt_pk_bf16(v1[0], v1[1]); w.w = cvt_pk_bf16(v1[2], v1[3]);
                    *(u32x4*)(rowp + bj * HALF) = w; } }
    }
};
struct EpiCdIn {
    static constexpr bool PERM = true, AFTER_DRAIN = false;
    bf16_t* UV; bf16_t* QKV; const float* ss; float qscale;
    __device__ __forceinline__ void operator()(const f32x4 (&acc)[2][2][4][2], const Unit& u, int wr, int wc, int fr, int fq) const {
        const int row0 = u.pm * BM + wr * 64 + fr; const bool isuv = u.pn < 4;
        const int colt = isuv ? u.pn * BM : (u.pn - 4) * BM; const int ldc = isuv ? 1024 : 1536; bf16_t* base = isuv ? UV : QKV;
        const float sc = (!isuv && u.pn < 6) ? qscale : 1.0f;
        const int col0 = colt + wc * 32 + 8 * fq;
        float rs[2][4]; rows_rstd(ss, row0, fq, rs);
#pragma unroll
        for (int ai = 0; ai < 2; ++ai)
#pragma unroll
            for (int m = 0; m < 4; ++m) { const int row = row0 + ai * HALF + m * 16; const float r = rs[ai][m] * sc;
                bf16_t* rowp = base + (size_t)row * ldc + col0;
#pragma unroll
                for (int bj = 0; bj < 2; ++bj) { f32x4 v0 = acc[ai][bj][m][0] * r, v1 = acc[ai][bj][m][1] * r;
                    if (isuv) { f32x2 a = gelu_pk((f32x2){v0[0], v0[1]}), b = gelu_pk((f32x2){v0[2], v0[3]}), c = gelu_pk((f32x2){v1[0], v1[1]}), d = gelu_pk((f32x2){v1[2], v1[3]});
                        v0 = (f32x4){a.x, a.y, b.x, b.y}; v1 = (f32x4){c.x, c.y, d.x, d.y}; }
                    u32x4 w; w.x = cvt_pk_bf16(v0[0], v0[1]); w.y = cvt_pk_bf16(v0[2], v0[3]); w.z = cvt_pk_bf16(v1[0], v1[1]); w.w = cvt_pk_bf16(v1[2], v1[3]);
                    *(u32x4*)(rowp + bj * HALF) = w; } }
    }
};
template <class Epi, class Sched, bool ALIGN_EPI = false, bool SP2 = false>
__device__ __forceinline__ void gemm_phase(PG8_LAS unsigned char* lds, const Gemm g, const Sched& S, const Epi& E) {
    const int tid = threadIdx.x, wid = __builtin_amdgcn_readfirstlane(tid >> 6), lane = tid & 63, wr = wid >> 2, wc = wid & 3, fr = lane & 15, fq = lane >> 4;
    const int K = g.K, nt = K / BK;
    unsigned voffA[2], voffB[2];
#pragma unroll
    for (int i = 0; i < 2; ++i) { int R, C; stage_rc(tid * 16 + i * 8192, R, C); const int Rb = Epi::PERM ? ((R & ~31) + perm32(R & 31)) : R;
        voffA[i] = (unsigned)(R * K + C) * 2u; voffB[i] = (unsigned)(Rb * K + C) * 2u; }
    const size_t kstep = (size_t)(BK * 2);
    const size_t hstep = (size_t)HALF * K * 2;
    const size_t tstep = 2 * hstep;
    const unsigned ldsw = (unsigned)wid * 1024u;
    const int aoff = lds_byte(wr * 64 + fr, fq * 8), boff = lds_byte(wc * 32 + fr, fq * 8);
#define PG8_SA(b, h) (((b) * 2 + (h)) * HTB)
#define PG8_SB(b, h) ((4 + (b) * 2 + (h)) * HTB)
#define PG8_STAGE(bufoff, gbase, voff) do { _Pragma("unroll") for (int _i = 0; _i < 2; ++_i) \
        __builtin_amdgcn_global_load_lds((const unsigned*)((const char*)(gbase) + (voff)[_i]), (PG8_LAS unsigned*)(lds + (bufoff) + ldsw + _i * 8192), 16, 0, 0); } while (0)
#define PG8_LDA(dst, b, h) do { _Pragma("unroll") for (int m = 0; m < 4; ++m) _Pragma("unroll") for (int k = 0; k < 2; ++k) dst[m][k] = *(const PG8_LAS bf16x8*)(lds + PG8_SA(b, h) + aoff + m * 2048 + k * 1024); } while (0)
#define PG8_LDB(dst, b, h) do { _Pragma("unroll") for (int n = 0; n < 2; ++n) _Pragma("unroll") for (int k = 0; k < 2; ++k) dst[n][k] = *(const PG8_LAS bf16x8*)(lds + PG8_SB(b, h) + boff + n * 2048 + k * 1024); } while (0)
#define PG8_MMA(ai, bj, At, Bt) do { __builtin_amdgcn_s_setprio(1); _Pragma("unroll") for (int m = 0; m < 4; ++m) _Pragma("unroll") for (int n = 0; n < 2; ++n) _Pragma("unroll") for (int k = 0; k < 2; ++k) \
        acc[ai][bj][m][n] = __builtin_amdgcn_mfma_f32_16x16x32_bf16(Bt[n][k], At[m][k], acc[ai][bj][m][n], 0, 0, 0); __builtin_amdgcn_s_setprio(0); } while (0)
#define PG8_WAIT_V(n) asm volatile("s_waitcnt vmcnt(" #n ")" ::: "memory")
#define PG8_WAIT_L(n) asm volatile("s_waitcnt lgkmcnt(" #n ")" ::: "memory")
#define PG8_BAR __builtin_amdgcn_s_barrier()
#define PG8_SCHED __builtin_amdgcn_sched_barrier(0)
    Unit cur, nxt; int ui = 0;
    if (!S.next(0, cur)) return;
    f32x4 acc[2][2][4][2];
#pragma unroll
    for (int a = 0; a < 2; ++a)
#pragma unroll
        for (int b = 0; b < 2; ++b)
#pragma unroll
            for (int m = 0; m < 4; ++m)
#pragma unroll
                for (int n = 0; n < 2; ++n) acc[a][b][m][n] = (f32x4){0.f, 0.f, 0.f, 0.f};
    bf16x8 At[4][2], B0[2][2], B1[2][2];
    const char* cA = (const char*)g.A + (size_t)cur.pm * tstep; const char* cB = (const char*)g.Bt + (size_t)cur.pn * tstep;
    S.a_ready(cur);
    if constexpr (SP2) {
        PG8_STAGE(PG8_SB(0, 0), cB, voffB); PG8_STAGE(PG8_SB(0, 1), cB + hstep, voffB); PG8_STAGE(PG8_SA(0, 0), cA, voffA); PG8_STAGE(PG8_SA(0, 1), cA + hstep, voffA);
        if (wr == 1) PG8_BAR;
        PG8_WAIT_V(2); PG8_BAR;
        PG8_STAGE(PG8_SB(1, 0), cB + kstep, voffB); PG8_STAGE(PG8_SA(1, 0), cA + kstep, voffA); PG8_STAGE(PG8_SB(1, 1), cB + hstep + kstep, voffB);
        PG8_WAIT_V(6); PG8_BAR;
    } else {
        PG8_STAGE(PG8_SB(0, 0), cB, voffB); PG8_STAGE(PG8_SA(0, 0), cA, voffA); PG8_STAGE(PG8_SB(0, 1), cB + hstep, voffB); PG8_STAGE(PG8_SA(0, 1), cA + hstep, voffA);
        if (wr == 1) PG8_BAR;
        PG8_WAIT_V(4); PG8_BAR;
        PG8_STAGE(PG8_SB(1, 0), cB + kstep, voffB); PG8_STAGE(PG8_SA(1, 0), cA + kstep, voffA); PG8_STAGE(PG8_SB(1, 1), cB + hstep + kstep, voffB);
        PG8_WAIT_V(6); PG8_BAR;
    }
    for (;;) {
        const bool has_next = S.next(ui + 1, nxt);
        const char* nA = has_next ? (const char*)g.A + (size_t)nxt.pm * tstep : cA; const char* nB = has_next ? (const char*)g.Bt + (size_t)nxt.pn * tstep : cB;
        for (int t = 0; t < nt; t += 2) {
            const bool last = (t == nt - 2);
            const char* a1 = cA + (size_t)(t + 1) * kstep;
            const char* a2 = last ? nA : cA + (size_t)(t + 2) * kstep; const char* b2 = last ? nB : cB + (size_t)(t + 2) * kstep;
            const char* a3 = a2 + kstep; const char* b3 = b2 + kstep;
            if (last && has_next) S.a_ready(nxt);
            if constexpr (SP2) {
            PG8_LDB(B0, 0, 0); PG8_LDB(B1, 0, 1); PG8_SCHED; PG8_LDA(At, 0, 0); PG8_STAGE(PG8_SA(1, 1), a1 + hstep, voffA);
            PG8_WAIT_V(8); PG8_WAIT_L(0); PG8_BAR; PG8_MMA(0, 0, At, B0); PG8_MMA(0, 1, At, B1); PG8_BAR; PG8_SCHED;
            PG8_LDA(At, 0, 1); PG8_STAGE(PG8_SB(0, 0), b2, voffB); PG8_STAGE(PG8_SB(0, 1), b2 + hstep, voffB); PG8_STAGE(PG8_SA(0, 0), a2, voffA);
            PG8_WAIT_V(8); PG8_WAIT_L(0); PG8_BAR; PG8_MMA(1, 0, At, B0); PG8_MMA(1, 1, At, B1); PG8_BAR; PG8_SCHED;
            PG8_LDB(B0, 1, 0); PG8_LDB(B1, 1, 1); PG8_SCHED; PG8_LDA(At, 1, 0); PG8_STAGE(PG8_SA(0, 1), a2 + hstep, voffA);
            PG8_WAIT_V(8); PG8_WAIT_L(0); PG8_BAR; PG8_MMA(0, 0, At, B0); PG8_MMA(0, 1, At, B1); PG8_BAR; PG8_SCHED;
            PG8_LDA(At, 1, 1); PG8_STAGE(PG8_SB(1, 0), b3, voffB); PG8_STAGE(PG8_SB(1, 1), b3 + hstep, voffB); PG8_STAGE(PG8_SA(1, 0), a3, voffA);
            PG8_WAIT_V(8); PG8_WAIT_L(0); PG8_BAR; PG8_MMA(1, 0, At, B0); PG8_MMA(1, 1, At, B1); PG8_BAR; PG8_SCHED;
            } else {
            PG8_LDB(B0, 0, 0); PG8_SCHED; PG8_LDA(At, 0, 0); PG8_STAGE(PG8_SA(1, 1), a1 + hstep, voffA);
            PG8_WAIT_L(8); PG8_BAR; PG8_WAIT_L(0); PG8_MMA(0, 0, At, B0); PG8_BAR; PG8_SCHED;
            PG8_LDB(B1, 0, 1); PG8_STAGE(PG8_SB(0, 0), b2, voffB);
            PG8_BAR; PG8_WAIT_L(0); PG8_MMA(0, 1, At, B1); PG8_BAR;
            PG8_LDA(At, 0, 1); PG8_STAGE(PG8_SA(0, 0), a2, voffA);
            PG8_BAR; PG8_WAIT_L(0); PG8_MMA(1, 0, At, B0); PG8_BAR; PG8_SCHED;
            PG8_STAGE(PG8_SB(0, 1), b2 + hstep, voffB);
            PG8_WAIT_V(6); PG8_BAR; PG8_MMA(1, 1, At, B1); PG8_BAR;
            PG8_LDB(B0, 1, 0); PG8_SCHED; PG8_LDA(At, 1, 0); PG8_STAGE(PG8_SA(0, 1), a2 + hstep, voffA);
            PG8_WAIT_L(8); PG8_BAR; PG8_WAIT_L(0); PG8_MMA(0, 0, At, B0); PG8_BAR; PG8_SCHED;
            PG8_LDB(B1, 1, 1); PG8_STAGE(PG8_SB(1, 0), b3, voffB);
            PG8_BAR; PG8_WAIT_L(0); PG8_MMA(0, 1, At, B1); PG8_BAR;
            PG8_LDA(At, 1, 1); PG8_STAGE(PG8_SA(1, 0), a3, voffA);
            PG8_BAR; PG8_WAIT_L(0); PG8_MMA(1, 0, At, B0); PG8_BAR; PG8_SCHED;
            PG8_STAGE(PG8_SB(1, 1), b3 + hstep, voffB);
            PG8_WAIT_V(6); PG8_BAR; PG8_MMA(1, 1, At, B1); PG8_BAR;
            }
        }
        if constexpr (ALIGN_EPI) { if (wr == 0) PG8_BAR; }
        if constexpr (!Epi::AFTER_DRAIN) { E(acc, cur, wr, wc, fr, fq); S.done(cur); }
        if (!has_next) break;
#pragma unroll
        for (int a = 0; a < 2; ++a)
#pragma unroll
            for (int b = 0; b < 2; ++b)
#pragma unroll
                for (int m = 0; m < 4; ++m)
#pragma unroll
                    for (int n = 0; n < 2; ++n) acc[a][b][m][n] = (f32x4){0.f, 0.f, 0.f, 0.f};
        cur = nxt; cA = nA; cB = nB; ++ui;
        if constexpr (ALIGN_EPI) { if (wr == 1) PG8_BAR; }
    }
    PG8_WAIT_V(0);
    if constexpr (!ALIGN_EPI) { if (wr == 0) PG8_BAR; }
    PG8_BAR;
    if constexpr (Epi::AFTER_DRAIN) { E.fused(acc, cur, wr, wc, fr, fq, lds, wid, lane); S.done(cur); }
#undef PG8_SA
#undef PG8_SB
#undef PG8_STAGE
#undef PG8_LDA
#undef PG8_LDB
#undef PG8_MMA
#undef PG8_WAIT_V
#undef PG8_WAIT_L
#undef PG8_BAR
#undef PG8_SCHED
}
}
constexpr int NWAVES = 8;
#ifndef PROBE_REPEAT
#define PROBE_REPEAT -1
#endif
#ifndef MK_N_LAUNCHES
#define MK_N_LAUNCHES 1
#endif
constexpr int N_PHASES = 12;
constexpr int N_LAUNCHES = MK_N_LAUNCHES;
constexpr int BATCH = 16, SEQ = 2048, DM = 1024, M = BATCH * SEQ, FF = 4096, AB_IN = 2048, CD_IN = 2560;
constexpr float EPS = 1e-6f;
constexpr float QSCALE = 0.125f * 1.4426950408889634f;
constexpr size_t MiB = 1u << 20;
constexpr size_t WS_CTL = 0, CTL_ZERO_BYTES = 1 * MiB;
constexpr size_t WS_WABIN = 2 * MiB, WS_WABOUT = 6 * MiB, WS_W1 = 8 * MiB  , WS_W2 = 24 * MiB  , WS_WCDIN = 40 * MiB, WS_WCDOUT = 46 * MiB, WS_WSGU = 48 * MiB;
constexpr size_t WS_TMPF = 50 * MiB;
constexpr size_t WS_SS = 52 * MiB;
constexpr size_t WS_XN = 56 * MiB;
constexpr size_t WS_MIX = 120 * MiB;
constexpr size_t WS_BIG = 184 * MiB;
constexpr size_t WS_QKV = WS_BIG + 64 * MiB;
constexpr size_t WS_END = 440 * MiB;
constexpr int CW_BAR = 4096;
constexpr int RING_OFF = 0, RING_BYTES = 131072;
constexpr int LDSCTL_OFF = RING_BYTES, MISC_OFF = LDSCTL_OFF + 320;
constexpr int LDS_BYTES = 147456;
#define GAS __attribute__((address_space(1)))
#define LAS __attribute__((address_space(3)))
typedef unsigned short bf16;
typedef unsigned v4u __attribute__((ext_vector_type(4)));
typedef float f32x4 __attribute__((ext_vector_type(4)));
typedef short bf16x8 __attribute__((ext_vector_type(8)));
typedef GAS unsigned gu32;
typedef GAS unsigned long long gu64;
#define RLX_AGENT __ATOMIC_RELAXED, __HIP_MEMORY_SCOPE_AGENT
#define LDS_WAIT() asm volatile("s_waitcnt lgkmcnt(0)" ::: "memory")
#define VM_WAIT() asm volatile("s_waitcnt vmcnt(0)" ::: "memory")
__device__ __forceinline__ unsigned long long rt() { return __builtin_amdgcn_s_memrealtime(); }
__device__ __forceinline__ unsigned f2bf(float f) { unsigned u = __builtin_bit_cast(unsigned, f); return (u + 0x7fffu + ((u >> 16) & 1u)) >> 16; }
__device__ __forceinline__ unsigned pk2(float lo, float hi) { return f2bf(lo) | (f2bf(hi) << 16); }
#define XB_TMO      128
#define XB_XCNT(j)  (256  + 64 * (j))
#define XB_XSUB(j)  (1280 + 64 * (j))
#define XB_XGEN(j)  (2304 + 64 * (j))
#define XB_TOP      3328
#define XB_TOPGEN   3392
#define XCD_BAR_WORDS 3456
#define XB_SPIN_CAP (1u << 18)

__device__ __forceinline__ unsigned xb_ld(unsigned* p)              { return __hip_atomic_load(p, __ATOMIC_RELAXED, __HIP_MEMORY_SCOPE_AGENT); }
__device__ __forceinline__ unsigned xb_add(unsigned* p, unsigned v) { return __hip_atomic_fetch_add(p, v, __ATOMIC_RELAXED, __HIP_MEMORY_SCOPE_AGENT); }
__device__ __forceinline__ unsigned xb_xcc_id() { return (unsigned)__builtin_amdgcn_s_getreg((3 << 11) | 20) & 0xFu; }
#define XB_SPIN(cond, bar) do { unsigned _sp = 0; while (cond) { __builtin_amdgcn_s_sleep(1); \
    if ((++_sp & 255u) == 0u) { if (xb_ld(&(bar)[XB_TMO])) break; if (_sp > XB_SPIN_CAP) { atomicAdd(&(bar)[XB_TMO], 1u); break; } } } } while (0)

struct XcdBarrier {
    unsigned* bar; unsigned x;
    volatile LAS unsigned* st;
};

__device__ __forceinline__ XcdBarrier xcd_barrier_post(unsigned* bar, volatile LAS unsigned* st) {
    XcdBarrier b; b.bar = bar; b.x = xb_xcc_id(); b.st = st;
    if (threadIdx.x == 0) (void)xb_add(&bar[XB_XCNT(b.x)], 1u);
    return b;
}
__device__ __forceinline__ void xcd_barrier_complete(unsigned* bar, unsigned x, unsigned& nloc, unsigned& nx) {
    const unsigned G = gridDim.x * gridDim.y * gridDim.z;
    unsigned sum, cnt, mine, sp = 0u;
    for (;;) {
        sum = 0u; cnt = 0u; mine = 0u;
#pragma unroll
        for (unsigned j = 0; j < 16; ++j) { const unsigned c = xb_ld(&bar[XB_XCNT(j)]); sum += c; cnt += (c > 0u) ? 1u : 0u; mine = (j == x) ? c : mine; }
        if (sum == G) break;
        __builtin_amdgcn_s_sleep(1);
        if ((++sp & 255u) == 0u) { if (xb_ld(&bar[XB_TMO])) break; if (sp > XB_SPIN_CAP) { atomicAdd(&bar[XB_TMO], 1u); break; } }
    }
    nloc = mine > 0u ? mine : 1u; nx = cnt > 0u ? cnt : 1u;
}

__device__ __forceinline__ void xcd_barrier(const XcdBarrier& b) {
    asm volatile("s_waitcnt vmcnt(0)" ::: "memory");
    __syncthreads();
    if (threadIdx.x == 0) {
        unsigned* bar = b.bar;
        __builtin_amdgcn_s_waitcnt(0);
        unsigned nloc = b.st[0], nx = b.st[1];
        if (nloc == 0u) { xcd_barrier_complete(bar, b.x, nloc, nx); b.st[0] = nloc; b.st[1] = nx; }
        const unsigned old = xb_add(&bar[XB_XSUB(b.x)], 1u);
        const unsigned gen = old / nloc;
        if (old + 1u == (gen + 1u) * nloc) {
            __builtin_amdgcn_fence(__ATOMIC_RELEASE, "agent");
            asm volatile("s_waitcnt vmcnt(0)" ::: "memory");
            const unsigned og = xb_add(&bar[XB_TOP], 1u);
            const unsigned tg = og / nx;
            if (og + 1u == (tg + 1u) * nx) xb_add(&bar[XB_TOPGEN], 1u);
            else XB_SPIN(xb_ld(&bar[XB_TOPGEN]) == tg, bar);
            __builtin_amdgcn_fence(__ATOMIC_ACQUIRE, "agent");
            xb_add(&bar[XB_XGEN(b.x)], 1u);
            asm volatile("s_waitcnt vmcnt(0)" ::: "memory");
        } else {
            XB_SPIN(xb_ld(&bar[XB_XGEN(b.x)]) == gen, bar);
            __builtin_amdgcn_fence(__ATOMIC_ACQUIRE, "agent");
            asm volatile("s_waitcnt vmcnt(0)" ::: "memory");
        }
    }
    __syncthreads();
}
struct Frame {
    LAS unsigned char* lds;
    volatile LAS unsigned* MISC;
    gu32* ctl;
    int tid, lane, wave;
    int vcu, G;
    const float* in[18]; float* out; unsigned char* ws;
};
__device__ __forceinline__ float bf2f(unsigned short b) { return __builtin_bit_cast(float, (unsigned)b << 16); }
__device__ __forceinline__ float wave_sum(float v) {
#pragma unroll
    for (int o = 1; o < 64; o <<= 1) v += __shfl_xor(v, o);
    return v;
}
__device__ __forceinline__ void unpack8(const v4u r, float* f) {
    f[0] = __builtin_bit_cast(float, r.x << 16); f[1] = __builtin_bit_cast(float, r.x & 0xffff0000u);
    f[2] = __builtin_bit_cast(float, r.y << 16); f[3] = __builtin_bit_cast(float, r.y & 0xffff0000u);
    f[4] = __builtin_bit_cast(float, r.z << 16); f[5] = __builtin_bit_cast(float, r.z & 0xffff0000u);
    f[6] = __builtin_bit_cast(float, r.w << 16); f[7] = __builtin_bit_cast(float, r.w & 0xffff0000u);
}
__device__ __forceinline__ v4u pack8(const float* f) { v4u o; o.x = pk2(f[0], f[1]); o.y = pk2(f[2], f[3]); o.z = pk2(f[4], f[5]); o.w = pk2(f[6], f[7]); return o; }

__device__ __forceinline__ void transpose_item(const float* W, const float* gk, int K, int N, bf16* WT, LAS float* scr, int item, int lane) {
    const int nblk = N / 32, kb = item / nblk, nb = item % nblk, k0 = 64 * kb, n0 = 32 * nb;
#pragma unroll 8
    for (int i = 0; i < 32; ++i) { const int kk = 2 * i + (lane >> 5); const float g = gk ? gk[k0 + kk] : 1.0f; scr[kk * 33 + (lane & 31)] = W[(size_t)(k0 + kk) * N + n0 + (lane & 31)] * g; }
    LDS_WAIT(); asm volatile("" ::: "memory");
    const int c = lane & 7;
#pragma unroll
    for (int j = 0; j < 4; ++j) { const int n = (lane >> 3) + 8 * j; const LAS float* s = scr + (8 * c) * 33 + n;
        v4u o; o.x = pk2(s[0 * 33], s[1 * 33]); o.y = pk2(s[2 * 33], s[3 * 33]); o.z = pk2(s[4 * 33], s[5 * 33]); o.w = pk2(s[6 * 33], s[7 * 33]);
        *(GAS v4u*)(WT + (size_t)(n0 + n) * K + k0 + 8 * c) = o; }
    LDS_WAIT(); asm volatile("" ::: "memory");
}

__device__ __forceinline__ void p0_prologue(Frame& F) {
    LAS float* scr = (LAS float*)(F.lds + RING_OFF + F.wave * 16384);
    const int gw = F.vcu * NWAVES + F.wave, NGW = F.G * NWAVES;
    const float* mixg = F.in[1]; const float* mlpg = F.in[2];
    constexpr int I_ABIN = (DM / 64) * (AB_IN / 32), I_W1 = (DM / 64) * (FF / 32), I_W2 = (FF / 64) * (DM / 32), I_CDIN = (DM / 64) * (CD_IN / 32), I_CDOUT = (DM / 64) * (DM / 32);
    constexpr int NITEMS = I_ABIN + 2 * I_W1 + 2 * I_W2 + I_CDIN + I_CDOUT;
    for (int it = gw; it < NITEMS; it += NGW) {
        int r = it;
        if (r < I_ABIN) { transpose_item(F.in[3], nullptr, DM, AB_IN, (bf16*)(F.ws + WS_WABIN), scr, r, F.lane); continue; } r -= I_ABIN;
        if (r < I_W1) { transpose_item(F.in[15], mlpg, DM, FF, (bf16*)(F.ws + WS_W1), scr, r, F.lane); continue; } r -= I_W1;
        if (r < I_W1) { transpose_item(F.in[15] + (size_t)DM * FF, mlpg + DM, DM, FF, (bf16*)(F.ws + WS_W1 + 8 * MiB), scr, r, F.lane); continue; } r -= I_W1;
        if (r < I_W2) { transpose_item(F.in[16], nullptr, FF, DM, (bf16*)(F.ws + WS_W2), scr, r, F.lane); continue; } r -= I_W2;
        if (r < I_W2) { transpose_item(F.in[16] + (size_t)FF * DM, nullptr, FF, DM, (bf16*)(F.ws + WS_W2 + 8 * MiB), scr, r, F.lane); continue; } r -= I_W2;
        if (r < I_CDIN) { transpose_item(F.in[9], mixg + DM, DM, CD_IN, (bf16*)(F.ws + WS_WCDIN), scr, r, F.lane); continue; } r -= I_CDIN;
        transpose_item(F.in[14], nullptr, DM, DM, (bf16*)(F.ws + WS_WCDOUT), scr, r, F.lane);
    }
    { const float* pw = F.in[4]; const float* psc = F.in[5]; const float* wo = F.in[8]; float* tmp = (float*)(F.ws + WS_TMPF);
      for (int it = gw; it < 512 * 16; it += NGW) { const int k = it >> 4, n = (it & 15) * 64 + F.lane, g = k >> 7;
          const float* pwr = pw + (size_t)k * 128; const float* scr_ = psc + g * 128; const float* wor = wo + (size_t)(g * 128) * DM + n; float a = 0.f;
#pragma unroll 8
          for (int d = 0; d < 128; ++d) a += (pwr[d] * scr_[d]) * wor[(size_t)d * DM];
          tmp[(size_t)k * DM + n] = a; } }
    { const float* sw = F.in[12]; bf16* wc = (bf16*)(F.ws + WS_WSGU);
      for (int it = gw * 64 + F.lane; it < 4 * 128 * 16; it += NGW * 64) { const int tt = (it >> 4) & 127, s0 = (it & 15) * 8; float f[8];
#pragma unroll
          for (int e = 0; e < 8; ++e) f[e] = (s0 + e <= tt) ? sw[(size_t)it * 8 + e] : 0.f;
          *(GAS v4u*)(wc + (size_t)it * 8) = pack8(f); } }
    { const float* x = F.in[0]; bf16* xn = (bf16*)(F.ws + WS_XN);
      for (int m = gw; m < M; m += NGW) { const GAS f32x4* xr = (const GAS f32x4*)(x + (size_t)m * DM) + F.lane; const GAS f32x4* gr = (const GAS f32x4*)mixg + F.lane;
          f32x4 v[4]; float s = 0.f;
#pragma unroll
          for (int j = 0; j < 4; ++j) { v[j] = xr[64 * j]; s += (v[j].x * v[j].x + v[j].y * v[j].y) + (v[j].z * v[j].z + v[j].w * v[j].w); }
          const float rstd = 1.0f / sqrtf(wave_sum(s) * (1.f / DM) + EPS);
          GAS unsigned long long* o8 = (GAS unsigned long long*)(xn + (size_t)m * DM) + F.lane;
#pragma unroll
          for (int j = 0; j < 4; ++j) { const f32x4 g = gr[64 * j]; o8[64 * j] = (unsigned long long)pk2(v[j].x * rstd * g.x, v[j].y * rstd * g.y) | ((unsigned long long)pk2(v[j].z * rstd * g.z, v[j].w * rstd * g.w) << 32); } } }
}

__device__ __forceinline__ void p2_mixer_ab(Frame& F) {
    { LAS float* scr = (LAS float*)(F.lds + RING_OFF + F.wave * 16384); const int gw = F.vcu * NWAVES + F.wave, NGW = F.G * NWAVES;
      bf16* wt = (bf16*)(F.ws + WS_WABOUT);
      for (int it = gw; it < (DM / 64) * (DM / 32); it += NGW) {
          const int kb = it / (DM / 32);
          transpose_item(kb < 8 ? (const float*)(F.ws + WS_TMPF) : F.in[8], nullptr, DM, DM, wt, scr, it, F.lane); } }
    const bf16* P = (const bf16*)(F.ws + WS_BIG); bf16* MX = (bf16*)(F.ws + WS_MIX);
    const float* cw = F.in[6]; const float* cb = F.in[7];
    const int tl = F.tid >> 7, ch = F.tid & 127;
    for (int u = F.vcu; u < BATCH * 32; u += F.G) {
        const int b = u >> 5, seg = u & 31, t0 = seg * 64 + tl * 16; const size_t rb = (size_t)b * SEQ;
        if (ch < 64) {
            const int c0 = ch * 8, g = ch >> 4, w = 2 << g; float sum[8], a[8];
#pragma unroll
            for (int e = 0; e < 8; ++e) sum[e] = 0.f;
            for (int j = (t0 - w + 1 > 0 ? t0 - w + 1 : 0); j < t0; ++j) { unpack8(*(const GAS v4u*)(P + (rb + j) * AB_IN + c0), a);
#pragma unroll
                for (int e = 0; e < 8; ++e) sum[e] += a[e]; }
            for (int i = 0; i < 16; ++i) { const int t = t0 + i; unpack8(*(const GAS v4u*)(P + (rb + t) * AB_IN + c0), a);
                const float inv = 1.0f / (float)(t + 1 < w ? t + 1 : w); float o[8];
#pragma unroll
                for (int e = 0; e < 8; ++e) { sum[e] += a[e]; o[e] = sum[e] * inv - a[e]; }
                *(GAS v4u*)(MX + (rb + t) * DM + c0) = pack8(o);
                if (t - w + 1 >= 0) { unpack8(*(const GAS v4u*)(P + (rb + t - w + 1) * AB_IN + c0), a);
#pragma unroll
                    for (int e = 0; e < 8; ++e) sum[e] -= a[e]; } }
        } else {
            const int cc = (ch - 64) * 8; float w0[8], w1[8], w2[8], bb[8], g1[8], g2[8], xb[8], gb[8], gc[8];
#pragma unroll
            for (int e = 0; e < 8; ++e) { w0[e] = cw[cc + e]; w1[e] = cw[512 + cc + e]; w2[e] = cw[1024 + cc + e]; bb[e] = cb[cc + e]; g1[e] = 0.f; g2[e] = 0.f; }
            if (t0 >= 1) { unpack8(*(const GAS v4u*)(P + (rb + t0 - 1) * AB_IN + 512 + cc), xb); unpack8(*(const GAS v4u*)(P + (rb + t0 - 1) * AB_IN + 1536 + cc), gc);
#pragma unroll
                for (int e = 0; e < 8; ++e) g1[e] = gc[e] * xb[e]; }
            if (t0 >= 2) { unpack8(*(const GAS v4u*)(P + (rb + t0 - 2) * AB_IN + 512 + cc), xb); unpack8(*(const GAS v4u*)(P + (rb + t0 - 2) * AB_IN + 1536 + cc), gc);
#pragma unroll
                for (int e = 0; e < 8; ++e) g2[e] = gc[e] * xb[e]; }
            for (int i = 0; i < 16; ++i) { const int t = t0 + i; const bf16* pr = P + (rb + t) * AB_IN;
                unpack8(*(const GAS v4u*)(pr + 512 + cc), xb); unpack8(*(const GAS v4u*)(pr + 1024 + cc), gb); unpack8(*(const GAS v4u*)(pr + 1536 + cc), gc); float o[8];
#pragma unroll
                for (int e = 0; e < 8; ++e) { const float g0 = gc[e] * xb[e]; o[e] = gb[e] * (w0[e] * g2[e] + w1[e] * g1[e] + w2[e] * g0 + bb[e]); g2[e] = g1[e]; g1[e] = g0; }
                *(GAS v4u*)(MX + (rb + t) * DM + 512 + cc) = pack8(o); }
        }
    }
}
namespace sba {
using bf16x8 = __attribute__((ext_vector_type(8))) short;
using f16x8 = __attribute__((ext_vector_type(8))) _Float16;
using s16x4 = __attribute__((ext_vector_type(4))) short;
using f32x16 = __attribute__((ext_vector_type(16))) float;
using u32x4 = __attribute__((ext_vector_type(4))) unsigned;
typedef short v4i16_t __attribute__((ext_vector_type(4)));
typedef float f32x2_t __attribute__((ext_vector_type(2))); typedef __bf16 bf16x2_t __attribute__((ext_vector_type(2))); typedef _Float16 f16x2_t __attribute__((ext_vector_type(2)));
typedef __attribute__((address_space(3))) const char* lds_cptr;
typedef __attribute__((address_space(3))) char* lds_ptr;
__device__ __forceinline__ unsigned pk_bf16(float lo, float hi) { f32x2_t v = {lo, hi}; bf16x2_t b = __builtin_convertvector(v, bf16x2_t); return __builtin_bit_cast(unsigned, b); }
__device__ __forceinline__ unsigned pk_f16(float lo, float hi) { f32x2_t v = {lo, hi}; f16x2_t b = __builtin_convertvector(v, f16x2_t); return __builtin_bit_cast(unsigned, b); }
__device__ __forceinline__ s16x4 vtr(lds_cptr p) { return __builtin_bit_cast(s16x4, __builtin_amdgcn_ds_read_tr16_b64_v4i16((__attribute__((address_space(3))) v4i16_t*)p)); }
#define SB_MFMA_BF16(a, b, c) __builtin_amdgcn_mfma_f32_32x32x16_bf16((a), (b), (c), 0, 0, 0)
#define SB_MFMA_F16(a, b, c) __builtin_amdgcn_mfma_f32_32x32x16_f16((a), (b), (c), 0, 0, 0)
constexpr int KV = 64, SLOT = 16384;

template <bool DIAG>
__device__ __forceinline__ void tile(lds_cptr Kb, lds_cptr Vb, const bf16x8 (&qf)[4], f32x16& o0, f32x16& o1, f32x16& carry,
                                     const f16x8 T0, const f16x8 T1, const f16x8 ONES, int r, int hi, int lane, int limA) {
    f32x16 p0, p1;
#pragma unroll
    for (int i = 0; i < 16; ++i) { p0[i] = 0.f; p1[i] = 0.f; }
    const lds_cptr kp = Kb + hi * 1024 + r * 16;
#pragma unroll
    for (int d0 = 0; d0 < 4; ++d0) {
        const bf16x8 a0 = *(const __attribute__((address_space(3))) bf16x8*)(kp + d0 * 2048);
        const bf16x8 a1 = *(const __attribute__((address_space(3))) bf16x8*)(kp + d0 * 2048 + 512);
        p0 = SB_MFMA_BF16(a0, qf[d0], p0); p1 = SB_MFMA_BF16(a1, qf[d0], p1); }
    unsigned l0p[8], l1p[8];
#pragma unroll
    for (int i = 0; i < 16; i += 2) {
        float n0[2], n1[2];
#pragma unroll
        for (int e = 0; e < 2; ++e) { const int ci = ((i + e) & 3) + 8 * ((i + e) >> 2);
            { const float S = p0[i + e]; const float ex = __builtin_amdgcn_exp2f(-__builtin_fabsf(S)), l = __builtin_amdgcn_logf(1.0f + ex); float nsp = __builtin_fminf(-S, 0.f) - l;
              if (DIAG) nsp = (ci < limA) ? nsp : 0.f; n0[e] = nsp; p0[i + e] = S + nsp; }
            { const float S = p1[i + e]; const float ex = __builtin_amdgcn_exp2f(-__builtin_fabsf(S)), l = __builtin_amdgcn_logf(1.0f + ex); float nsp = __builtin_fminf(-S, 0.f) - l;
              if (DIAG) nsp = (ci + 32 < limA) ? nsp : 0.f; n1[e] = nsp; p1[i + e] = S + nsp; } }
        l0p[i >> 1] = pk_f16(n0[0], n0[1]); l1p[i >> 1] = pk_f16(n1[0], n1[1]); }
    const f16x8 l0a = __builtin_bit_cast(f16x8, (u32x4){l0p[0], l0p[1], l0p[2], l0p[3]}), l0b = __builtin_bit_cast(f16x8, (u32x4){l0p[4], l0p[5], l0p[6], l0p[7]});
    const f16x8 l1a = __builtin_bit_cast(f16x8, (u32x4){l1p[0], l1p[1], l1p[2], l1p[3]}), l1b = __builtin_bit_cast(f16x8, (u32x4){l1p[4], l1p[5], l1p[6], l1p[7]});
    f32x16 u1 = SB_MFMA_F16(ONES, l1a, carry); u1 = SB_MFMA_F16(ONES, l1b, u1);
    f32x16 y0 = SB_MFMA_F16(T0, l0a, u1); y0 = SB_MFMA_F16(T1, l0b, y0);
    f32x16 y1 = SB_MFMA_F16(T0, l1a, carry); y1 = SB_MFMA_F16(T1, l1b, y1);
    carry = SB_MFMA_F16(ONES, l0a, u1); carry = SB_MFMA_F16(ONES, l0b, carry);
    unsigned w0p[8], w1p[8];
#pragma unroll
    for (int i = 0; i < 16; i += 2) {
        float a[2], b[2];
#pragma unroll
        for (int e = 0; e < 2; ++e) { const int ci = ((i + e) & 3) + 8 * ((i + e) >> 2);
            a[e] = __builtin_amdgcn_exp2f(p0[i + e] + y0[i + e]); b[e] = __builtin_amdgcn_exp2f(p1[i + e] + y1[i + e]);
            if (DIAG) { a[e] = (ci < limA) ? a[e] : 0.f; b[e] = (ci + 32 < limA) ? b[e] : 0.f; } }
        w0p[i >> 1] = pk_bf16(a[0], a[1]); w1p[i >> 1] = pk_bf16(b[0], b[1]); }
    const bf16x8 pa0 = __builtin_bit_cast(bf16x8, (u32x4){w0p[0], w0p[1], w0p[2], w0p[3]}), pa1 = __builtin_bit_cast(bf16x8, (u32x4){w0p[4], w0p[5], w0p[6], w0p[7]});
    const bf16x8 pa2 = __builtin_bit_cast(bf16x8, (u32x4){w1p[0], w1p[1], w1p[2], w1p[3]}), pa3 = __builtin_bit_cast(bf16x8, (u32x4){w1p[4], w1p[5], w1p[6], w1p[7]});
    const lds_cptr vp = Vb + ((lane >> 4) & 1) * 32 + (lane & 3) * 8 + (4 * hi + ((lane & 15) >> 2)) * 64;
#pragma unroll
    for (int d0 = 0; d0 < 2; ++d0) {
        s16x4 lo[4], hh[4];
#pragma unroll
        for (int ks = 0; ks < 4; ++ks) { lo[ks] = vtr(vp + d0 * 4096 + ks * 1024); hh[ks] = vtr(vp + d0 * 4096 + ks * 1024 + 512); }
#define SB_PK(k) (bf16x8){lo[k][0], lo[k][1], lo[k][2], lo[k][3], hh[k][0], hh[k][1], hh[k][2], hh[k][3]}
        f32x16 o = d0 == 0 ? o0 : o1;
        o = SB_MFMA_BF16(pa0, SB_PK(0), o); o = SB_MFMA_BF16(pa1, SB_PK(1), o); o = SB_MFMA_BF16(pa2, SB_PK(2), o); o = SB_MFMA_BF16(pa3, SB_PK(3), o);
        if (d0 == 0) o0 = o; else o1 = o;
#undef SB_PK
    }
}
}

__device__ __forceinline__ void p7_attention_mfma(Frame& F) {
    using namespace sba;
    const bf16* QKV = (const bf16*)(F.ws + WS_QKV); bf16* MX = (bf16*)(F.ws + WS_MIX);
    const lds_ptr L = (lds_ptr)(F.lds + RING_OFF);
    volatile LAS unsigned* dflag = (volatile LAS unsigned*)(F.lds + RING_OFF + 2 * sba::SLOT);
    const int lane = F.lane, r = lane & 31, hi = lane >> 5, w = F.wave;
    unsigned t0w[4], t1w[4];
#pragma unroll
    for (int jj = 0; jj < 4; ++jj) { const int j = 2 * jj; const int k0 = 8 * (j >> 2) + 4 * hi + (j & 3), k1 = k0 + 1;
        t0w[jj] = (k0 > r ? 0x3C00u : 0u) | (k1 > r ? 0x3C000000u : 0u); t1w[jj] = (k0 + 16 > r ? 0x3C00u : 0u) | (k1 + 16 > r ? 0x3C000000u : 0u); }
    const f16x8 T0 = __builtin_bit_cast(f16x8, (u32x4){t0w[0], t0w[1], t0w[2], t0w[3]}), T1 = __builtin_bit_cast(f16x8, (u32x4){t1w[0], t1w[1], t1w[2], t1w[3]});
    const f16x8 ONES = __builtin_bit_cast(f16x8, (u32x4){0x3C003C00u, 0x3C003C00u, 0x3C003C00u, 0x3C003C00u});
    const int limA = 32 * (w & 1) + r - 4 * hi;
    const int skv = F.tid & 63, sch = F.tid >> 6;
    const int kdst = sch * 1024 + skv * 16, vdst = 8192 + (sch >> 2) * 4096 + skv * 64 + (sch & 3) * 16;
    for (int u = F.vcu; u < 1024; u += F.G) {
        const int bh = (u & 255) >> 1, ii = (u >> 8) & 3, odd = u & 1;
        const int qb = odd ? (ii == 0 ? 1 : ii == 1 ? 6 : ii == 2 ? 2 : 5) : (ii == 0 ? 0 : ii == 1 ? 7 : ii == 2 ? 3 : 4);
        const int b = bh >> 3, h = bh & 7; const size_t rb = (size_t)b * SEQ;
        const bf16* kbase = QKV + rb * 1536 + 512 + h * 64 + sch * 8;
        bf16x8 qf[4];
        { const bf16* qp = QKV + (rb + 256 * qb + 32 * w + r) * 1536 + h * 64 + hi * 8;
#pragma unroll
          for (int d0 = 0; d0 < 4; ++d0) qf[d0] = *(const bf16x8*)(qp + d0 * 16); }
        f32x16 o0, o1, carry;
#pragma unroll
        for (int i = 0; i < 16; ++i) { o0[i] = 0.f; o1[i] = 0.f; carry[i] = 0.f; }
        const int ttd = 4 * qb + (w >> 1), ntile = 4 * qb + 4;
        __syncthreads();
        { const bf16* kp = kbase + (size_t)((ntile - 1) * KV + skv) * 1536; const v4u kr = *(const GAS v4u*)kp, vr = *(const GAS v4u*)(kp + 512);
          *(__attribute__((address_space(3))) v4u*)(L + kdst) = kr; *(__attribute__((address_space(3))) v4u*)(L + vdst) = vr; }
        __syncthreads();
        int cur = 0; bool wdone = false;
        for (int tt = ntile - 1; tt >= 0; --tt) {
            v4u kr, vr;
            if (tt > 0) { const bf16* kp = kbase + (size_t)((tt - 1) * KV + skv) * 1536; kr = *(const GAS v4u*)kp; vr = *(const GAS v4u*)(kp + 512); }
            const lds_cptr Kb = (lds_cptr)(L + cur * SLOT), Vb = Kb + 8192;
            if (!wdone) {
                if (tt < ttd) { tile<false>(Kb, Vb, qf, o0, o1, carry, T0, T1, ONES, r, hi, lane, limA); wdone = __all(carry[0] < -150.0f) != 0; }
                else if (tt == ttd) { tile<true>(Kb, Vb, qf, o0, o1, carry, T0, T1, ONES, r, hi, lane, limA); wdone = __all(carry[0] < -150.0f) != 0; }
            }
            if (tt > 0) { *(__attribute__((address_space(3))) v4u*)(L + (cur ^ 1) * SLOT + kdst) = kr; *(__attribute__((address_space(3))) v4u*)(L + (cur ^ 1) * SLOT + vdst) = vr; }
            if (lane == 0) dflag[(tt & 1) * 8 + w] = wdone ? 1u : 0u;
            __syncthreads();
            { const unsigned f = dflag[(tt & 1) * 8 + (lane & 7)]; if (__all(f != 0u)) break; }
            cur ^= 1;
        }
        { bf16* op = MX + (rb + 256 * qb + 32 * w) * DM + 512 + h * 64 + r;
#pragma unroll
          for (int i = 0; i < 16; ++i) { const int q = (i & 3) + 8 * (i >> 2) + 4 * hi;
              op[(size_t)q * DM] = (bf16)f2bf(o0[i]); op[(size_t)q * DM + 32] = (bf16)f2bf(o1[i]); } }
    }
    __syncthreads();
}

__device__ __forceinline__ void p7_attention(Frame& F) {
    typedef float f4 __attribute__((ext_vector_type(4)));
    LAS f4* Ks = (LAS f4*)(F.lds + RING_OFF); LAS f4* Vs = Ks + 1024;
    const bf16* QKV = (const bf16*)(F.ws + WS_QKV); bf16* MX = (bf16*)(F.ws + WS_MIX);
    for (int u = F.vcu; u < 512; u += F.G) {
        const int bh = (u & 255) >> 1, q01 = u & 1, qq = (u >> 8) ? 3 - q01 : q01, b = bh >> 3, h = bh & 7;
        const int t = 512 * qq + F.tid; const size_t rb = (size_t)b * SEQ;
        float q[64], o[64];
        { const bf16* qp = QKV + (rb + t) * 1536 + h * 64;
#pragma unroll
          for (int c = 0; c < 8; ++c) unpack8(*(const GAS v4u*)(qp + c * 8), q + c * 8); }
#pragma unroll
        for (int d = 0; d < 64; ++d) o[d] = 0.f;
        float carry = 0.f;
        const int wave_tmax = 512 * qq + 64 * F.wave + 63;
        for (int tt = 8 * qq + 7; tt >= 0; --tt) {
            __syncthreads();
            { const int kk = F.tid >> 3, c8 = F.tid & 7; const bf16* kp = QKV + (rb + tt * 64 + kk) * 1536 + 512 + h * 64 + c8 * 8; float f[8];
              unpack8(*(const GAS v4u*)kp, f); Ks[kk * 16 + c8 * 2] = (f4){f[0], f[1], f[2], f[3]}; Ks[kk * 16 + c8 * 2 + 1] = (f4){f[4], f[5], f[6], f[7]};
              unpack8(*(const GAS v4u*)(kp + 512), f); Vs[kk * 16 + c8 * 2] = (f4){f[0], f[1], f[2], f[3]}; Vs[kk * 16 + c8 * 2 + 1] = (f4){f[4], f[5], f[6], f[7]}; }
            __syncthreads();
            if (tt * 64 < wave_tmax) {
                for (int s = 63; s >= 0; --s) {
                    float d0 = 0.f, d1 = 0.f;
#pragma unroll
                    for (int c = 0; c < 16; c += 2) { const f4 k0 = Ks[s * 16 + c], k1 = Ks[s * 16 + c + 1];
                        d0 += q[4 * c] * k0.x + q[4 * c + 1] * k0.y + q[4 * c + 2] * k0.z + q[4 * c + 3] * k0.w;
                        d1 += q[4 * c + 4] * k1.x + q[4 * c + 5] * k1.y + q[4 * c + 6] * k1.z + q[4 * c + 7] * k1.w; }
                    const float S = d0 + d1; const bool valid = (tt * 64 + s) < t;
                    const float e = __builtin_amdgcn_exp2f(-fabsf(S)), l = __builtin_amdgcn_logf(1.0f + e), nsp = fminf(-S, 0.f) - l, lb = S + nsp;
                    const float w = valid ? __builtin_amdgcn_exp2f(lb + carry) : 0.f; carry += valid ? nsp : 0.f;
#pragma unroll
                    for (int c = 0; c < 16; ++c) { const f4 v = Vs[s * 16 + c]; o[4 * c] += w * v.x; o[4 * c + 1] += w * v.y; o[4 * c + 2] += w * v.z; o[4 * c + 3] += w * v.w; }
                }
            }
        }
        { bf16* op = MX + (rb + t) * DM + 512 + h * 64;
#pragma unroll
          for (int c = 0; c < 8; ++c) *(GAS v4u*)(op + c * 8) = pack8(o + c * 8); }
    }
    __syncthreads();
}
__device__ __forceinline__ void p7_sgu_mfma(Frame& F) {
    typedef __attribute__((address_space(3))) unsigned short lds_u16;
    constexpr int PITCH = 136;
    LAS float* st = (LAS float*)(F.lds + RING_OFF); LAS unsigned char* VT = F.lds + RING_OFF + 1024;
    const bf16* UV = (const bf16*)(F.ws + WS_BIG); bf16* MX = (bf16*)(F.ws + WS_MIX); const bf16* WC = (const bf16*)(F.ws + WS_WSGU);
    const float* gam = F.in[10]; const float* bet = F.in[11]; const float* sb = F.in[13];
    const int lane = F.lane, w = F.wave, fr = lane & 15, fq = lane >> 4;
    for (int u = F.vcu; u < 256; u += F.G) {
        const size_t row0 = (size_t)(u >> 4) * SEQ + (size_t)(u & 15) * 128;
        __syncthreads();
        for (int i = 0; i < 16; ++i) { const int s = 16 * w + i; float f[8]; unpack8(*(const GAS v4u*)(UV + (row0 + s) * 1024 + 512 + lane * 8), f);
            float a = 0.f;
#pragma unroll
            for (int e = 0; e < 8; ++e) a += f[e];
            const float mean = wave_sum(a) * (1.0f / 512.0f); float qv = 0.f;
#pragma unroll
            for (int e = 0; e < 8; ++e) { const float d = f[e] - mean; qv += d * d; }
            const float rstd = 1.0f / sqrtf(wave_sum(qv) * (1.0f / 512.0f) + EPS);
            if (lane == 0) { st[s] = mean; st[128 + s] = rstd; } }
        __syncthreads();
        for (int g = 0; g < 4; ++g) {
            { const int s = 64 * (w & 1) + lane, cq = w >> 1; const float mean = st[s], rstd = st[128 + s];
#pragma unroll
              for (int j = 0; j < 4; ++j) { const int c0 = (4 * cq + j) * 8; float f[8]; unpack8(*(const GAS v4u*)(UV + (row0 + s) * 1024 + 512 + g * 128 + c0), f);
#pragma unroll
                  for (int e = 0; e < 8; ++e) { const float vn = (f[e] - mean) * rstd * gam[g * 128 + c0 + e] + bet[g * 128 + c0 + e];
                      *(lds_u16*)(VT + ((c0 + e) * PITCH + s) * 2) = (unsigned short)f2bf(vn); } } }
            __syncthreads();
            { pg8::f32x4 acc[8];
#pragma unroll
              for (int ct = 0; ct < 8; ++ct) acc[ct] = (pg8::f32x4){0.f, 0.f, 0.f, 0.f};
              const int t = 16 * w + fr; const bf16* wrow = WC + ((size_t)g * 128 + t) * 128 + 8 * fq;
              for (int ks = 0; ks <= (w >> 1); ++ks) {
                  const bf16x8 bfr = *(const bf16x8*)(wrow + 32 * ks);
#pragma unroll
                  for (int ct = 0; ct < 8; ++ct) { const bf16x8 afr = *(const LAS bf16x8*)(VT + ((16 * ct + fr) * PITCH + 32 * ks + 8 * fq) * 2);
                      acc[ct] = __builtin_amdgcn_mfma_f32_16x16x32_bf16(afr, bfr, acc[ct], 0, 0, 0); } }
              const float bias = sb[g * 128 + t]; const size_t ro = (row0 + t) * 1024 + g * 128 + 4 * fq;
#pragma unroll
              for (int ct = 0; ct < 8; ++ct) { const unsigned long long uu = *(const GAS unsigned long long*)(UV + ro + 16 * ct);
                  const float u0 = __builtin_bit_cast(float, (unsigned)(uu << 16)), u1 = __builtin_bit_cast(float, (unsigned)uu & 0xffff0000u), u2 = __builtin_bit_cast(float, (unsigned)(uu >> 32) << 16), u3 = __builtin_bit_cast(float, (unsigned)(uu >> 32) & 0xffff0000u);
                  const unsigned long long o = (unsigned long long)pk2(u0 * (acc[ct][0] + bias), u1 * (acc[ct][1] + bias)) | ((unsigned long long)pk2(u2 * (acc[ct][2] + bias), u3 * (acc[ct][3] + bias)) << 32);
                  *(GAS unsigned long long*)(MX + ro + 16 * ct) = o; } }
            __syncthreads();
        }
    }
}

__device__ __forceinline__ void p7_sgu(Frame& F) {
    LAS float* st = (LAS float*)(F.lds + RING_OFF); LAS float* VN = st + 256;
    const bf16* UV = (const bf16*)(F.ws + WS_BIG); bf16* MX = (bf16*)(F.ws + WS_MIX);
    const float* gam = F.in[10]; const float* bet = F.in[11]; const float* sw = F.in[12]; const float* sb = F.in[13];
    for (int u = F.vcu; u < 256; u += F.G) {
        const size_t row0 = (size_t)(u >> 4) * SEQ + (size_t)(u & 15) * 128;
        __syncthreads();
        for (int i = 0; i < 16; ++i) { const int s = 16 * F.wave + i; float f[8]; unpack8(*(const GAS v4u*)(UV + (row0 + s) * 1024 + 512 + F.lane * 8), f);
            float a = 0.f;
#pragma unroll
            for (int e = 0; e < 8; ++e) a += f[e];
            const float mean = wave_sum(a) * (1.0f / 512.0f); float qv = 0.f;
#pragma unroll
            for (int e = 0; e < 8; ++e) { const float d = f[e] - mean; qv += d * d; }
            const float rstd = 1.0f / sqrtf(wave_sum(qv) * (1.0f / 512.0f) + EPS);
            if (F.lane == 0) { st[s] = mean; st[128 + s] = rstd; } }
        __syncthreads();
        for (int g = 0; g < 4; ++g) {
            { const int s = F.tid >> 2, cq = F.tid & 3; const float mean = st[s], rstd = st[128 + s];
#pragma unroll
              for (int j = 0; j < 4; ++j) { const int c = cq * 32 + j * 8; float f[8]; unpack8(*(const GAS v4u*)(UV + (row0 + s) * 1024 + 512 + g * 128 + c), f);
#pragma unroll
                  for (int e = 0; e < 8; ++e) VN[s * 128 + c + e] = (f[e] - mean) * rstd * gam[g * 128 + c + e] + bet[g * 128 + c + e]; } }
            __syncthreads();
            { const int c = F.tid & 127, tq = F.tid >> 7;
              for (int i = 0; i < 32; ++i) { const int t = tq * 32 + i; const float* wr = sw + ((size_t)g * 128 + t) * 128; float a = 0.f;
                  for (int s = 0; s <= t; ++s) a += wr[s] * VN[s * 128 + c];
                  const float uu = bf2f(UV[(row0 + t) * 1024 + g * 128 + c]);
                  MX[(row0 + t) * DM + g * 128 + c] = (bf16)f2bf(uu * (a + sb[g * 128 + t])); } }
            __syncthreads();
        }
    }
}
__device__ __forceinline__ void p11_final(Frame& F) {
    const int gw = F.vcu * NWAVES + F.wave, NGW = F.G * NWAVES; const bf16* HB = (const bf16*)(F.ws + WS_XN); const float* gf = F.in[17];
    f32x4 g[4];
#pragma unroll
    for (int j = 0; j < 4; ++j) g[j] = *(const GAS f32x4*)(gf + (j >> 1) * 512 + F.lane * 8 + (j & 1) * 4);
    for (int m0 = gw * 2; m0 < M; m0 += NGW * 2) {
        v4u r[2][2];
#pragma unroll
        for (int i = 0; i < 2; ++i) { r[i][0] = *(const GAS v4u*)(HB + (size_t)(m0 + i) * DM + F.lane * 8); r[i][1] = *(const GAS v4u*)(HB + (size_t)(m0 + i) * DM + 512 + F.lane * 8); }
#pragma unroll
        for (int i = 0; i < 2; ++i) { float f[16]; unpack8(r[i][0], f); unpack8(r[i][1], f + 8); float s = 0.f;
#pragma unroll
            for (int e = 0; e < 16; ++e) s += f[e] * f[e];
            const float rstd = 1.0f / sqrtf(wave_sum(s) * (1.f / DM) + EPS); float* op = F.out + (size_t)(m0 + i) * DM + F.lane * 8;
#pragma unroll
            for (int j = 0; j < 4; ++j) *(GAS f32x4*)(op + (j >> 1) * 512 + (j & 1) * 4) = (f32x4){f[4 * j] * rstd * g[j].x, f[4 * j + 1] * rstd * g[j].y, f[4 * j + 2] * rstd * g[j].z, f[4 * j + 3] * rstd * g[j].w}; } }
}

struct Args { const float* in[18]; float* out; unsigned char* ws; int ph_lo, ph_hi, li, pad; };
__global__ void __launch_bounds__(NWAVES * 64, 2) trunk_fwd(Args args) {
    extern __shared__ __attribute__((aligned(16))) unsigned char lds[];
    Frame F;
    F.lds = (LAS unsigned char*)lds;
    F.MISC = (volatile LAS unsigned*)(F.lds + MISC_OFF);
    F.tid = threadIdx.x; F.lane = F.tid & 63; F.wave = __builtin_amdgcn_readfirstlane(F.tid >> 6);
    F.G = gridDim.x; { const int bx = blockIdx.x; F.vcu = (F.G % 8 == 0) ? (bx % 8) * (F.G / 8) + bx / 8 : bx; }
#pragma unroll
    for (int i = 0; i < 18; ++i) F.in[i] = args.in[i];
    F.out = args.out; F.ws = args.ws; F.ctl = (gu32*)(args.ws + WS_CTL);
    for (int u = F.tid; u < (LDS_BYTES - LDSCTL_OFF) / 4; u += NWAVES * 64) ((LAS unsigned*)(F.lds + LDSCTL_OFF))[u] = 0u;
    __syncthreads();
    XcdBarrier bar = xcd_barrier_post((unsigned*)(F.ctl + CW_BAR) + args.li * XCD_BAR_WORDS, F.MISC + 8);
    const int lo = args.ph_lo, hi = args.ph_hi;
#define IN(k) (lo <= (k) && (k) < hi)
#define SEAM(k) do { if (IN(k) && IN((k) + 1)) xcd_barrier(bar); } while (0)
    bf16* XN = (bf16*)(F.ws + WS_XN); bf16* MIX = (bf16*)(F.ws + WS_MIX); bf16* BIG = (bf16*)(F.ws + WS_BIG); bf16* QKV = (bf16*)(F.ws + WS_QKV); float* SS = (float*)(F.ws + WS_SS);
    if (IN(0)) { p0_prologue(F); SEAM(0); }
    if (IN(1)) { pg8::Gemm g{XN, (const bf16*)(F.ws + WS_WABIN), M, AB_IN, DM}; pg8::StaticOrder S; S.init(M, AB_IN, F.G, (int)blockIdx.x);
        pg8::EpiStore E{BIG, AB_IN};
        pg8::gemm_phase<pg8::EpiStore, pg8::StaticOrder, true, true>(F.lds + RING_OFF, g, S, E); SEAM(1); }
    if (IN(2)) { p2_mixer_ab(F); SEAM(2); }
    if (IN(3)) { pg8::Gemm g{MIX, (const bf16*)(F.ws + WS_WABOUT), M, DM, DM}; pg8::StaticOrder S; S.init(M, DM, F.G, (int)blockIdx.x);
        pg8::EpiResid<true, true> E{F.in[0], XN, SS};
        pg8::gemm_phase<pg8::EpiResid<true, true>, pg8::StaticOrder, true, true>(F.lds + RING_OFF, g, S, E); SEAM(3); }
    if (IN(4)) { pg8::Gemm g{XN, (const bf16*)(F.ws + WS_W1), M, FF, DM}; pg8::StaticOrder S; S.init(M, FF, F.G, (int)blockIdx.x);
        pg8::EpiUp E{BIG, SS};
        pg8::gemm_phase<pg8::EpiUp, pg8::StaticOrder, true, true>(F.lds + RING_OFF, g, S, E); SEAM(4); }
    if (IN(5)) { pg8::Gemm g{BIG, (const bf16*)(F.ws + WS_W2), M, DM, FF}; pg8::StaticOrder S; S.init(M, DM, F.G, (int)blockIdx.x);
        pg8::EpiResid<false, true> E{nullptr, XN, SS};
        pg8::gemm_phase<pg8::EpiResid<false, true>, pg8::StaticOrder, true, true>(F.lds + RING_OFF, g, S, E); SEAM(5); }
    if (IN(6)) { pg8::Gemm g{XN, (const bf16*)(F.ws + WS_WCDIN), M, CD_IN, DM}; pg8::StaticOrder S; S.init(M, CD_IN, F.G, (int)blockIdx.x);
        pg8::EpiCdIn E{BIG, QKV, SS, QSCALE};
        pg8::gemm_phase<pg8::EpiCdIn, pg8::StaticOrder, true, true>(F.lds + RING_OFF, g, S, E); SEAM(6); }
    if (IN(7)) { p7_attention_mfma(F); p7_sgu_mfma(F); SEAM(7); }
    if (IN(8)) { pg8::Gemm g{MIX, (const bf16*)(F.ws + WS_WCDOUT), M, DM, DM}; pg8::StaticOrder S; S.init(M, DM, F.G, (int)blockIdx.x);
        pg8::EpiResid<false, true> E{nullptr, XN, SS};
        pg8::gemm_phase<pg8::EpiResid<false, true>, pg8::StaticOrder, true, true>(F.lds + RING_OFF, g, S, E); SEAM(8); }
    if (IN(9)) { pg8::Gemm g{XN, (const bf16*)(F.ws + WS_W1 + 8 * MiB), M, FF, DM}; pg8::StaticOrder S; S.init(M, FF, F.G, (int)blockIdx.x);
        pg8::EpiUp E{BIG, SS};
        pg8::gemm_phase<pg8::EpiUp, pg8::StaticOrder, true, true>(F.lds + RING_OFF, g, S, E); SEAM(9); }
    if (IN(10)) { pg8::Gemm g{BIG, (const bf16*)(F.ws + WS_W2 + 8 * MiB), M, DM, FF}; pg8::StaticOrder S; S.init(M, DM, F.G, (int)blockIdx.x);
        pg8::EpiResid<false, false> E{nullptr, XN, SS};
        pg8::gemm_phase<pg8::EpiResid<false, false>, pg8::StaticOrder, true, true>(F.lds + RING_OFF, g, S, E); SEAM(10); }
    if (IN(11)) { p11_final(F); }
#undef IN
#undef SEAM
}

extern "C" void kernel_launch(void* const* d_in, const int* in_sizes, int n_in, void* d_out, int out_size, void* d_ws, size_t ws_size, hipStream_t stream) {
    static int grid = 0;
    if (grid == 0) {
        if (n_in != 18 || in_sizes[0] != M * DM || out_size != M * DM || ws_size < WS_END) { fprintf(stderr, "kernel_launch: unexpected shapes (n_in %d in0 %d out %d ws %zu); nothing launched\n", n_in, n_in > 0 ? in_sizes[0] : -1, out_size, ws_size); grid = -1; return; }
        int dev = 0, cus = 0, per_cu = 0;
        if (hipGetDevice(&dev) != hipSuccess || hipDeviceGetAttribute(&cus, hipDeviceAttributeMultiprocessorCount, dev) != hipSuccess) { grid = -1; return; }
        if (hipFuncSetAttribute((const void*)trunk_fwd, hipFuncAttributeMaxDynamicSharedMemorySize, LDS_BYTES) != hipSuccess) { fprintf(stderr, "kernel_launch: hipFuncSetAttribute failed\n"); grid = -1; return; }
        if (hipOccupancyMaxActiveBlocksPerMultiprocessor(&per_cu, (const void*)trunk_fwd, NWAVES * 64, LDS_BYTES) != hipSuccess || per_cu < 1) { fprintf(stderr, "kernel_launch: occupancy query reports %d workgroups per CU\n", per_cu); }
        (void)hipGetLastError();
        grid = cus;
    }
    if (grid < 0) return;
    if (hipMemsetAsync((char*)d_ws + WS_CTL, 0, CTL_ZERO_BYTES, stream) != hipSuccess) return;
    Args a{};
    for (int i = 0; i < 18; ++i) a.in[i] = (const float*)d_in[i];
    a.out = (float*)d_out; a.ws = (unsigned char*)d_ws;
#if PROBE_REPEAT >= 0
    const int plan[2][2] = {{0, PROBE_REPEAT + 1}, {PROBE_REPEAT, N_PHASES}}; const int nl = 2;
#else
    const int plan[1][2] = {{0, N_PHASES}}; const int nl = 1;
#endif
    for (int li = 0; li < nl; ++li) {
        a.ph_lo = plan[li][0]; a.ph_hi = plan[li][1]; a.li = li;
        hipLaunchKernelGGL(trunk_fwd, dim3(grid), dim3(NWAVES * 64), LDS_BYTES, stream, a);
    }
}
```

```cpp
#include <hip/hip_runtime.h>
#include <cstdio>
#include <cstdint>
namespace pg8 {
#define PG8_LAS __attribute__((address_space(3)))
typedef unsigned short bf16_t;
typedef short bf16x8 __attribute__((ext_vector_type(8)));
typedef float f32x4 __attribute__((ext_vector_type(4)));
typedef unsigned u32x4 __attribute__((ext_vector_type(4)));
constexpr int BM = 256, BK = 64, HALF = 128, HTB = HALF * BK * 2  , STAGE_BYTES = 8 * HTB, NXCD = 8, WGM = 8;

__host__ __device__ __forceinline__ int lds_byte(int r, int c) { const int st = (r >> 4) * 2 + (c >> 5), rr = r & 15, cc = c & 31, ob = rr * 64 + cc * 2; return st * 1024 + (ob ^ (((ob >> 9) & 1) << 5)); }
__host__ __device__ __forceinline__ void stage_rc(int b, int& R, int& C) { const int st = b / 1024, sb = b % 1024, swz = sb ^ (((sb >> 9) & 1) << 5); R = (st >> 1) * 16 + swz / 64; C = (st & 1) * 32 + (swz % 64) / 2; }
__host__ __device__ __forceinline__ int perm32(int rho) { const int n = rho >> 4, i = rho & 15; return 8 * (i >> 2) + 4 * n + (i & 3); }

struct Unit { int pm, pn; };
struct Gemm { const bf16_t* A; const bf16_t* Bt; int M, N, K; };

struct StaticOrder {
    int nM, nN, nwg, G, c;
    __host__ __device__ void init(int M, int N, int G_, int c_) { nM = M / BM; nN = N / BM; nwg = nM * nN; G = G_; c = c_; }
    __host__ __device__ bool next(int i, Unit& u) const {
        const long L = (long)i * G + c; if (L >= nwg) return false;
        int wgid = (int)L; { const int q = nwg / NXCD, r = nwg % NXCD, xcd = wgid % NXCD, off = wgid / NXCD; wgid = (xcd < r ? xcd * (q + 1) : r * (q + 1) + (xcd - r) * q) + off; }
        const int nig = WGM * nN, gid = wgid / nig, fm = gid * WGM, gsz = (nM - fm) < WGM ? (nM - fm) : WGM;
        u.pm = fm + ((wgid % nig) % gsz); u.pn = (wgid % nig) / gsz; return true;
    }
    __device__ __forceinline__ void a_ready(const Unit&) const {}
    __device__ __forceinline__ void done(const Unit&) const {}
};

__device__ __forceinline__ unsigned cvt_pk_bf16(float lo, float hi) { unsigned r; asm volatile("v_cvt_pk_bf16_f32 %0, %1, %2" : "=v"(r) : "v"(lo), "v"(hi)); return r; }
typedef float f32x2 __attribute__((ext_vector_type(2)));
__device__ __forceinline__ f32x2 gelu_pk(f32x2 v) {
    const f32x2 av = __builtin_elementwise_abs(v), d = av * 0.2316418882f + 1.0f;
    f32x2 t; t.x = __builtin_amdgcn_rcpf(d.x); t.y = __builtin_amdgcn_rcpf(d.y);
    f32x2 q = t * 0.5307027145f + (-0.7265760135f); q = q * t + 0.7107068705f; q = q * t + (-0.142248368f); q = q * t + 0.127414796f; q = q * t;
    const f32x2 s = (v * v) * (-0.72134752044f);
    f32x2 e; e.x = __builtin_amdgcn_exp2f(s.x); e.y = __builtin_amdgcn_exp2f(s.y);
    const f32x2 m = v * (q * e), r = v - m;
    f32x2 o; o.x = v.x < 0.f ? m.x : r.x; o.y = v.y < 0.f ? m.y : r.y; return o;
}
typedef unsigned u32x2 __attribute__((ext_vector_type(2)));
struct EpiStore {
    static constexpr bool PERM = true, AFTER_DRAIN = false;
    bf16_t* O; int ldc;
    __device__ __forceinline__ void operator()(const f32x4 (&acc)[2][2][4][2], const Unit& u, int wr, int wc, int fr, int fq) const {
        const int row0 = u.pm * BM + wr * 64 + fr, col0 = u.pn * BM + wc * 32 + 8 * fq;
#pragma unroll
        for (int ai = 0; ai < 2; ++ai)
#pragma unroll
            for (int m = 0; m < 4; ++m) { bf16_t* rowp = O + (size_t)(row0 + ai * HALF + m * 16) * ldc + col0;
#pragma unroll
                for (int bj = 0; bj < 2; ++bj) { const f32x4 v0 = acc[ai][bj][m][0], v1 = acc[ai][bj][m][1];
                    u32x4 w; w.x = cvt_pk_bf16(v0[0], v0[1]); w.y = cvt_pk_bf16(v0[2], v0[3]); w.z = cvt_pk_bf16(v1[0], v1[1]); w.w = cvt_pk_bf16(v1[2], v1[3]);
                    *(u32x4*)(rowp + bj * HALF) = w; } }
    }
};
__device__ __forceinline__ float bflo(unsigned w) { return __builtin_bit_cast(float, w << 16); }
__device__ __forceinline__ float bfhi(unsigned w) { return __builtin_bit_cast(float, w & 0xffff0000u); }
template <bool XF32, bool WRITE_SS> struct EpiResid {
    static constexpr bool PERM = true, AFTER_DRAIN = false;
    const float* xf; bf16_t* hb; float* ss;
    __device__ __forceinline__ void operator()(const f32x4 (&acc)[2][2][4][2], const Unit& u, int wr, int wc, int fr, int fq) const {
        const int row0 = u.pm * BM + wr * 64 + fr, col0 = u.pn * BM + wc * 32 + 8 * fq;
#pragma unroll
        for (int ai = 0; ai < 2; ++ai) {
            f32x4 b[4][2][2];
            if (XF32) {
#pragma unroll
                for (int m = 0; m < 4; ++m)
#pragma unroll
                    for (int bj = 0; bj < 2; ++bj) { const float* p = xf + (size_t)(row0 + ai * HALF + m * 16) * 1024 + col0 + bj * HALF; b[m][bj][0] = *(const f32x4*)p; b[m][bj][1] = *(const f32x4*)(p + 4); }
            } else {
#pragma unroll
                for (int m = 0; m < 4; ++m)
#pragma unroll
                    for (int bj = 0; bj < 2; ++bj) { const u32x4 w = *(const u32x4*)(hb + (size_t)(row0 + ai * HALF + m * 16) * 1024 + col0 + bj * HALF);
                        b[m][bj][0] = (f32x4){bflo(w.x), bfhi(w.x), bflo(w.y), bfhi(w.y)}; b[m][bj][1] = (f32x4){bflo(w.z), bfhi(w.z), bflo(w.w), bfhi(w.w)}; }
            }
#pragma unroll
            for (int m = 0; m < 4; ++m) { const int row = row0 + ai * HALF + m * 16; float s = 0.f;
#pragma unroll
                for (int bj = 0; bj < 2; ++bj) { const f32x4 v0 = b[m][bj][0] + acc[ai][bj][m][0], v1 = b[m][bj][1] + acc[ai][bj][m][1];
                    u32x4 w; w.x = cvt_pk_bf16(v0[0], v0[1]); w.y = cvt_pk_bf16(v0[2], v0[3]); w.z = cvt_pk_bf16(v1[0], v1[1]); w.w = cvt_pk_bf16(v1[2], v1[3]);
                    *(u32x4*)(hb + (size_t)row * 1024 + col0 + bj * HALF) = w;
                    if (WRITE_SS) s += ((v0[0] * v0[0] + v0[1] * v0[1]) + (v0[2] * v0[2] + v0[3] * v0[3])) + ((v1[0] * v1[0] + v1[1] * v1[1]) + (v1[2] * v1[2] + v1[3] * v1[3])); }
                if (WRITE_SS) { s += __shfl_xor(s, 16); s += __shfl_xor(s, 32); if (fq == 0) ss[(size_t)row * 16 + u.pn * 4 + wc] = s; } }
            asm volatile("" ::: "memory");
        }
    }
};
__device__ __forceinline__ void rows_rstd(const float* ss, int row0, int fq, float (&rs)[2][4]) {
    f32x4 p[2][4];
#pragma unroll
    for (int ai = 0; ai < 2; ++ai)
#pragma unroll
        for (int m = 0; m < 4; ++m) p[ai][m] = *(const f32x4*)(ss + (size_t)(row0 + ai * HALF + m * 16) * 16 + 4 * fq);
#pragma unroll
    for (int ai = 0; ai < 2; ++ai)
#pragma unroll
        for (int m = 0; m < 4; ++m) { float s = (p[ai][m][0] + p[ai][m][1]) + (p[ai][m][2] + p[ai][m][3]); s += __shfl_xor(s, 16); s += __shfl_xor(s, 32); rs[ai][m] = 1.0f / sqrtf(s * (1.0f / 1024.0f) + 1e-6f); }
}
struct EpiUp {
    static constexpr bool PERM = true, AFTER_DRAIN = false;
    bf16_t* O; const float* ss;
    __device__ __forceinline__ void operator()(const f32x4 (&acc)[2][2][4][2], const Unit& u, int wr, int wc, int fr, int fq) const {
        const int row0 = u.pm * BM + wr * 64 + fr, col0 = u.pn * BM + wc * 32 + 8 * fq;
        float rs[2][4]; rows_rstd(ss, row0, fq, rs);
#pragma unroll
        for (int ai = 0; ai < 2; ++ai)
#pragma unroll
            for (int m = 0; m < 4; ++m) { const int row = row0 + ai * HALF + m * 16; const float r = rs[ai][m];
                bf16_t* rowp = O + (size_t)row * 4096 + col0;
#pragma unroll
                for (int bj = 0; bj < 2; ++bj) { f32x4 v0 = acc[ai][bj][m][0] * r, v1 = acc[ai][bj][m][1] * r;
#pragma unroll
                    for (int e = 0; e < 4; ++e) { const float a = fmaxf(v0[e], 0.f), b = fmaxf(v1[e], 0.f); v0[e] = a * a; v1[e] = b * b; }
                    u32x4 w; w.x = cvt_pk_bf16(v0[0], v0[1]); w.y = cvt_pk_bf16(v0[2], v0[3]); w.z = cvt_pk_bf16(v1[0], v1[1]); w.w = cvt_pk_bf16(v1[2], v1[3]);
                    *(u32x4*)(rowp + bj * HALF) = w; } }
    }
};
struct EpiCdIn {
    static constexpr bool PERM = true, AFTER_DRAIN = false;
    bf16_t* UV; bf16_t* QKV; const float* ss; float qscale;
    __device__ __forceinline__ void operator()(const f32x4 (&acc)[2][2][4][2], const Unit& u, int wr, int wc, int fr, int fq) const {
        const int row0 = u.pm * BM + wr * 64 + fr; const bool isuv = u.pn < 4;
        const int colt = isuv ? u.pn * BM : (u.pn - 4) * BM; const int ldc = isuv ? 1024 : 1536; bf16_t* base = isuv ? UV : QKV;
        const float sc = (!isuv && u.pn < 6) ? qscale : 1.0f;
        const int col0 = colt + wc * 32 + 8 * fq;
        float rs[2][4]; rows_rstd(ss, row0, fq, rs);
#pragma unroll
        for (int ai = 0; ai < 2; ++ai)
#pragma unroll
            for (int m = 0; m < 4; ++m) { const int row = row0 + ai * HALF + m * 16; const float r = rs[ai][m] * sc;
                bf16_t* rowp = base + (size_t)row * ldc + col0;
#pragma unroll
                for (int bj = 0; bj < 2; ++bj) { f32x4 v0 = acc[ai][bj][m][0] * r, v1 = acc[ai][bj][m][1] * r;
                    if (isuv) { f32x2 a = gelu_pk((f32x2){v0[0], v0[1]}), b = gelu_pk((f32x2){v0[2], v0[3]}), c = gelu_pk((f32x2){v1[0], v1[1]}), d = gelu_pk((f32x2){v1[2], v1[3]});
                        v0 = (f32x4){a.x, a.y, b.x, b.y}; v1 = (f32x4){c.x, c.y, d.x, d.y}; }
                    u32x4 w; w.x = cvt_pk_bf16(v0[0], v0[1]); w.y = cvt_pk_bf16(v0[2], v0[3]); w.z = cvt_pk_bf16(v1[0], v1[1]); w.w = cvt_pk_bf16(v1[2], v1[3]);
                    *(u32x4*)(rowp + bj * HALF) = w; } }
    }
};
template <class Epi, class Sched, bool ALIGN_EPI = false, bool SP2 = false>
__device__ __forceinline__ void gemm_phase(PG8_LAS unsigned char* lds, const Gemm g, const Sched& S, const Epi& E) {
    const int tid = threadIdx.x, wid = __builtin_amdgcn_readfirstlane(tid >> 6), lane = tid & 63, wr = wid >> 2, wc = wid & 3, fr = lane & 15, fq = lane >> 4;
    const int K = g.K, nt = K / BK;
    unsigned voffA[2], voffB[2];
#pragma unroll
    for (int i = 0; i < 2; ++i) { int R, C; stage_rc(tid * 16 + i * 8192, R, C); const int Rb = Epi::PERM ? ((R & ~31) + perm32(R & 31)) : R;
        voffA[i] = (unsigned)(R * K + C) * 2u; voffB[i] = (unsigned)(Rb * K + C) * 2u; }
    const size_t kstep = (size_t)(BK * 2);
    const size_t hstep = (size_t)HALF * K * 2;
    const size_t tstep = 2 * hstep;
    const unsigned ldsw = (unsigned)wid * 1024u;
    const int aoff = lds_byte(wr * 64 + fr, fq * 8), boff = lds_byte(wc * 32 + fr, fq * 8);
#define PG8_SA(b, h) (((b) * 2 + (h)) * HTB)
#define PG8_SB(b, h) ((4 + (b) * 2 + (h)) * HTB)
#define PG8_STAGE(bufoff, gbase, voff) do { _Pragma("unroll") for (int _i = 0; _i < 2; ++_i) \
        __builtin_amdgcn_global_load_lds((const unsigned*)((const char*)(gbase) + (voff)[_i]), (PG8_LAS unsigned*)(lds + (bufoff) + ldsw + _i * 8192), 16, 0, 0); } while (0)
#define PG8_LDA(dst, b, h) do { _Pragma("unroll") for (int m = 0; m < 4; ++m) _Pragma("unroll") for (int k = 0; k < 2; ++k) dst[m][k] = *(const PG8_LAS bf16x8*)(lds + PG8_SA(b, h) + aoff + m * 2048 + k * 1024); } while (0)
#define PG8_LDB(dst, b, h) do { _Pragma("unroll") for (int n = 0; n < 2; ++n) _Pragma("unroll") for (int k = 0; k < 2; ++k) dst[n][k] = *(const PG8_LAS bf16x8*)(lds + PG8_SB(b, h) + boff + n * 2048 + k * 1024); } while (0)
#define PG8_MMA(ai, bj, At, Bt) do { __builtin_amdgcn_s_setprio(1); _Pragma("unroll") for (int m = 0; m < 4; ++m) _Pragma("unroll") for (int n = 0; n < 2; ++n) _Pragma("unroll") for (int k = 0; k < 2; ++k) \
        acc[ai][bj][m][n] = __builtin_amdgcn_mfma_f32_16x16x32_bf16(Bt[n][k], At[m][k], acc[ai][bj][m][n], 0, 0, 0); __builtin_amdgcn_s_setprio(0); } while (0)
#define PG8_WAIT_V(n) asm volatile("s_waitcnt vmcnt(" #n ")" ::: "memory")
#define PG8_WAIT_L(n) asm volatile("s_waitcnt lgkmcnt(" #n ")" ::: "memory")
#define PG8_BAR __builtin_amdgcn_s_barrier()
#define PG8_SCHED __builtin_amdgcn_sched_barrier(0)
    Unit cur, nxt; int ui = 0;
    if (!S.next(0, cur)) return;
    f32x4 acc[2][2][4][2];
#pragma unroll
    for (int a = 0; a < 2; ++a)
#pragma unroll
        for (int b = 0; b < 2; ++b)
#pragma unroll
            for (int m = 0; m < 4; ++m)
#pragma unroll
                for (int n = 0; n < 2; ++n) acc[a][b][m][n] = (f32x4){0.f, 0.f, 0.f, 0.f};
    bf16x8 At[4][2], B0[2][2], B1[2][2];
    const char* cA = (const char*)g.A + (size_t)cur.pm * tstep; const char* cB = (const char*)g.Bt + (size_t)cur.pn * tstep;
    S.a_ready(cur);
    if constexpr (SP2) {
        PG8_STAGE(PG8_SB(0, 0), cB, voffB); PG8_STAGE(PG8_SB(0, 1), cB + hstep, voffB); PG8_STAGE(PG8_SA(0, 0), cA, voffA); PG8_STAGE(PG8_SA(0, 1), cA + hstep, voffA);
        if (wr == 1) PG8_BAR;
        PG8_WAIT_V(2); PG8_BAR;
        PG8_STAGE(PG8_SB(1, 0), cB + kstep, voffB); PG8_STAGE(PG8_SA(1, 0), cA + kstep, voffA); PG8_STAGE(PG8_SB(1, 1), cB + hstep + kstep, voffB);
        PG8_WAIT_V(6); PG8_BAR;
    } else {
        PG8_STAGE(PG8_SB(0, 0), cB, voffB); PG8_STAGE(PG8_SA(0, 0), cA, voffA); PG8_STAGE(PG8_SB(0, 1), cB + hstep, voffB); PG8_STAGE(PG8_SA(0, 1), cA + hstep, voffA);
        if (wr == 1) PG8_BAR;
        PG8_WAIT_V(4); PG8_BAR;
        PG8_STAGE(PG8_SB(1, 0), cB + kstep, voffB); PG8_STAGE(PG8_SA(1, 0), cA + kstep, voffA); PG8_STAGE(PG8_SB(1, 1), cB + hstep + kstep, voffB);
        PG8_WAIT_V(6); PG8_BAR;
    }
    for (;;) {
        const bool has_next = S.next(ui + 1, nxt);
        const char* nA = has_next ? (const char*)g.A + (size_t)nxt.pm * tstep : cA; const char* nB = has_next ? (const char*)g.Bt + (size_t)nxt.pn * tstep : cB;
        for (int t = 0; t < nt; t += 2) {
            const bool last = (t == nt - 2);
            const char* a1 = cA + (size_t)(t + 1) * kstep;
            const char* a2 = last ? nA : cA + (size_t)(t + 2) * kstep; const char* b2 = last ? nB : cB + (size_t)(t + 2) * kstep;
            const char* a3 = a2 + kstep; const char* b3 = b2 + kstep;
            if (last && has_next) S.a_ready(nxt);
            if constexpr (SP2) {
            PG8_LDB(B0, 0, 0); PG8_LDB(B1, 0, 1); PG8_SCHED; PG8_LDA(At, 0, 0); PG8_STAGE(PG8_SA(1, 1), a1 + hstep, voffA);
            PG8_WAIT_V(8); PG8_WAIT_L(0); PG8_BAR; PG8_MMA(0, 0, At, B0); PG8_MMA(0, 1, At, B1); PG8_BAR; PG8_SCHED;
            PG8_LDA(At, 0, 1); PG8_STAGE(PG8_SB(0, 0), b2, voffB); PG8_STAGE(PG8_SB(0, 1), b2 + hstep, voffB); PG8_STAGE(PG8_SA(0, 0), a2, voffA);
            PG8_WAIT_V(8); PG8_WAIT_L(0); PG8_BAR; PG8_MMA(1, 0, At, B0); PG8_MMA(1, 1, At, B1); PG8_BAR; PG8_SCHED;
            PG8_LDB(B0, 1, 0); PG8_LDB(B1, 1, 1); PG8_SCHED; PG8_LDA(At, 1, 0); PG8_STAGE(PG8_SA(0, 1), a2 + hstep, voffA);
            PG8_WAIT_V(8); PG8_WAIT_L(0); PG8_BAR; PG8_MMA(0, 0, At, B0); PG8_MMA(0, 1, At, B1); PG8_BAR; PG8_SCHED;
            PG8_LDA(At, 1, 1); PG8_STAGE(PG8_SB(1, 0), b3, voffB); PG8_STAGE(PG8_SB(1, 1), b3 + hstep, voffB); PG8_STAGE(PG8_SA(1, 0), a3, voffA);
            PG8_WAIT_V(8); PG8_WAIT_L(0); PG8_BAR; PG8_MMA(1, 0, At, B0); PG8_MMA(1, 1, At, B1); PG8_BAR; PG8_SCHED;
            } else {
            PG8_LDB(B0, 0, 0); PG8_SCHED; PG8_LDA(At, 0, 0); PG8_STAGE(PG8_SA(1, 1), a1 + hstep, voffA);
            PG8_WAIT_L(8); PG8_BAR; PG8_WAIT_L(0); PG8_MMA(0, 0, At, B0); PG8_BAR; PG8_SCHED;
            PG8_LDB(B1, 0, 1); PG8_STAGE(PG8_SB(0, 0), b2, voffB);
            PG8_BAR; PG8_WAIT_L(0); PG8_MMA(0, 1, At, B1); PG8_BAR;
            PG8_LDA(At, 0, 1); PG8_STAGE(PG8_SA(0, 0), a2, voffA);
            PG8_BAR; PG8_WAIT_L(0); PG8_MMA(1, 0, At, B0); PG8_BAR; PG8_SCHED;
            PG8_STAGE(PG8_SB(0, 1), b2 + hstep, voffB);
            PG8_WAIT_V(6); PG8_BAR; PG8_MMA(1, 1, At, B1); PG8_BAR;
            PG8_LDB(B0, 1, 0); PG8_SCHED; PG8_LDA(At, 1, 0); PG8_STAGE(PG8_SA(0, 1), a2 + hstep, voffA);
            PG8_WAIT_L(8); PG8_BAR; PG8_WAIT_L(0); PG8_MMA(0, 0, At, B0); PG8_BAR; PG8_SCHED;
            PG8_LDB(B1, 1, 1); PG8_STAGE(PG8_SB(1, 0), b3, voffB);
            PG8_BAR; PG8_WAIT_L(0); PG8_MMA(0, 1, At, B1); PG8_BAR;
            PG8_LDA(At, 1, 1); PG8_STAGE(PG8_SA(1, 0), a3, voffA);
            PG8_BAR; PG8_WAIT_L(0); PG8_MMA(1, 0, At, B0); PG8_BAR; PG8_SCHED;
            PG8_STAGE(PG8_SB(1, 1), b3 + hstep, voffB);
            PG8_WAIT_V(6); PG8_BAR; PG8_MMA(1, 1, At, B1); PG8_BAR;
            }
        }
        if constexpr (ALIGN_EPI) { if (wr == 0) PG8_BAR; }
        if constexpr (!Epi::AFTER_DRAIN) { E(acc, cur, wr, wc, fr, fq); S.done(cur); }
        if (!has_next) break;
#pragma unroll
        for (int a = 0; a < 2; ++a)
#pragma unroll
            for (int b = 0; b < 2; ++b)
#pragma unroll
                for (int m = 0; m < 4; ++m)
#pragma unroll
                    for (int n = 0; n < 2; ++n) acc[a][b][m][n] = (f32x4){0.f, 0.f, 0.f, 0.f};
        cur = nxt; cA = nA; cB = nB; ++ui;
        if constexpr (ALIGN_EPI) { if (wr == 1) PG8_BAR; }
    }
    PG8_WAIT_V(0);
    if constexpr (!ALIGN_EPI) { if (wr == 0) PG8_BAR; }
    PG8_BAR;
    if constexpr (Epi::AFTER_DRAIN) { E.fused(acc, cur, wr, wc, fr, fq, lds, wid, lane); S.done(cur); }
#undef PG8_SA
#undef PG8_SB
#undef PG8_STAGE
#undef PG8_LDA
#undef PG8_LDB
#undef PG8_MMA
#undef PG8_WAIT_V
#undef PG8_WAIT_L
#undef PG8_BAR
#undef PG8_SCHED
}
}
constexpr int NWAVES = 8;
#ifndef PROBE_REPEAT
#define PROBE_REPEAT -1
#endif
#ifndef MK_N_LAUNCHES
#define MK_N_LAUNCHES 1
#endif
constexpr int N_PHASES = 12;
constexpr int N_LAUNCHES = MK_N_LAUNCHES;
constexpr int BATCH = 16, SEQ = 2048, DM = 1024, M = BATCH * SEQ, FF = 4096, AB_IN = 2048, CD_IN = 2560;
constexpr float EPS = 1e-6f;
constexpr float QSCALE = 0.125f * 1.4426950408889634f;
constexpr size_t MiB = 1u << 20;
constexpr size_t WS_CTL = 0, CTL_ZERO_BYTES = 1 * MiB;
constexpr size_t WS_WABIN = 2 * MiB, WS_WABOUT = 6 * MiB, WS_W1 = 8 * MiB  , WS_W2 = 24 * MiB  , WS_WCDIN = 40 * MiB, WS_WCDOUT = 46 * MiB, WS_WSGU = 48 * MiB;
constexpr size_t WS_TMPF = 50 * MiB;
constexpr size_t WS_SS = 52 * MiB;
constexpr size_t WS_XN = 56 * MiB;
constexpr size_t WS_MIX = 120 * MiB;
constexpr size_t WS_BIG = 184 * MiB;
constexpr size_t WS_QKV = WS_BIG + 64 * MiB;
constexpr size_t WS_END = 440 * MiB;
constexpr int CW_BAR = 4096;
constexpr int RING_OFF = 0, RING_BYTES = 131072;
constexpr int LDSCTL_OFF = RING_BYTES, MISC_OFF = LDSCTL_OFF + 320;
constexpr int LDS_BYTES = 147456;
#define GAS __attribute__((address_space(1)))
#define LAS __attribute__((address_space(3)))
typedef unsigned short bf16;
typedef unsigned v4u __attribute__((ext_vector_type(4)));
typedef float f32x4 __attribute__((ext_vector_type(4)));
typedef short bf16x8 __attribute__((ext_vector_type(8)));
typedef GAS unsigned gu32;
typedef GAS unsigned long long gu64;
#define RLX_AGENT __ATOMIC_RELAXED, __HIP_MEMORY_SCOPE_AGENT
#define LDS_WAIT() asm volatile("s_waitcnt lgkmcnt(0)" ::: "memory")
#define VM_WAIT() asm volatile("s_waitcnt vmcnt(0)" ::: "memory")
__device__ __forceinline__ unsigned long long rt() { return __builtin_amdgcn_s_memrealtime(); }
__device__ __forceinline__ unsigned f2bf(float f) { unsigned u = __builtin_bit_cast(unsigned, f); return (u + 0x7fffu + ((u >> 16) & 1u)) >> 16; }
__device__ __forceinline__ unsigned pk2(float lo, float hi) { return f2bf(lo) | (f2bf(hi) << 16); }
#define XB_TMO      128
#define XB_XCNT(j)  (256  + 64 * (j))
#define XB_XSUB(j)  (1280 + 64 * (j))
#define XB_XGEN(j)  (2304 + 64 * (j))
#define XB_TOP      3328
#define XB_TOPGEN   3392
#define XCD_BAR_WORDS 3456
#define XB_SPIN_CAP (1u << 18)

__device__ __forceinline__ unsigned xb_ld(unsigned* p)              { return __hip_atomic_load(p, __ATOMIC_RELAXED, __HIP_MEMORY_SCOPE_AGENT); }
__device__ __forceinline__ unsigned xb_add(unsigned* p, unsigned v) { return __hip_atomic_fetch_add(p, v, __ATOMIC_RELAXED, __HIP_MEMORY_SCOPE_AGENT); }
__device__ __forceinline__ unsigned xb_xcc_id() { return (unsigned)__builtin_amdgcn_s_getreg((3 << 11) | 20) & 0xFu; }
#define XB_SPIN(cond, bar) do { unsigned _sp = 0; while (cond) { __builtin_amdgcn_s_sleep(1); \
    if ((++_sp & 255u) == 0u) { if (xb_ld(&(bar)[XB_TMO])) break; if (_sp > XB_SPIN_CAP) { atomicAdd(&(bar)[XB_TMO], 1u); break; } } } } while (0)

struct XcdBarrier {
    unsigned* bar; unsigned x;
    volatile LAS unsigned* st;
};

__device__ __forceinline__ XcdBarrier xcd_barrier_post(unsigned* bar, volatile LAS unsigned* st) {
    XcdBarrier b; b.bar = bar; b.x = xb_xcc_id(); b.st = st;
    if (threadIdx.x == 0) (void)xb_add(&bar[XB_XCNT(b.x)], 1u);
    return b;
}
__device__ __forceinline__ void xcd_barrier_complete(unsigned* bar, unsigned x, unsigned& nloc, unsigned& nx) {
    const unsigned G = gridDim.x * gridDim.y * gridDim.z;
    unsigned sum, cnt, mine, sp = 0u;
    for (;;) {
        sum = 0u; cnt = 0u; mine = 0u;
#pragma unroll
        for (unsigned j = 0; j < 16; ++j) { const unsigned c = xb_ld(&bar[XB_XCNT(j)]); sum += c; cnt += (c > 0u) ? 1u : 0u; mine = (j == x) ? c : mine; }
        if (sum == G) break;
        __builtin_amdgcn_s_sleep(1);
        if ((++sp & 255u) == 0u) { if (xb_ld(&bar[XB_TMO])) break; if (sp > XB_SPIN_CAP) { atomicAdd(&bar[XB_TMO], 1u); break; } }
    }
    nloc = mine > 0u ? mine : 1u; nx = cnt > 0u ? cnt : 1u;
}

__device__ __forceinline__ void xcd_barrier(const XcdBarrier& b) {
    asm volatile("s_waitcnt vmcnt(0)" ::: "memory");
    __syncthreads();
    if (threadIdx.x == 0) {
        unsigned* bar = b.bar;
        __builtin_amdgcn_s_waitcnt(0);
        unsigned nloc = b.st[0], nx = b.st[1];
        if (nloc == 0u) { xcd_barrier_complete(bar, b.x, nloc, nx); b.st[0] = nloc; b.st[1] = nx; }
        const unsigned old = xb_add(&bar[XB_XSUB(b.x)], 1u);
        const unsigned gen = old / nloc;
        if (old + 1u == (gen + 1u) * nloc) {
            __builtin_amdgcn_fence(__ATOMIC_RELEASE, "agent");
            asm volatile("s_waitcnt vmcnt(0)" ::: "memory");
            const unsigned og = xb_add(&bar[XB_TOP], 1u);
            const unsigned tg = og / nx;
            if (og + 1u == (tg + 1u) * nx) xb_add(&bar[XB_TOPGEN], 1u);
            else XB_SPIN(xb_ld(&bar[XB_TOPGEN]) == tg, bar);
            __builtin_amdgcn_fence(__ATOMIC_ACQUIRE, "agent");
            xb_add(&bar[XB_XGEN(b.x)], 1u);
            asm volatile("s_waitcnt vmcnt(0)" ::: "memory");
        } else {
            XB_SPIN(xb_ld(&bar[XB_XGEN(b.x)]) == gen, bar);
            __builtin_amdgcn_fence(__ATOMIC_ACQUIRE, "agent");
            asm volatile("s_waitcnt vmcnt(0)" ::: "memory");
        }
    }
    __syncthreads();
}
struct Frame {
    LAS unsigned char* lds;
    volatile LAS unsigned* MISC;
    gu32* ctl;
    int tid, lane, wave;
    int vcu, G;
    const float* in[18]; float* out; unsigned char* ws;
};
__device__ __forceinline__ float bf2f(unsigned short b) { return __builtin_bit_cast(float, (unsigned)b << 16); }
__device__ __forceinline__ float wave_sum(float v) {
#pragma unroll
    for (int o = 1; o < 64; o <<= 1) v += __shfl_xor(v, o);
    return v;
}
__device__ __forceinline__ void unpack8(const v4u r, float* f) {
    f[0] = __builtin_bit_cast(float, r.x << 16); f[1] = __builtin_bit_cast(float, r.x & 0xffff0000u);
    f[2] = __builtin_bit_cast(float, r.y << 16); f[3] = __builtin_bit_cast(float, r.y & 0xffff0000u);
    f[4] = __builtin_bit_cast(float, r.z << 16); f[5] = __builtin_bit_cast(float, r.z & 0xffff0000u);
    f[6] = __builtin_bit_cast(float, r.w << 16); f[7] = __builtin_bit_cast(float, r.w & 0xffff0000u);
}
__device__ __forceinline__ v4u pack8(const float* f) { v4u o; o.x = pk2(f[0], f[1]); o.y = pk2(f[2], f[3]); o.z = pk2(f[4], f[5]); o.w = pk2(f[6], f[7]); return o; }

__device__ __forceinline__ void transpose_item(const float* W, const float* gk, int K, int N, bf16* WT, LAS float* scr, int item, int lane) {
    const int nblk = N / 32, kb = item / nblk, nb = item % nblk, k0 = 64 * kb, n0 = 32 * nb;
    float v[32]; const float* src = W + (size_t)(k0 + (lane >> 5)) * N + n0 + (lane & 31);
#pragma unroll
    for (int i = 0; i < 32; ++i) v[i] = src[(size_t)(2 * i) * N];
    if (gk) {
#pragma unroll
        for (int i = 0; i < 32; ++i) v[i] *= gk[k0 + 2 * i + (lane >> 5)]; }
#pragma unroll
    for (int i = 0; i < 32; ++i) scr[(2 * i + (lane >> 5)) * 33 + (lane & 31)] = v[i];
    LDS_WAIT(); asm volatile("" ::: "memory");
    const int c = lane & 7;
#pragma unroll
    for (int j = 0; j < 4; ++j) { const int n = (lane >> 3) + 8 * j; const LAS float* s = scr + (8 * c) * 33 + n;
        v4u o; o.x = pk2(s[0 * 33], s[1 * 33]); o.y = pk2(s[2 * 33], s[3 * 33]); o.z = pk2(s[4 * 33], s[5 * 33]); o.w = pk2(s[6 * 33], s[7 * 33]);
        *(GAS v4u*)(WT + (size_t)(n0 + n) * K + k0 + 8 * c) = o; }
    LDS_WAIT(); asm volatile("" ::: "memory");
}

__device__ __forceinline__ void p0_prologue(Frame& F) {
    LAS float* scr = (LAS float*)(F.lds + RING_OFF + F.wave * 16384);
    const int gw = F.vcu * NWAVES + F.wave, NGW = F.G * NWAVES;
    const float* mixg = F.in[1]; const float* mlpg = F.in[2];
    { const float* x = F.in[0]; bf16* xn = (bf16*)(F.ws + WS_XN); const GAS f32x4* gr = (const GAS f32x4*)mixg + F.lane;
      f32x4 g[4];
#pragma unroll
      for (int j = 0; j < 4; ++j) g[j] = gr[64 * j];
      for (int m0 = gw * 4; m0 < M; m0 += NGW * 4) { f32x4 v[4][4];
#pragma unroll
          for (int i = 0; i < 4; ++i) { const GAS f32x4* xr = (const GAS f32x4*)(x + (size_t)(m0 + i) * DM) + F.lane;
#pragma unroll
              for (int j = 0; j < 4; ++j) v[i][j] = xr[64 * j]; }
#pragma unroll
          for (int i = 0; i < 4; ++i) { float s = 0.f;
#pragma unroll
              for (int j = 0; j < 4; ++j) s += (v[i][j].x * v[i][j].x + v[i][j].y * v[i][j].y) + (v[i][j].z * v[i][j].z + v[i][j].w * v[i][j].w);
              const float rstd = 1.0f / sqrtf(wave_sum(s) * (1.f / DM) + EPS);
              GAS unsigned long long* o8 = (GAS unsigned long long*)(xn + (size_t)(m0 + i) * DM) + F.lane;
#pragma unroll
              for (int j = 0; j < 4; ++j) o8[64 * j] = (unsigned long long)pk2(v[i][j].x * rstd * g[j].x, v[i][j].y * rstd * g[j].y) | ((unsigned long long)pk2(v[i][j].z * rstd * g[j].z, v[i][j].w * rstd * g[j].w) << 32); } } }
    constexpr int I_ABIN = (DM / 64) * (AB_IN / 32), I_W1 = (DM / 64) * (FF / 32), I_W2 = (FF / 64) * (DM / 32), I_CDIN = (DM / 64) * (CD_IN / 32), I_CDOUT = (DM / 64) * (DM / 32);
    constexpr int NITEMS = I_ABIN + 2 * I_W1 + 2 * I_W2 + I_CDIN + I_CDOUT;
    for (int it = gw; it < NITEMS; it += NGW) {
        int r = it;
        if (r < I_ABIN) { transpose_item(F.in[3], nullptr, DM, AB_IN, (bf16*)(F.ws + WS_WABIN), scr, r, F.lane); continue; } r -= I_ABIN;
        if (r < I_W1) { transpose_item(F.in[15], mlpg, DM, FF, (bf16*)(F.ws + WS_W1), scr, r, F.lane); continue; } r -= I_W1;
        if (r < I_W1) { transpose_item(F.in[15] + (size_t)DM * FF, mlpg + DM, DM, FF, (bf16*)(F.ws + WS_W1 + 8 * MiB), scr, r, F.lane); continue; } r -= I_W1;
        if (r < I_W2) { transpose_item(F.in[16], nullptr, FF, DM, (bf16*)(F.ws + WS_W2), scr, r, F.lane); continue; } r -= I_W2;
        if (r < I_W2) { transpose_item(F.in[16] + (size_t)FF * DM, nullptr, FF, DM, (bf16*)(F.ws + WS_W2 + 8 * MiB), scr, r, F.lane); continue; } r -= I_W2;
        if (r < I_CDIN) { transpose_item(F.in[9], mixg + DM, DM, CD_IN, (bf16*)(F.ws + WS_WCDIN), scr, r, F.lane); continue; } r -= I_CDIN;
        transpose_item(F.in[14], nullptr, DM, DM, (bf16*)(F.ws + WS_WCDOUT), scr, r, F.lane);
    }
    { const float* pw = F.in[4]; const float* psc = F.in[5]; const float* wo = F.in[8]; float* tmp = (float*)(F.ws + WS_TMPF);
      for (int it = gw; it < 128 * 16; it += NGW) { const int k0 = (it >> 4) * 4, n = (it & 15) * 64 + F.lane, g = k0 >> 7;
          const float* pwr = pw + (size_t)k0 * 128; const float* scr_ = psc + g * 128; const float* wor = wo + (size_t)(g * 128) * DM + n; float a[4] = {0.f, 0.f, 0.f, 0.f};
#pragma unroll 16
          for (int d = 0; d < 128; ++d) { const float wv = wor[(size_t)d * DM] * scr_[d];
#pragma unroll
              for (int j = 0; j < 4; ++j) a[j] += pwr[j * 128 + d] * wv; }
#pragma unroll
          for (int j = 0; j < 4; ++j) tmp[(size_t)(k0 + j) * DM + n] = a[j]; } }
    { const float* sw = F.in[12]; bf16* wc = (bf16*)(F.ws + WS_WSGU);
      for (int it = gw * 64 + F.lane; it < 4 * 128 * 16; it += NGW * 64) { const int tt = (it >> 4) & 127, s0 = (it & 15) * 8; float f[8];
#pragma unroll
          for (int e = 0; e < 8; ++e) f[e] = (s0 + e <= tt) ? sw[(size_t)it * 8 + e] : 0.f;
          *(GAS v4u*)(wc + (size_t)it * 8) = pack8(f); } }
}

template <int W> __device__ __forceinline__ void pool_task(const bf16* P, bf16* MX, size_t rb, int t0, int c0) {
    v4u r[W + 7];
#pragma unroll
    for (int j = 0; j < W + 7; ++j) { const int t = t0 - (W - 1) + j; r[j] = (t >= 0) ? *(const GAS v4u*)(P + (rb + t) * AB_IN + c0) : (v4u){0u, 0u, 0u, 0u}; }
    float sum[8], a[8];
#pragma unroll
    for (int e = 0; e < 8; ++e) sum[e] = 0.f;
#pragma unroll
    for (int j = 0; j < W - 1; ++j) { unpack8(r[j], a);
#pragma unroll
        for (int e = 0; e < 8; ++e) sum[e] += a[e]; }
#pragma unroll
    for (int i = 0; i < 8; ++i) { const int t = t0 + i; unpack8(r[W - 1 + i], a);
        const float inv = 1.0f / (float)(t + 1 < W ? t + 1 : W); float o[8];
#pragma unroll
        for (int e = 0; e < 8; ++e) { sum[e] += a[e]; o[e] = sum[e] * inv - a[e]; }
        *(GAS v4u*)(MX + (rb + t) * DM + c0) = pack8(o);
        unpack8(r[i], a);
#pragma unroll
        for (int e = 0; e < 8; ++e) sum[e] -= a[e]; }
}
__device__ __forceinline__ void p2_mixer_ab(Frame& F) {
    { LAS float* scr = (LAS float*)(F.lds + RING_OFF + F.wave * 16384); const int gw = F.vcu * NWAVES + F.wave, NGW = F.G * NWAVES;
      bf16* wt = (bf16*)(F.ws + WS_WABOUT);
      for (int it = gw; it < (DM / 64) * (DM / 32); it += NGW) {
          const int kb = it / (DM / 32);
          transpose_item(kb < 8 ? (const float*)(F.ws + WS_TMPF) : F.in[8], nullptr, DM, DM, wt, scr, it, F.lane); } }
    const bf16* P = (const bf16*)(F.ws + WS_BIG); bf16* MX = (bf16*)(F.ws + WS_MIX);
    const float* cw = F.in[6]; const float* cb = F.in[7];
    const int w = F.wave, lane = F.lane;
    for (int u = F.vcu; u < BATCH * 32; u += F.G) {
        const int b = u >> 5, seg = u & 31; const size_t rb = (size_t)b * SEQ;
        { const int g = w >> 1, c0 = g * 128 + (lane & 15) * 8, t0 = seg * 64 + ((w & 1) * 4 + (lane >> 4)) * 8;
          if (g == 0) pool_task<2>(P, MX, rb, t0, c0); else if (g == 1) pool_task<4>(P, MX, rb, t0, c0); else if (g == 2) pool_task<8>(P, MX, rb, t0, c0); else pool_task<16>(P, MX, rb, t0, c0); }
        const int cc = lane * 8; float w0[8], w1[8], w2[8], bb[8];
#pragma unroll
        for (int e = 0; e < 8; ++e) { w0[e] = cw[cc + e]; w1[e] = cw[512 + cc + e]; w2[e] = cw[1024 + cc + e]; bb[e] = cb[cc + e]; }
#pragma unroll
        for (int j = 0; j < 2; ++j) {
            const int t0 = seg * 64 + (w * 2 + j) * 4; v4u rx[6], rc[6], rg[4];
#pragma unroll
            for (int i = 0; i < 6; ++i) { const int t = t0 - 2 + i; const bool ok = t >= 0; const bf16* pr = P + (rb + (ok ? t : 0)) * AB_IN;
                rx[i] = ok ? *(const GAS v4u*)(pr + 512 + cc) : (v4u){0u, 0u, 0u, 0u}; rc[i] = ok ? *(const GAS v4u*)(pr + 1536 + cc) : (v4u){0u, 0u, 0u, 0u}; }
#pragma unroll
            for (int i = 0; i < 4; ++i) rg[i] = *(const GAS v4u*)(P + (rb + t0 + i) * AB_IN + 1024 + cc);
            float gx[6][8];
#pragma unroll
            for (int i = 0; i < 6; ++i) { float xb[8], gc[8]; unpack8(rx[i], xb); unpack8(rc[i], gc);
#pragma unroll
                for (int e = 0; e < 8; ++e) gx[i][e] = gc[e] * xb[e]; }
#pragma unroll
            for (int i = 0; i < 4; ++i) { float gb[8], o[8]; unpack8(rg[i], gb);
#pragma unroll
                for (int e = 0; e < 8; ++e) o[e] = gb[e] * (w0[e] * gx[i][e] + w1[e] * gx[i + 1][e] + w2[e] * gx[i + 2][e] + bb[e]);
                *(GAS v4u*)(MX + (rb + t0 + i) * DM + 512 + cc) = pack8(o); }
        }
    }
}
namespace sba {
using bf16x8 = __attribute__((ext_vector_type(8))) short;
using f16x8 = __attribute__((ext_vector_type(8))) _Float16;
using s16x4 = __attribute__((ext_vector_type(4))) short;
using f32x16 = __attribute__((ext_vector_type(16))) float;
using u32x4 = __attribute__((ext_vector_type(4))) unsigned;
typedef short v4i16_t __attribute__((ext_vector_type(4)));
typedef float f32x2_t __attribute__((ext_vector_type(2))); typedef __bf16 bf16x2_t __attribute__((ext_vector_type(2))); typedef _Float16 f16x2_t __attribute__((ext_vector_type(2)));
typedef __attribute__((address_space(3))) const char* lds_cptr;
typedef __attribute__((address_space(3))) char* lds_ptr;
__device__ __forceinline__ unsigned pk_bf16(float lo, float hi) { f32x2_t v = {lo, hi}; bf16x2_t b = __builtin_convertvector(v, bf16x2_t); return __builtin_bit_cast(unsigned, b); }
__device__ __forceinline__ unsigned pk_f16(float lo, float hi) { f32x2_t v = {lo, hi}; f16x2_t b = __builtin_convertvector(v, f16x2_t); return __builtin_bit_cast(unsigned, b); }
__device__ __forceinline__ s16x4 vtr(lds_cptr p) { return __builtin_bit_cast(s16x4, __builtin_amdgcn_ds_read_tr16_b64_v4i16((__attribute__((address_space(3))) v4i16_t*)p)); }
#define SB_MFMA_BF16(a, b, c) __builtin_amdgcn_mfma_f32_32x32x16_bf16((a), (b), (c), 0, 0, 0)
#define SB_MFMA_F16(a, b, c) __builtin_amdgcn_mfma_f32_32x32x16_f16((a), (b), (c), 0, 0, 0)
constexpr int KV = 64, SLOT = 16384;

template <bool DIAG>
__device__ __forceinline__ void tile(lds_cptr Kb, lds_cptr Vb, const bf16x8 (&qf)[4], f32x16& o0, f32x16& o1, f32x16& carry,
                                     const f16x8 T0, const f16x8 T1, const f16x8 ONES, int r, int hi, int lane, int limA) {
    f32x16 p0, p1;
#pragma unroll
    for (int i = 0; i < 16; ++i) { p0[i] = 0.f; p1[i] = 0.f; }
    const lds_cptr kp = Kb + hi * 1024 + r * 16;
#pragma unroll
    for (int d0 = 0; d0 < 4; ++d0) {
        const bf16x8 a0 = *(const __attribute__((address_space(3))) bf16x8*)(kp + d0 * 2048);
        const bf16x8 a1 = *(const __attribute__((address_space(3))) bf16x8*)(kp + d0 * 2048 + 512);
        p0 = SB_MFMA_BF16(a0, qf[d0], p0); p1 = SB_MFMA_BF16(a1, qf[d0], p1); }
    unsigned l0p[8], l1p[8];
#pragma unroll
    for (int i = 0; i < 16; i += 2) {
        float n0[2], n1[2];
#pragma unroll
        for (int e = 0; e < 2; ++e) { const int ci = ((i + e) & 3) + 8 * ((i + e) >> 2);
            { const float S = p0[i + e]; const float ex = __builtin_amdgcn_exp2f(-__builtin_fabsf(S)), l = __builtin_amdgcn_logf(1.0f + ex); float nsp = __builtin_fminf(-S, 0.f) - l;
              if (DIAG) nsp = (ci < limA) ? nsp : 0.f; n0[e] = nsp; p0[i + e] = S + nsp; }
            { const float S = p1[i + e]; const float ex = __builtin_amdgcn_exp2f(-__builtin_fabsf(S)), l = __builtin_amdgcn_logf(1.0f + ex); float nsp = __builtin_fminf(-S, 0.f) - l;
              if (DIAG) nsp = (ci + 32 < limA) ? nsp : 0.f; n1[e] = nsp; p1[i + e] = S + nsp; } }
        l0p[i >> 1] = pk_f16(n0[0], n0[1]); l1p[i >> 1] = pk_f16(n1[0], n1[1]); }
    const f16x8 l0a = __builtin_bit_cast(f16x8, (u32x4){l0p[0], l0p[1], l0p[2], l0p[3]}), l0b = __builtin_bit_cast(f16x8, (u32x4){l0p[4], l0p[5], l0p[6], l0p[7]});
    const f16x8 l1a = __builtin_bit_cast(f16x8, (u32x4){l1p[0], l1p[1], l1p[2], l1p[3]}), l1b = __builtin_bit_cast(f16x8, (u32x4){l1p[4], l1p[5], l1p[6], l1p[7]});
    f32x16 u1 = SB_MFMA_F16(ONES, l1a, carry); u1 = SB_MFMA_F16(ONES, l1b, u1);
    f32x16 y0 = SB_MFMA_F16(T0, l0a, u1); y0 = SB_MFMA_F16(T1, l0b, y0);
    f32x16 y1 = SB_MFMA_F16(T0, l1a, carry); y1 = SB_MFMA_F16(T1, l1b, y1);
    carry = SB_MFMA_F16(ONES, l0a, u1); carry = SB_MFMA_F16(ONES, l0b, carry);
    unsigned w0p[8], w1p[8];
#pragma unroll
    for (int i = 0; i < 16; i += 2) {
        float a[2], b[2];
#pragma unroll
        for (int e = 0; e < 2; ++e) { const int ci = ((i + e) & 3) + 8 * ((i + e) >> 2);
            a[e] = __builtin_amdgcn_exp2f(p0[i + e] + y0[i + e]); b[e] = __builtin_amdgcn_exp2f(p1[i + e] + y1[i + e]);
            if (DIAG) { a[e] = (ci < limA) ? a[e] : 0.f; b[e] = (ci + 32 < limA) ? b[e] : 0.f; } }
        w0p[i >> 1] = pk_bf16(a[0], a[1]); w1p[i >> 1] = pk_bf16(b[0], b[1]); }
    const bf16x8 pa0 = __builtin_bit_cast(bf16x8, (u32x4){w0p[0], w0p[1], w0p[2], w0p[3]}), pa1 = __builtin_bit_cast(bf16x8, (u32x4){w0p[4], w0p[5], w0p[6], w0p[7]});
    const bf16x8 pa2 = __builtin_bit_cast(bf16x8, (u32x4){w1p[0], w1p[1], w1p[2], w1p[3]}), pa3 = __builtin_bit_cast(bf16x8, (u32x4){w1p[4], w1p[5], w1p[6], w1p[7]});
    const lds_cptr vp = Vb + ((lane >> 4) & 1) * 32 + (lane & 3) * 8 + (4 * hi + ((lane & 15) >> 2)) * 64;
#pragma unroll
    for (int d0 = 0; d0 < 2; ++d0) {
        s16x4 lo[4], hh[4];
#pragma unroll
        for (int ks = 0; ks < 4; ++ks) { lo[ks] = vtr(vp + d0 * 4096 + ks * 1024); hh[ks] = vtr(vp + d0 * 4096 + ks * 1024 + 512); }
#define SB_PK(k) (bf16x8){lo[k][0], lo[k][1], lo[k][2], lo[k][3], hh[k][0], hh[k][1], hh[k][2], hh[k][3]}
        f32x16 o = d0 == 0 ? o0 : o1;
        o = SB_MFMA_BF16(pa0, SB_PK(0), o); o = SB_MFMA_BF16(pa1, SB_PK(1), o); o = SB_MFMA_BF16(pa2, SB_PK(2), o); o = SB_MFMA_BF16(pa3, SB_PK(3), o);
        if (d0 == 0) o0 = o; else o1 = o;
#undef SB_PK
    }
}
}

__device__ __forceinline__ void p7_attention_mfma(Frame& F) {
    using namespace sba;
    const bf16* QKV = (const bf16*)(F.ws + WS_QKV); bf16* MX = (bf16*)(F.ws + WS_MIX);
    const lds_ptr L = (lds_ptr)(F.lds + RING_OFF);
    volatile LAS unsigned* dflag = (volatile LAS unsigned*)(F.lds + RING_OFF + 2 * sba::SLOT);
    const int lane = F.lane, r = lane & 31, hi = lane >> 5, w = F.wave;
    unsigned t0w[4], t1w[4];
#pragma unroll
    for (int jj = 0; jj < 4; ++jj) { const int j = 2 * jj; const int k0 = 8 * (j >> 2) + 4 * hi + (j & 3), k1 = k0 + 1;
        t0w[jj] = (k0 > r ? 0x3C00u : 0u) | (k1 > r ? 0x3C000000u : 0u); t1w[jj] = (k0 + 16 > r ? 0x3C00u : 0u) | (k1 + 16 > r ? 0x3C000000u : 0u); }
    const f16x8 T0 = __builtin_bit_cast(f16x8, (u32x4){t0w[0], t0w[1], t0w[2], t0w[3]}), T1 = __builtin_bit_cast(f16x8, (u32x4){t1w[0], t1w[1], t1w[2], t1w[3]});
    const f16x8 ONES = __builtin_bit_cast(f16x8, (u32x4){0x3C003C00u, 0x3C003C00u, 0x3C003C00u, 0x3C003C00u});
    const int limA = 32 * (w & 1) + r - 4 * hi;
    const int skv = F.tid & 63, sch = F.tid >> 6;
    const int kdst = sch * 1024 + skv * 16, vdst = 8192 + (sch >> 2) * 4096 + skv * 64 + (sch & 3) * 16;
    for (int u = F.vcu; u < 1024; u += F.G) {
        const int bh = (u & 255) >> 1, ii = (u >> 8) & 3, odd = u & 1;
        const int qb = odd ? (ii == 0 ? 1 : ii == 1 ? 6 : ii == 2 ? 2 : 5) : (ii == 0 ? 0 : ii == 1 ? 7 : ii == 2 ? 3 : 4);
        const int b = bh >> 3, h = bh & 7; const size_t rb = (size_t)b * SEQ;
        const bf16* kbase = QKV + rb * 1536 + 512 + h * 64 + sch * 8;
        bf16x8 qf[4];
        { const bf16* qp = QKV + (rb + 256 * qb + 32 * w + r) * 1536 + h * 64 + hi * 8;
#pragma unroll
          for (int d0 = 0; d0 < 4; ++d0) qf[d0] = *(const bf16x8*)(qp + d0 * 16); }
        f32x16 o0, o1, carry;
#pragma unroll
        for (int i = 0; i < 16; ++i) { o0[i] = 0.f; o1[i] = 0.f; carry[i] = 0.f; }
        const int ttd = 4 * qb + (w >> 1), ntile = 4 * qb + 4;
        __syncthreads();
        { const bf16* kp = kbase + (size_t)((ntile - 1) * KV + skv) * 1536; const v4u kr = *(const GAS v4u*)kp, vr = *(const GAS v4u*)(kp + 512);
          *(__attribute__((address_space(3))) v4u*)(L + kdst) = kr; *(__attribute__((address_space(3))) v4u*)(L + vdst) = vr; }
        __syncthreads();
        int cur = 0; bool wdone = false;
        for (int tt = ntile - 1; tt >= 0; --tt) {
            v4u kr, vr;
            if (tt > 0) { const bf16* kp = kbase + (size_t)((tt - 1) * KV + skv) * 1536; kr = *(const GAS v4u*)kp; vr = *(const GAS v4u*)(kp + 512); }
            const lds_cptr Kb = (lds_cptr)(L + cur * SLOT), Vb = Kb + 8192;
            if (!wdone) {
                if (tt < ttd) { tile<false>(Kb, Vb, qf, o0, o1, carry, T0, T1, ONES, r, hi, lane, limA); wdone = __all(carry[0] < -150.0f) != 0; }
                else if (tt == ttd) { tile<true>(Kb, Vb, qf, o0, o1, carry, T0, T1, ONES, r, hi, lane, limA); wdone = __all(carry[0] < -150.0f) != 0; }
            }
            if (tt > 0) { *(__attribute__((address_space(3))) v4u*)(L + (cur ^ 1) * SLOT + kdst) = kr; *(__attribute__((address_space(3))) v4u*)(L + (cur ^ 1) * SLOT + vdst) = vr; }
            if (lane == 0) dflag[(tt & 1) * 8 + w] = wdone ? 1u : 0u;
            __syncthreads();
            { const unsigned f = dflag[(tt & 1) * 8 + (lane & 7)]; if (__all(f != 0u)) break; }
            cur ^= 1;
        }
        { bf16* op = MX + (rb + 256 * qb + 32 * w) * DM + 512 + h * 64 + r;
#pragma unroll
          for (int i = 0; i < 16; ++i) { const int q = (i & 3) + 8 * (i >> 2) + 4 * hi;
              op[(size_t)q * DM] = (bf16)f2bf(o0[i]); op[(size_t)q * DM + 32] = (bf16)f2bf(o1[i]); } }
    }
    __syncthreads();
}

__device__ __forceinline__ void p7_attention(Frame& F) {
    typedef float f4 __attribute__((ext_vector_type(4)));
    LAS f4* Ks = (LAS f4*)(F.lds + RING_OFF); LAS f4* Vs = Ks + 1024;
    const bf16* QKV = (const bf16*)(F.ws + WS_QKV); bf16* MX = (bf16*)(F.ws + WS_MIX);
    for (int u = F.vcu; u < 512; u += F.G) {
        const int bh = (u & 255) >> 1, q01 = u & 1, qq = (u >> 8) ? 3 - q01 : q01, b = bh >> 3, h = bh & 7;
        const int t = 512 * qq + F.tid; const size_t rb = (size_t)b * SEQ;
        float q[64], o[64];
        { const bf16* qp = QKV + (rb + t) * 1536 + h * 64;
#pragma unroll
          for (int c = 0; c < 8; ++c) unpack8(*(const GAS v4u*)(qp + c * 8), q + c * 8); }
#pragma unroll
        for (int d = 0; d < 64; ++d) o[d] = 0.f;
        float carry = 0.f;
        const int wave_tmax = 512 * qq + 64 * F.wave + 63;
        for (int tt = 8 * qq + 7; tt >= 0; --tt) {
            __syncthreads();
            { const int kk = F.tid >> 3, c8 = F.tid & 7; const bf16* kp = QKV + (rb + tt * 64 + kk) * 1536 + 512 + h * 64 + c8 * 8; float f[8];
              unpack8(*(const GAS v4u*)kp, f); Ks[kk * 16 + c8 * 2] = (f4){f[0], f[1], f[2], f[3]}; Ks[kk * 16 + c8 * 2 + 1] = (f4){f[4], f[5], f[6], f[7]};
              unpack8(*(const GAS v4u*)(kp + 512), f); Vs[kk * 16 + c8 * 2] = (f4){f[0], f[1], f[2], f[3]}; Vs[kk * 16 + c8 * 2 + 1] = (f4){f[4], f[5], f[6], f[7]}; }
            __syncthreads();
            if (tt * 64 < wave_tmax) {
                for (int s = 63; s >= 0; --s) {
                    float d0 = 0.f, d1 = 0.f;
#pragma unroll
                    for (int c = 0; c < 16; c += 2) { const f4 k0 = Ks[s * 16 + c], k1 = Ks[s * 16 + c + 1];
                        d0 += q[4 * c] * k0.x + q[4 * c + 1] * k0.y + q[4 * c + 2] * k0.z + q[4 * c + 3] * k0.w;
                        d1 += q[4 * c + 4] * k1.x + q[4 * c + 5] * k1.y + q[4 * c + 6] * k1.z + q[4 * c + 7] * k1.w; }
                    const float S = d0 + d1; const bool valid = (tt * 64 + s) < t;
                    const float e = __builtin_amdgcn_exp2f(-fabsf(S)), l = __builtin_amdgcn_logf(1.0f + e), nsp = fminf(-S, 0.f) - l, lb = S + nsp;
                    const float w = valid ? __builtin_amdgcn_exp2f(lb + carry) : 0.f; carry += valid ? nsp : 0.f;
#pragma unroll
                    for (int c = 0; c < 16; ++c) { const f4 v = Vs[s * 16 + c]; o[4 * c] += w * v.x; o[4 * c + 1] += w * v.y; o[4 * c + 2] += w * v.z; o[4 * c + 3] += w * v.w; }
                }
            }
        }
        { bf16* op = MX + (rb + t) * DM + 512 + h * 64;
#pragma unroll
          for (int c = 0; c < 8; ++c) *(GAS v4u*)(op + c * 8) = pack8(o + c * 8); }
    }
    __syncthreads();
}
__device__ __forceinline__ void p7_sgu_mfma(Frame& F) {
    typedef __attribute__((address_space(3))) unsigned short lds_u16;
    constexpr int PITCH = 136;
    LAS float* st = (LAS float*)(F.lds + RING_OFF); LAS unsigned char* VT = F.lds + RING_OFF + 1024;
    const bf16* UV = (const bf16*)(F.ws + WS_BIG); bf16* MX = (bf16*)(F.ws + WS_MIX); const bf16* WC = (const bf16*)(F.ws + WS_WSGU);
    const float* gam = F.in[10]; const float* bet = F.in[11]; const float* sb = F.in[13];
    const int lane = F.lane, w = F.wave, fr = lane & 15, fq = lane >> 4;
    for (int u = F.vcu; u < 256; u += F.G) {
        const size_t row0 = (size_t)(u >> 4) * SEQ + (size_t)(u & 15) * 128;
        __syncthreads();
        for (int i = 0; i < 16; ++i) { const int s = 16 * w + i; float f[8]; unpack8(*(const GAS v4u*)(UV + (row0 + s) * 1024 + 512 + lane * 8), f);
            float a = 0.f;
#pragma unroll
            for (int e = 0; e < 8; ++e) a += f[e];
            const float mean = wave_sum(a) * (1.0f / 512.0f); float qv = 0.f;
#pragma unroll
            for (int e = 0; e < 8; ++e) { const float d = f[e] - mean; qv += d * d; }
            const float rstd = 1.0f / sqrtf(wave_sum(qv) * (1.0f / 512.0f) + EPS);
            if (lane == 0) { st[s] = mean; st[128 + s] = rstd; } }
        __syncthreads();
        for (int g = 0; g < 4; ++g) {
            { const int s = 64 * (w & 1) + lane, cq = w >> 1; const float mean = st[s], rstd = st[128 + s];
#pragma unroll
              for (int j = 0; j < 4; ++j) { const int c0 = (4 * cq + j) * 8; float f[8]; unpack8(*(const GAS v4u*)(UV + (row0 + s) * 1024 + 512 + g * 128 + c0), f);
#pragma unroll
                  for (int e = 0; e < 8; ++e) { const float vn = (f[e] - mean) * rstd * gam[g * 128 + c0 + e] + bet[g * 128 + c0 + e];
                      *(lds_u16*)(VT + ((c0 + e) * PITCH + s) * 2) = (unsigned short)f2bf(vn); } } }
            __syncthreads();
            { pg8::f32x4 acc[8];
#pragma unroll
              for (int ct = 0; ct < 8; ++ct) acc[ct] = (pg8::f32x4){0.f, 0.f, 0.f, 0.f};
              const int t = 16 * w + fr; const bf16* wrow = WC + ((size_t)g * 128 + t) * 128 + 8 * fq;
              for (int ks = 0; ks <= (w >> 1); ++ks) {
                  const bf16x8 bfr = *(const bf16x8*)(wrow + 32 * ks);
#pragma unroll
                  for (int ct = 0; ct < 8; ++ct) { const bf16x8 afr = *(const LAS bf16x8*)(VT + ((16 * ct + fr) * PITCH + 32 * ks + 8 * fq) * 2);
                      acc[ct] = __builtin_amdgcn_mfma_f32_16x16x32_bf16(afr, bfr, acc[ct], 0, 0, 0); } }
              const float bias = sb[g * 128 + t]; const size_t ro = (row0 + t) * 1024 + g * 128 + 4 * fq;
#pragma unroll
              for (int ct = 0; ct < 8; ++ct) { const unsigned long long uu = *(const GAS unsigned long long*)(UV + ro + 16 * ct);
                  const float u0 = __builtin_bit_cast(float, (unsigned)(uu << 16)), u1 = __builtin_bit_cast(float, (unsigned)uu & 0xffff0000u), u2 = __builtin_bit_cast(float, (unsigned)(uu >> 32) << 16), u3 = __builtin_bit_cast(float, (unsigned)(uu >> 32) & 0xffff0000u);
                  const unsigned long long o = (unsigned long long)pk2(u0 * (acc[ct][0] + bias), u1 * (acc[ct][1] + bias)) | ((unsigned long long)pk2(u2 * (acc[ct][2] + bias), u3 * (acc[ct][3] + bias)) << 32);
                  *(GAS unsigned long long*)(MX + ro + 16 * ct) = o; } }
            __syncthreads();
        }
    }
}

__device__ __forceinline__ void p7_sgu(Frame& F) {
    LAS float* st = (LAS float*)(F.lds + RING_OFF); LAS float* VN = st + 256;
    const bf16* UV = (const bf16*)(F.ws + WS_BIG); bf16* MX = (bf16*)(F.ws + WS_MIX);
    const float* gam = F.in[10]; const float* bet = F.in[11]; const float* sw = F.in[12]; const float* sb = F.in[13];
    for (int u = F.vcu; u < 256; u += F.G) {
        const size_t row0 = (size_t)(u >> 4) * SEQ + (size_t)(u & 15) * 128;
        __syncthreads();
        for (int i = 0; i < 16; ++i) { const int s = 16 * F.wave + i; float f[8]; unpack8(*(const GAS v4u*)(UV + (row0 + s) * 1024 + 512 + F.lane * 8), f);
            float a = 0.f;
#pragma unroll
            for (int e = 0; e < 8; ++e) a += f[e];
            const float mean = wave_sum(a) * (1.0f / 512.0f); float qv = 0.f;
#pragma unroll
            for (int e = 0; e < 8; ++e) { const float d = f[e] - mean; qv += d * d; }
            const float rstd = 1.0f / sqrtf(wave_sum(qv) * (1.0f / 512.0f) + EPS);
            if (F.lane == 0) { st[s] = mean; st[128 + s] = rstd; } }
        __syncthreads();
        for (int g = 0; g < 4; ++g) {
            { const int s = F.tid >> 2, cq = F.tid & 3; const float mean = st[s], rstd = st[128 + s];
#pragma unroll
              for (int j = 0; j < 4; ++j) { const int c = cq * 32 + j * 8; float f[8]; unpack8(*(const GAS v4u*)(UV + (row0 + s) * 1024 + 512 + g * 128 + c), f);
#pragma unroll
                  for (int e = 0; e < 8; ++e) VN[s * 128 + c + e] = (f[e] - mean) * rstd * gam[g * 128 + c + e] + bet[g * 128 + c + e]; } }
            __syncthreads();
            { const int c = F.tid & 127, tq = F.tid >> 7;
              for (int i = 0; i < 32; ++i) { const int t = tq * 32 + i; const float* wr = sw + ((size_t)g * 128 + t) * 128; float a = 0.f;
                  for (int s = 0; s <= t; ++s) a += wr[s] * VN[s * 128 + c];
                  const float uu = bf2f(UV[(row0 + t) * 1024 + g * 128 + c]);
                  MX[(row0 + t) * DM + g * 128 + c] = (bf16)f2bf(uu * (a + sb[g * 128 + t])); } }
            __syncthreads();
        }
    }
}
__device__ __forceinline__ void p11_final(Frame& F) {
    const int gw = F.vcu * NWAVES + F.wave, NGW = F.G * NWAVES; const bf16* HB = (const bf16*)(F.ws + WS_XN); const float* gf = F.in[17];
    f32x4 g[4];
#pragma unroll
    for (int j = 0; j < 4; ++j) g[j] = *(const GAS f32x4*)(gf + (j >> 1) * 512 + F.lane * 8 + (j & 1) * 4);
    for (int m0 = gw * 2; m0 < M; m0 += NGW * 2) {
        v4u r[2][2];
#pragma unroll
        for (int i = 0; i < 2; ++i) { r[i][0] = *(const GAS v4u*)(HB + (size_t)(m0 + i) * DM + F.lane * 8); r[i][1] = *(const GAS v4u*)(HB + (size_t)(m0 + i) * DM + 512 + F.lane * 8); }
#pragma unroll
        for (int i = 0; i < 2; ++i) { float f[16]; unpack8(r[i][0], f); unpack8(r[i][1], f + 8); float s = 0.f;
#pragma unroll
            for (int e = 0; e < 16; ++e) s += f[e] * f[e];
            const float rstd = 1.0f / sqrtf(wave_sum(s) * (1.f / DM) + EPS); float* op = F.out + (size_t)(m0 + i) * DM + F.lane * 8;
#pragma unroll
            for (int j = 0; j < 4; ++j) *(GAS f32x4*)(op + (j >> 1) * 512 + (j & 1) * 4) = (f32x4){f[4 * j] * rstd * g[j].x, f[4 * j + 1] * rstd * g[j].y, f[4 * j + 2] * rstd * g[j].z, f[4 * j + 3] * rstd * g[j].w}; } }
}

struct Args { const float* in[18]; float* out; unsigned char* ws; int ph_lo, ph_hi, li, pad; };
__global__ void __launch_bounds__(NWAVES * 64, 2) trunk_fwd(Args args) {
    extern __shared__ __attribute__((aligned(16))) unsigned char lds[];
    Frame F;
    F.lds = (LAS unsigned char*)lds;
    F.MISC = (volatile LAS unsigned*)(F.lds + MISC_OFF);
    F.tid = threadIdx.x; F.lane = F.tid & 63; F.wave = __builtin_amdgcn_readfirstlane(F.tid >> 6);
    F.G = gridDim.x; { const int bx = blockIdx.x; F.vcu = (F.G % 8 == 0) ? (bx % 8) * (F.G / 8) + bx / 8 : bx; }
#pragma unroll
    for (int i = 0; i < 18; ++i) F.in[i] = args.in[i];
    F.out = args.out; F.ws = args.ws; F.ctl = (gu32*)(args.ws + WS_CTL);
    for (int u = F.tid; u < (LDS_BYTES - LDSCTL_OFF) / 4; u += NWAVES * 64) ((LAS unsigned*)(F.lds + LDSCTL_OFF))[u] = 0u;
    __syncthreads();
    XcdBarrier bar = xcd_barrier_post((unsigned*)(F.ctl + CW_BAR) + args.li * XCD_BAR_WORDS, F.MISC + 8);
    const int lo = args.ph_lo, hi = args.ph_hi;
#define IN(k) (lo <= (k) && (k) < hi)
#define SEAM(k) do { if (IN(k) && IN((k) + 1)) xcd_barrier(bar); } while (0)
    bf16* XN = (bf16*)(F.ws + WS_XN); bf16* MIX = (bf16*)(F.ws + WS_MIX); bf16* BIG = (bf16*)(F.ws + WS_BIG); bf16* QKV = (bf16*)(F.ws + WS_QKV); float* SS = (float*)(F.ws + WS_SS);
    if (IN(0)) { p0_prologue(F); SEAM(0); }
    if (IN(1)) { pg8::Gemm g{XN, (const bf16*)(F.ws + WS_WABIN), M, AB_IN, DM}; pg8::StaticOrder S; S.init(M, AB_IN, F.G, (int)blockIdx.x);
        pg8::EpiStore E{BIG, AB_IN};
        pg8::gemm_phase<pg8::EpiStore, pg8::StaticOrder, true, true>(F.lds + RING_OFF, g, S, E); SEAM(1); }
    if (IN(2)) { p2_mixer_ab(F); SEAM(2); }
    if (IN(3)) { pg8::Gemm g{MIX, (const bf16*)(F.ws + WS_WABOUT), M, DM, DM}; pg8::StaticOrder S; S.init(M, DM, F.G, (int)blockIdx.x);
        pg8::EpiResid<true, true> E{F.in[0], XN, SS};
        pg8::gemm_phase<pg8::EpiResid<true, true>, pg8::StaticOrder, true, true>(F.lds + RING_OFF, g, S, E); SEAM(3); }
    if (IN(4)) { pg8::Gemm g{XN, (const bf16*)(F.ws + WS_W1), M, FF, DM}; pg8::StaticOrder S; S.init(M, FF, F.G, (int)blockIdx.x);
        pg8::EpiUp E{BIG, SS};
        pg8::gemm_phase<pg8::EpiUp, pg8::StaticOrder, true, true>(F.lds + RING_OFF, g, S, E); SEAM(4); }
    if (IN(5)) { pg8::Gemm g{BIG, (const bf16*)(F.ws + WS_W2), M, DM, FF}; pg8::StaticOrder S; S.init(M, DM, F.G, (int)blockIdx.x);
        pg8::EpiResid<false, true> E{nullptr, XN, SS};
        pg8::gemm_phase<pg8::EpiResid<false, true>, pg8::StaticOrder, true, true>(F.lds + RING_OFF, g, S, E); SEAM(5); }
    if (IN(6)) { pg8::Gemm g{XN, (const bf16*)(F.ws + WS_WCDIN), M, CD_IN, DM}; pg8::StaticOrder S; S.init(M, CD_IN, F.G, (int)blockIdx.x);
        pg8::EpiCdIn E{BIG, QKV, SS, QSCALE};
        pg8::gemm_phase<pg8::EpiCdIn, pg8::StaticOrder, true, true>(F.lds + RING_OFF, g, S, E); SEAM(6); }
    if (IN(7)) { p7_attention_mfma(F); p7_sgu_mfma(F); SEAM(7); }
    if (IN(8)) { pg8::Gemm g{MIX, (const bf16*)(F.ws + WS_WCDOUT), M, DM, DM}; pg8::StaticOrder S; S.init(M, DM, F.G, (int)blockIdx.x);
        pg8::EpiResid<false, true> E{nullptr, XN, SS};
        pg8::gemm_phase<pg8::EpiResid<false, true>, pg8::StaticOrder, true, true>(F.lds + RING_OFF, g, S, E); SEAM(8); }
    if (IN(9)) { pg8::Gemm g{XN, (const bf16*)(F.ws + WS_W1 + 8 * MiB), M, FF, DM}; pg8::StaticOrder S; S.init(M, FF, F.G, (int)blockIdx.x);
        pg8::EpiUp E{BIG, SS};
        pg8::gemm_phase<pg8::EpiUp, pg8::StaticOrder, true, true>(F.lds + RING_OFF, g, S, E); SEAM(9); }
    if (IN(10)) { pg8::Gemm g{BIG, (const bf16*)(F.ws + WS_W2 + 8 * MiB), M, DM, FF}; pg8::StaticOrder S; S.init(M, DM, F.G, (int)blockIdx.x);
        pg8::EpiResid<false, false> E{nullptr, XN, SS};
        pg8::gemm_phase<pg8::EpiResid<false, false>, pg8::StaticOrder, true, true>(F.lds + RING_OFF, g, S, E); SEAM(10); }
    if (IN(11)) { p11_final(F); }
#undef IN
#undef SEAM
}

extern "C" void kernel_launch(void* const* d_in, const int* in_sizes, int n_in, void* d_out, int out_size, void* d_ws, size_t ws_size, hipStream_t stream) {
    static int grid = 0;
    if (grid == 0) {
        if (n_in != 18 || in_sizes[0] != M * DM || out_size != M * DM || ws_size < WS_END) { fprintf(stderr, "kernel_launch: unexpected shapes (n_in %d in0 %d out %d ws %zu); nothing launched\n", n_in, n_in > 0 ? in_sizes[0] : -1, out_size, ws_size); grid = -1; return; }
        int dev = 0, cus = 0, per_cu = 0;
        if (hipGetDevice(&dev) != hipSuccess || hipDeviceGetAttribute(&cus, hipDeviceAttributeMultiprocessorCount, dev) != hipSuccess) { grid = -1; return; }
        if (hipFuncSetAttribute((const void*)trunk_fwd, hipFuncAttributeMaxDynamicSharedMemorySize, LDS_BYTES) != hipSuccess) { fprintf(stderr, "kernel_launch: hipFuncSetAttribute failed\n"); grid = -1; return; }
        if (hipOccupancyMaxActiveBlocksPerMultiprocessor(&per_cu, (const void*)trunk_fwd, NWAVES * 64, LDS_BYTES) != hipSuccess || per_cu < 1) { fprintf(stderr, "kernel_launch: occupancy query reports %d workgroups per CU\n", per_cu); }
        (void)hipGetLastError();
        grid = cus;
    }
    if (grid < 0) return;
    if (hipMemsetAsync((char*)d_ws + WS_CTL, 0, CTL_ZERO_BYTES, stream) != hipSuccess) return;
    Args a{};
    for (int i = 0; i < 18; ++i) a.in[i] = (const float*)d_in[i];
    a.out = (float*)d_out; a.ws = (unsigned char*)d_ws;
#if PROBE_REPEAT >= 0
    const int plan[2][2] = {{0, PROBE_REPEAT + 1}, {PROBE_REPEAT, N_PHASES}}; const int nl = 2;
#else
    const int plan[1][2] = {{0, N_PHASES}}; const int nl = 1;
#endif
    for (int li = 0; li < nl; ++li) {
        a.ph_lo = plan[li][0]; a.ph_hi = plan[li][1]; a.li = li;
        hipLaunchKernelGGL(trunk_fwd, dim3(grid), dim3(NWAVES * 64), LDS_BYTES, stream, a);
    }
}
```

```cpp
#include <hip/hip_runtime.h>
#include <cstdio>
#include <cstdint>
namespace pg8 {
#define PG8_LAS __attribute__((address_space(3)))
typedef unsigned short bf16_t;
typedef short bf16x8 __attribute__((ext_vector_type(8)));
typedef float f32x4 __attribute__((ext_vector_type(4)));
typedef unsigned u32x4 __attribute__((ext_vector_type(4)));
constexpr int BM = 256, BK = 64, HALF = 128, HTB = HALF * BK * 2  , STAGE_BYTES = 8 * HTB, NXCD = 8, WGM = 8;

__host__ __device__ __forceinline__ int lds_byte(int r, int c) { const int st = (r >> 4) * 2 + (c >> 5), rr = r & 15, cc = c & 31, ob = rr * 64 + cc * 2; return st * 1024 + (ob ^ (((ob >> 9) & 1) << 5)); }
__host__ __device__ __forceinline__ void stage_rc(int b, int& R, int& C) { const int st = b / 1024, sb = b % 1024, swz = sb ^ (((sb >> 9) & 1) << 5); R = (st >> 1) * 16 + swz / 64; C = (st & 1) * 32 + (swz % 64) / 2; }
__host__ __device__ __forceinline__ int perm32(int rho) { const int n = rho >> 4, i = rho & 15; return 8 * (i >> 2) + 4 * n + (i & 3); }

struct Unit { int pm, pn; };
struct Gemm { const bf16_t* A; const bf16_t* Bt; int M, N, K; };

struct StaticOrder {
    int nM, nN, nwg, G, c;
    __host__ __device__ void init(int M, int N, int G_, int c_) { nM = M / BM; nN = N / BM; nwg = nM * nN; G = G_; c = c_; }
    __host__ __device__ bool next(int i, Unit& u) const {
        const long L = (long)i * G + c; if (L >= nwg) return false;
        int wgid = (int)L; { const int q = nwg / NXCD, r = nwg % NXCD, xcd = wgid % NXCD, off = wgid / NXCD; wgid = (xcd < r ? xcd * (q + 1) : r * (q + 1) + (xcd - r) * q) + off; }
        const int nig = WGM * nN, gid = wgid / nig, fm = gid * WGM, gsz = (nM - fm) < WGM ? (nM - fm) : WGM;
        u.pm = fm + ((wgid % nig) % gsz); u.pn = (wgid % nig) / gsz; return true;
    }
    __device__ __forceinline__ void a_ready(const Unit&) const {}
    __device__ __forceinline__ void done(const Unit&) const {}
};

__device__ __forceinline__ unsigned cvt_pk_bf16(float lo, float hi) { unsigned r; asm volatile("v_cvt_pk_bf16_f32 %0, %1, %2" : "=v"(r) : "v"(lo), "v"(hi)); return r; }
typedef float f32x2 __attribute__((ext_vector_type(2)));
__device__ __forceinline__ f32x2 gelu_pk(f32x2 v) {
    const f32x2 av = __builtin_elementwise_abs(v), d = av * 0.2316418882f + 1.0f;
    f32x2 t; t.x = __builtin_amdgcn_rcpf(d.x); t.y = __builtin_amdgcn_rcpf(d.y);
    f32x2 q = t * 0.5307027145f + (-0.7265760135f); q = q * t + 0.7107068705f; q = q * t + (-0.142248368f); q = q * t + 0.127414796f; q = q * t;
    const f32x2 s = (v * v) * (-0.72134752044f);
    f32x2 e; e.x = __builtin_amdgcn_exp2f(s.x); e.y = __builtin_amdgcn_exp2f(s.y);
    const f32x2 m = v * (q * e), r = v - m;
    f32x2 o; o.x = v.x < 0.f ? m.x : r.x; o.y = v.y < 0.f ? m.y : r.y; return o;
}
typedef unsigned u32x2 __attribute__((ext_vector_type(2)));
struct NoState {};
struct RowState { float ssv[2][4]; };
struct EpiStore {
    static constexpr bool PERM = true, AFTER_DRAIN = false; typedef NoState State;
    bf16_t* O; int ldc;
    __device__ __forceinline__ void pre(const Unit&, int, int, State&) const {}
    __device__ __forceinline__ void operator()(const f32x4 (&acc)[2][2][4][2], const Unit& u, int wr, int wc, int fr, int fq, const State&) const {
        const int row0 = u.pm * BM + wr * 64 + fr, col0 = u.pn * BM + wc * 32 + 8 * fq;
#pragma unroll
        for (int ai = 0; ai < 2; ++ai)
#pragma unroll
            for (int m = 0; m < 4; ++m) { bf16_t* rowp = O + (size_t)(row0 + ai * HALF + m * 16) * ldc + col0;
#pragma unroll
                for (int bj = 0; bj < 2; ++bj) { const f32x4 v0 = acc[ai][bj][m][0], v1 = acc[ai][bj][m][1];
                    u32x4 w; w.x = cvt_pk_bf16(v0[0], v0[1]); w.y = cvt_pk_bf16(v0[2], v0[3]); w.z = cvt_pk_bf16(v1[0], v1[1]); w.w = cvt_pk_bf16(v1[2], v1[3]);
                    *(u32x4*)(rowp + bj * HALF) = w; } }
    }
};
__device__ __forceinline__ float bflo(unsigned w) { return __builtin_bit_cast(float, w << 16); }
__device__ __forceinline__ float bfhi(unsigned w) { return __builtin_bit_cast(float, w & 0xffff0000u); }
template <bool XF32, bool WRITE_SS> struct EpiResid {
    static constexpr bool PERM = true, AFTER_DRAIN = false; typedef NoState State;
    const float* xf; bf16_t* hb; float* ssq;
    __device__ __forceinline__ void pre(const Unit&, int, int, State&) const {}
    __device__ __forceinline__ void operator()(const f32x4 (&acc)[2][2][4][2], const Unit& u, int wr, int wc, int fr, int fq, const State&) const {
        const int row0 = u.pm * BM + wr * 64 + fr, col0 = u.pn * BM + wc * 32 + 8 * fq;
#pragma unroll
        for (int ai = 0; ai < 2; ++ai) {
            f32x4 b[4][2][2];
            if (XF32) {
#pragma unroll
                for (int m = 0; m < 4; ++m)
#pragma unroll
                    for (int bj = 0; bj < 2; ++bj) { const float* p = xf + (size_t)(row0 + ai * HALF + m * 16) * 1024 + col0 + bj * HALF; b[m][bj][0] = *(const f32x4*)p; b[m][bj][1] = *(const f32x4*)(p + 4); }
            } else {
#pragma unroll
                for (int m = 0; m < 4; ++m)
#pragma unroll
                    for (int bj = 0; bj < 2; ++bj) { const u32x4 w = *(const u32x4*)(hb + (size_t)(row0 + ai * HALF + m * 16) * 1024 + col0 + bj * HALF);
                        b[m][bj][0] = (f32x4){bflo(w.x), bfhi(w.x), bflo(w.y), bfhi(w.y)}; b[m][bj][1] = (f32x4){bflo(w.z), bfhi(w.z), bflo(w.w), bfhi(w.w)}; }
            }
#pragma unroll
            for (int m = 0; m < 4; ++m) { const int row = row0 + ai * HALF + m * 16; float s = 0.f;
#pragma unroll
                for (int bj = 0; bj < 2; ++bj) { const f32x4 v0 = b[m][bj][0] + acc[ai][bj][m][0], v1 = b[m][bj][1] + acc[ai][bj][m][1];
                    u32x4 w; w.x = cvt_pk_bf16(v0[0], v0[1]); w.y = cvt_pk_bf16(v0[2], v0[3]); w.z = cvt_pk_bf16(v1[0], v1[1]); w.w = cvt_pk_bf16(v1[2], v1[3]);
                    *(u32x4*)(hb + (size_t)row * 1024 + col0 + bj * HALF) = w;
                    if (WRITE_SS) s += ((v0[0] * v0[0] + v0[1] * v0[1]) + (v0[2] * v0[2] + v0[3] * v0[3])) + ((v1[0] * v1[0] + v1[1] * v1[1]) + (v1[2] * v1[2] + v1[3] * v1[3])); }
                if (WRITE_SS) { s += __shfl_xor(s, 16); s += __shfl_xor(s, 32); if (fq == 0) atomicAdd(ssq + row, s); } }
            asm volatile("" ::: "memory");
        }
    }
};
__device__ __forceinline__ void rows_pre(const float* ssq, const Unit& u, int wr, int fr, RowState& st) {
    const int row0 = u.pm * BM + wr * 64 + fr;
#pragma unroll
    for (int ai = 0; ai < 2; ++ai)
#pragma unroll
        for (int m = 0; m < 4; ++m) st.ssv[ai][m] = ssq[row0 + ai * HALF + m * 16];
}
struct EpiUp {
    static constexpr bool PERM = true, AFTER_DRAIN = false; typedef RowState State;
    bf16_t* O; const float* ssq;
    __device__ __forceinline__ void pre(const Unit& u, int wr, int fr, State& st) const { rows_pre(ssq, u, wr, fr, st); }
    __device__ __forceinline__ void operator()(const f32x4 (&acc)[2][2][4][2], const Unit& u, int wr, int wc, int fr, int fq, const State& st) const {
        const int row0 = u.pm * BM + wr * 64 + fr, col0 = u.pn * BM + wc * 32 + 8 * fq;
#pragma unroll
        for (int ai = 0; ai < 2; ++ai)
#pragma unroll
            for (int m = 0; m < 4; ++m) { const int row = row0 + ai * HALF + m * 16; const float r = __builtin_amdgcn_rsqf(st.ssv[ai][m] * (1.0f / 1024.0f) + 1e-6f);
                bf16_t* rowp = O + (size_t)row * 4096 + col0;
#pragma unroll
                for (int bj = 0; bj < 2; ++bj) { f32x4 v0 = acc[ai][bj][m][0] * r, v1 = acc[ai][bj][m][1] * r;
#pragma unroll
                    for (int e = 0; e < 4; ++e) { const float a = fmaxf(v0[e], 0.f), b = fmaxf(v1[e], 0.f); v0[e] = a * a; v1[e] = b * b; }
                    u32x4 w; w.x = cvt_pk_bf16(v0[0], v0[1]); w.y = cvt_pk_bf16(v0[2], v0[3]); w.z = cvt_pk_bf16(v1[0], v1[1]); w.w = cvt_pk_bf16(v1[2], v1[3]);
                    *(u32x4*)(rowp + bj * HALF) = w; } }
    }
};
struct EpiCdIn {
    static constexpr bool PERM = true, AFTER_DRAIN = false; typedef RowState State;
    bf16_t* UV; bf16_t* QKV; const float* ssq; float qscale;
    __device__ __forceinline__ void pre(const Unit& u, int wr, int fr, State& st) const { rows_pre(ssq, u, wr, fr, st); }
    __device__ __forceinline__ void operator()(const f32x4 (&acc)[2][2][4][2], const Unit& u, int wr, int wc, int fr, int fq, const State& st) const {
        const int row0 = u.pm * BM + wr * 64 + fr; const bool isuv = u.pn < 4;
        const int colt = isuv ? u.pn * BM : (u.pn - 4) * BM; const int ldc = isuv ? 1024 : 1536; bf16_t* base = isuv ? UV : QKV;
        const float sc = (!isuv && u.pn < 6) ? qscale : 1.0f;
        const int col0 = colt + wc * 32 + 8 * fq;
#pragma unroll
        for (int ai = 0; ai < 2; ++ai)
#pragma unroll
            for (int m = 0; m < 4; ++m) { const int row = row0 + ai * HALF + m * 16; const float r = __builtin_amdgcn_rsqf(st.ssv[ai][m] * (1.0f / 1024.0f) + 1e-6f) * sc;
                bf16_t* rowp = base + (size_t)row * ldc + col0;
#pragma unroll
                for (int bj = 0; bj < 2; ++bj) { f32x4 v0 = acc[ai][bj][m][0] * r, v1 = acc[ai][bj][m][1] * r;
                    if (isuv) { f32x2 a = gelu_pk((f32x2){v0[0], v0[1]}), b = gelu_pk((f32x2){v0[2], v0[3]}), c = gelu_pk((f32x2){v1[0], v1[1]}), d = gelu_pk((f32x2){v1[2], v1[3]});
                        v0 = (f32x4){a.x, a.y, b.x, b.y}; v1 = (f32x4){c.x, c.y, d.x, d.y}; }
                    u32x4 w; w.x = cvt_pk_bf16(v0[0], v0[1]); w.y = cvt_pk_bf16(v0[2], v0[3]); w.z = cvt_pk_bf16(v1[0], v1[1]); w.w = cvt_pk_bf16(v1[2], v1[3]);
                    *(u32x4*)(rowp + bj * HALF) = w; } }
    }
};
template <class Epi, class Sched, bool ALIGN_EPI = false, bool SP2 = false>
__device__ __forceinline__ void gemm_phase(PG8_LAS unsigned char* lds, const Gemm g, const Sched& S, const Epi& E) {
    const int tid = threadIdx.x, wid = __builtin_amdgcn_readfirstlane(tid >> 6), lane = tid & 63, wr = wid >> 2, wc = wid & 3, fr = lane & 15, fq = lane >> 4;
    const int K = g.K, nt = K / BK;
    unsigned voffA[2], voffB[2];
#pragma unroll
    for (int i = 0; i < 2; ++i) { int R, C; stage_rc(tid * 16 + i * 8192, R, C); const int Rb = Epi::PERM ? ((R & ~31) + perm32(R & 31)) : R;
        voffA[i] = (unsigned)(R * K + C) * 2u; voffB[i] = (unsigned)(Rb * K + C) * 2u; }
    const size_t kstep = (size_t)(BK * 2);
    const size_t hstep = (size_t)HALF * K * 2;
    const size_t tstep = 2 * hstep;
    const unsigned ldsw = (unsigned)wid * 1024u;
    const int aoff = lds_byte(wr * 64 + fr, fq * 8), boff = lds_byte(wc * 32 + fr, fq * 8);
#define PG8_SA(b, h) (((b) * 2 + (h)) * HTB)
#define PG8_SB(b, h) ((4 + (b) * 2 + (h)) * HTB)
#define PG8_STAGE(bufoff, gbase, voff) do { _Pragma("unroll") for (int _i = 0; _i < 2; ++_i) \
        __builtin_amdgcn_global_load_lds((const unsigned*)((const char*)(gbase) + (voff)[_i]), (PG8_LAS unsigned*)(lds + (bufoff) + ldsw + _i * 8192), 16, 0, 0); } while (0)
#define PG8_LDA(dst, b, h) do { _Pragma("unroll") for (int m = 0; m < 4; ++m) _Pragma("unroll") for (int k = 0; k < 2; ++k) dst[m][k] = *(const PG8_LAS bf16x8*)(lds + PG8_SA(b, h) + aoff + m * 2048 + k * 1024); } while (0)
#define PG8_LDB(dst, b, h) do { _Pragma("unroll") for (int n = 0; n < 2; ++n) _Pragma("unroll") for (int k = 0; k < 2; ++k) dst[n][k] = *(const PG8_LAS bf16x8*)(lds + PG8_SB(b, h) + boff + n * 2048 + k * 1024); } while (0)
#define PG8_MMA(ai, bj, At, Bt) do { __builtin_amdgcn_s_setprio(1); _Pragma("unroll") for (int m = 0; m < 4; ++m) _Pragma("unroll") for (int n = 0; n < 2; ++n) _Pragma("unroll") for (int k = 0; k < 2; ++k) \
        acc[ai][bj][m][n] = __builtin_amdgcn_mfma_f32_16x16x32_bf16(Bt[n][k], At[m][k], acc[ai][bj][m][n], 0, 0, 0); __builtin_amdgcn_s_setprio(0); } while (0)
#define PG8_WAIT_V(n) asm volatile("s_waitcnt vmcnt(" #n ")" ::: "memory")
#define PG8_WAIT_L(n) asm volatile("s_waitcnt lgkmcnt(" #n ")" ::: "memory")
#define PG8_BAR __builtin_amdgcn_s_barrier()
#define PG8_SCHED __builtin_amdgcn_sched_barrier(0)
    Unit cur, nxt; int ui = 0;
    if (!S.next(0, cur)) return;
    typename Epi::State est;
    f32x4 acc[2][2][4][2];
#pragma unroll
    for (int a = 0; a < 2; ++a)
#pragma unroll
        for (int b = 0; b < 2; ++b)
#pragma unroll
            for (int m = 0; m < 4; ++m)
#pragma unroll
                for (int n = 0; n < 2; ++n) acc[a][b][m][n] = (f32x4){0.f, 0.f, 0.f, 0.f};
    bf16x8 At[4][2], B0[2][2], B1[2][2];
    const char* cA = (const char*)g.A + (size_t)cur.pm * tstep; const char* cB = (const char*)g.Bt + (size_t)cur.pn * tstep;
    S.a_ready(cur);
    if constexpr (SP2) {
        PG8_STAGE(PG8_SB(0, 0), cB, voffB); PG8_STAGE(PG8_SB(0, 1), cB + hstep, voffB); PG8_STAGE(PG8_SA(0, 0), cA, voffA); PG8_STAGE(PG8_SA(0, 1), cA + hstep, voffA);
        if (wr == 1) PG8_BAR;
        PG8_WAIT_V(2); PG8_BAR;
        PG8_STAGE(PG8_SB(1, 0), cB + kstep, voffB); PG8_STAGE(PG8_SA(1, 0), cA + kstep, voffA); PG8_STAGE(PG8_SB(1, 1), cB + hstep + kstep, voffB);
        PG8_WAIT_V(6); PG8_BAR;
    } else {
        PG8_STAGE(PG8_SB(0, 0), cB, voffB); PG8_STAGE(PG8_SA(0, 0), cA, voffA); PG8_STAGE(PG8_SB(0, 1), cB + hstep, voffB); PG8_STAGE(PG8_SA(0, 1), cA + hstep, voffA);
        if (wr == 1) PG8_BAR;
        PG8_WAIT_V(4); PG8_BAR;
        PG8_STAGE(PG8_SB(1, 0), cB + kstep, voffB); PG8_STAGE(PG8_SA(1, 0), cA + kstep, voffA); PG8_STAGE(PG8_SB(1, 1), cB + hstep + kstep, voffB);
        PG8_WAIT_V(6); PG8_BAR;
    }
    for (;;) {
        E.pre(cur, wr, fr, est);
        const bool has_next = S.next(ui + 1, nxt);
        const char* nA = has_next ? (const char*)g.A + (size_t)nxt.pm * tstep : cA; const char* nB = has_next ? (const char*)g.Bt + (size_t)nxt.pn * tstep : cB;
        for (int t = 0; t < nt; t += 2) {
            const bool last = (t == nt - 2);
            const char* a1 = cA + (size_t)(t + 1) * kstep;
            const char* a2 = last ? nA : cA + (size_t)(t + 2) * kstep; const char* b2 = last ? nB : cB + (size_t)(t + 2) * kstep;
            const char* a3 = a2 + kstep; const char* b3 = b2 + kstep;
            if (last && has_next) S.a_ready(nxt);
            if constexpr (SP2) {
            PG8_LDB(B0, 0, 0); PG8_LDB(B1, 0, 1); PG8_SCHED; PG8_LDA(At, 0, 0); PG8_STAGE(PG8_SA(1, 1), a1 + hstep, voffA);
            PG8_WAIT_V(8); PG8_WAIT_L(0); PG8_BAR; PG8_MMA(0, 0, At, B0); PG8_MMA(0, 1, At, B1); PG8_BAR; PG8_SCHED;
            PG8_LDA(At, 0, 1); PG8_STAGE(PG8_SB(0, 0), b2, voffB); PG8_STAGE(PG8_SB(0, 1), b2 + hstep, voffB); PG8_STAGE(PG8_SA(0, 0), a2, voffA);
            PG8_WAIT_V(8); PG8_WAIT_L(0); PG8_BAR; PG8_MMA(1, 0, At, B0); PG8_MMA(1, 1, At, B1); PG8_BAR; PG8_SCHED;
            PG8_LDB(B0, 1, 0); PG8_LDB(B1, 1, 1); PG8_SCHED; PG8_LDA(At, 1, 0); PG8_STAGE(PG8_SA(0, 1), a2 + hstep, voffA);
            PG8_WAIT_V(8); PG8_WAIT_L(0); PG8_BAR; PG8_MMA(0, 0, At, B0); PG8_MMA(0, 1, At, B1); PG8_BAR; PG8_SCHED;
            PG8_LDA(At, 1, 1); PG8_STAGE(PG8_SB(1, 0), b3, voffB); PG8_STAGE(PG8_SB(1, 1), b3 + hstep, voffB); PG8_STAGE(PG8_SA(1, 0), a3, voffA);
            PG8_WAIT_V(8); PG8_WAIT_L(0); PG8_BAR; PG8_MMA(1, 0, At, B0); PG8_MMA(1, 1, At, B1); PG8_BAR; PG8_SCHED;
            } else {
            PG8_LDB(B0, 0, 0); PG8_SCHED; PG8_LDA(At, 0, 0); PG8_STAGE(PG8_SA(1, 1), a1 + hstep, voffA);
            PG8_WAIT_L(8); PG8_BAR; PG8_WAIT_L(0); PG8_MMA(0, 0, At, B0); PG8_BAR; PG8_SCHED;
            PG8_LDB(B1, 0, 1); PG8_STAGE(PG8_SB(0, 0), b2, voffB);
            PG8_BAR; PG8_WAIT_L(0); PG8_MMA(0, 1, At, B1); PG8_BAR;
            PG8_LDA(At, 0, 1); PG8_STAGE(PG8_SA(0, 0), a2, voffA);
            PG8_BAR; PG8_WAIT_L(0); PG8_MMA(1, 0, At, B0); PG8_BAR; PG8_SCHED;
            PG8_STAGE(PG8_SB(0, 1), b2 + hstep, voffB);
            PG8_WAIT_V(6); PG8_BAR; PG8_MMA(1, 1, At, B1); PG8_BAR;
            PG8_LDB(B0, 1, 0); PG8_SCHED; PG8_LDA(At, 1, 0); PG8_STAGE(PG8_SA(0, 1), a2 + hstep, voffA);
            PG8_WAIT_L(8); PG8_BAR; PG8_WAIT_L(0); PG8_MMA(0, 0, At, B0); PG8_BAR; PG8_SCHED;
            PG8_LDB(B1, 1, 1); PG8_STAGE(PG8_SB(1, 0), b3, voffB);
            PG8_BAR; PG8_WAIT_L(0); PG8_MMA(0, 1, At, B1); PG8_BAR;
            PG8_LDA(At, 1, 1); PG8_STAGE(PG8_SA(1, 0), a3, voffA);
            PG8_BAR; PG8_WAIT_L(0); PG8_MMA(1, 0, At, B0); PG8_BAR; PG8_SCHED;
            PG8_STAGE(PG8_SB(1, 1), b3 + hstep, voffB);
            PG8_WAIT_V(6); PG8_BAR; PG8_MMA(1, 1, At, B1); PG8_BAR;
            }
        }
        if constexpr (ALIGN_EPI) { if (wr == 0) PG8_BAR; }
        if constexpr (!Epi::AFTER_DRAIN) { E(acc, cur, wr, wc, fr, fq, est); S.done(cur); }
        if (!has_next) break;
#pragma unroll
        for (int a = 0; a < 2; ++a)
#pragma unroll
            for (int b = 0; b < 2; ++b)
#pragma unroll
                for (int m = 0; m < 4; ++m)
#pragma unroll
                    for (int n = 0; n < 2; ++n) acc[a][b][m][n] = (f32x4){0.f, 0.f, 0.f, 0.f};
        cur = nxt; cA = nA; cB = nB; ++ui;
        if constexpr (ALIGN_EPI) { if (wr == 1) PG8_BAR; }
    }
    PG8_WAIT_V(0);
    if constexpr (!ALIGN_EPI) { if (wr == 0) PG8_BAR; }
    PG8_BAR;
    if constexpr (Epi::AFTER_DRAIN) { E.fused(acc, cur, wr, wc, fr, fq, lds, wid, lane); S.done(cur); }
#undef PG8_SA
#undef PG8_SB
#undef PG8_STAGE
#undef PG8_LDA
#undef PG8_LDB
#undef PG8_MMA
#undef PG8_WAIT_V
#undef PG8_WAIT_L
#undef PG8_BAR
#undef PG8_SCHED
}
}
constexpr int NWAVES = 8;
#ifndef PROBE_REPEAT
#define PROBE_REPEAT -1
#endif
#ifndef MK_N_LAUNCHES
#define MK_N_LAUNCHES 1
#endif
constexpr int N_PHASES = 12;
constexpr int N_LAUNCHES = MK_N_LAUNCHES;
constexpr int BATCH = 16, SEQ = 2048, DM = 1024, M = BATCH * SEQ, FF = 4096, AB_IN = 2048, CD_IN = 2560;
constexpr float EPS = 1e-6f;
constexpr float QSCALE = 0.125f * 1.4426950408889634f;
constexpr size_t MiB = 1u << 20;
constexpr size_t WS_CTL = 0, CTL_ZERO_BYTES = 1 * MiB;
constexpr size_t WS_WABIN = 2 * MiB, WS_WABOUT = 6 * MiB, WS_W1 = 8 * MiB  , WS_W2 = 24 * MiB  , WS_WCDIN = 40 * MiB, WS_WCDOUT = 46 * MiB, WS_WSGU = 48 * MiB;
constexpr size_t WS_TMPF = 50 * MiB;
constexpr size_t WS_SS = 52 * MiB;
constexpr size_t WS_XN = 56 * MiB;
constexpr size_t WS_MIX = 120 * MiB;
constexpr size_t WS_BIG = 184 * MiB;
constexpr size_t WS_QKV = WS_BIG + 64 * MiB;
constexpr size_t WS_END = 440 * MiB;
constexpr int CW_BAR = 4096;
constexpr int RING_OFF = 0, RING_BYTES = 131072;
constexpr int LDSCTL_OFF = RING_BYTES, MISC_OFF = LDSCTL_OFF + 320;
constexpr int LDS_BYTES = 147456;
#define GAS __attribute__((address_space(1)))
#define LAS __attribute__((address_space(3)))
typedef unsigned short bf16;
typedef unsigned v4u __attribute__((ext_vector_type(4)));
typedef float f32x4 __attribute__((ext_vector_type(4)));
typedef short bf16x8 __attribute__((ext_vector_type(8)));
typedef GAS unsigned gu32;
typedef GAS unsigned long long gu64;
#define RLX_AGENT __ATOMIC_RELAXED, __HIP_MEMORY_SCOPE_AGENT
#define LDS_WAIT() asm volatile("s_waitcnt lgkmcnt(0)" ::: "memory")
#define VM_WAIT() asm volatile("s_waitcnt vmcnt(0)" ::: "memory")
__device__ __forceinline__ unsigned long long rt() { return __builtin_amdgcn_s_memrealtime(); }
__device__ __forceinline__ unsigned f2bf(float f) { unsigned u = __builtin_bit_cast(unsigned, f); return (u + 0x7fffu + ((u >> 16) & 1u)) >> 16; }
__device__ __forceinline__ unsigned pk2(float lo, float hi) { return f2bf(lo) | (f2bf(hi) << 16); }
#define XB_TMO      128
#define XB_XCNT(j)  (256  + 64 * (j))
#define XB_XSUB(j)  (1280 + 64 * (j))
#define XB_XGEN(j)  (2304 + 64 * (j))
#define XB_TOP      3328
#define XB_TOPGEN   3392
#define XCD_BAR_WORDS 3456
#define XB_SPIN_CAP (1u << 18)

__device__ __forceinline__ unsigned xb_ld(unsigned* p)              { return __hip_atomic_load(p, __ATOMIC_RELAXED, __HIP_MEMORY_SCOPE_AGENT); }
__device__ __forceinline__ unsigned xb_add(unsigned* p, unsigned v) { return __hip_atomic_fetch_add(p, v, __ATOMIC_RELAXED, __HIP_MEMORY_SCOPE_AGENT); }
__device__ __forceinline__ unsigned xb_xcc_id() { return (unsigned)__builtin_amdgcn_s_getreg((3 << 11) | 20) & 0xFu; }
#define XB_SPIN(cond, bar) do { unsigned _sp = 0; while (cond) { __builtin_amdgcn_s_sleep(1); \
    if ((++_sp & 255u) == 0u) { if (xb_ld(&(bar)[XB_TMO])) break; if (_sp > XB_SPIN_CAP) { atomicAdd(&(bar)[XB_TMO], 1u); break; } } } } while (0)

struct XcdBarrier {
    unsigned* bar; unsigned x;
    volatile LAS unsigned* st;
};

__device__ __forceinline__ XcdBarrier xcd_barrier_post(unsigned* bar, volatile LAS unsigned* st) {
    XcdBarrier b; b.bar = bar; b.x = xb_xcc_id(); b.st = st;
    if (threadIdx.x == 0) (void)xb_add(&bar[XB_XCNT(b.x)], 1u);
    return b;
}
__device__ __forceinline__ void xcd_barrier_complete(unsigned* bar, unsigned x, unsigned& nloc, unsigned& nx) {
    const unsigned G = gridDim.x * gridDim.y * gridDim.z;
    unsigned sum, cnt, mine, sp = 0u;
    for (;;) {
        sum = 0u; cnt = 0u; mine = 0u;
#pragma unroll
        for (unsigned j = 0; j < 16; ++j) { const unsigned c = xb_ld(&bar[XB_XCNT(j)]); sum += c; cnt += (c > 0u) ? 1u : 0u; mine = (j == x) ? c : mine; }
        if (sum == G) break;
        __builtin_amdgcn_s_sleep(1);
        if ((++sp & 255u) == 0u) { if (xb_ld(&bar[XB_TMO])) break; if (sp > XB_SPIN_CAP) { atomicAdd(&bar[XB_TMO], 1u); break; } }
    }
    nloc = mine > 0u ? mine : 1u; nx = cnt > 0u ? cnt : 1u;
}

__device__ __forceinline__ void xcd_barrier(const XcdBarrier& b) {
    asm volatile("s_waitcnt vmcnt(0)" ::: "memory");
    __syncthreads();
    if (threadIdx.x == 0) {
        unsigned* bar = b.bar;
        __builtin_amdgcn_s_waitcnt(0);
        unsigned nloc = b.st[0], nx = b.st[1];
        if (nloc == 0u) { xcd_barrier_complete(bar, b.x, nloc, nx); b.st[0] = nloc; b.st[1] = nx; }
        const unsigned old = xb_add(&bar[XB_XSUB(b.x)], 1u);
        const unsigned gen = old / nloc;
        if (old + 1u == (gen + 1u) * nloc) {
            __builtin_amdgcn_fence(__ATOMIC_RELEASE, "agent");
            asm volatile("s_waitcnt vmcnt(0)" ::: "memory");
            const unsigned og = xb_add(&bar[XB_TOP], 1u);
            const unsigned tg = og / nx;
            if (og + 1u == (tg + 1u) * nx) xb_add(&bar[XB_TOPGEN], 1u);
            else XB_SPIN(xb_ld(&bar[XB_TOPGEN]) == tg, bar);
            __builtin_amdgcn_fence(__ATOMIC_ACQUIRE, "agent");
            xb_add(&bar[XB_XGEN(b.x)], 1u);
            asm volatile("s_waitcnt vmcnt(0)" ::: "memory");
        } else {
            XB_SPIN(xb_ld(&bar[XB_XGEN(b.x)]) == gen, bar);
            __builtin_amdgcn_fence(__ATOMIC_ACQUIRE, "agent");
            asm volatile("s_waitcnt vmcnt(0)" ::: "memory");
        }
    }
    __syncthreads();
}
struct Frame {
    LAS unsigned char* lds;
    volatile LAS unsigned* MISC;
    gu32* ctl;
    int tid, lane, wave;
    int vcu, G;
    const float* in[18]; float* out; unsigned char* ws;
};
__device__ __forceinline__ float bf2f(unsigned short b) { return __builtin_bit_cast(float, (unsigned)b << 16); }
__device__ __forceinline__ float wave_sum(float v) {
#pragma unroll
    for (int o = 1; o < 64; o <<= 1) v += __shfl_xor(v, o);
    return v;
}
__device__ __forceinline__ void unpack8(const v4u r, float* f) {
    f[0] = __builtin_bit_cast(float, r.x << 16); f[1] = __builtin_bit_cast(float, r.x & 0xffff0000u);
    f[2] = __builtin_bit_cast(float, r.y << 16); f[3] = __builtin_bit_cast(float, r.y & 0xffff0000u);
    f[4] = __builtin_bit_cast(float, r.z << 16); f[5] = __builtin_bit_cast(float, r.z & 0xffff0000u);
    f[6] = __builtin_bit_cast(float, r.w << 16); f[7] = __builtin_bit_cast(float, r.w & 0xffff0000u);
}
__device__ __forceinline__ v4u pack8(const float* f) { v4u o; o.x = pk2(f[0], f[1]); o.y = pk2(f[2], f[3]); o.z = pk2(f[4], f[5]); o.w = pk2(f[6], f[7]); return o; }

__device__ __forceinline__ void transpose_item(const float* W, const float* gk, int K, int N, bf16* WT, LAS float* scr, int item, int lane) {
    const int nblk = N / 32, kb = item / nblk, nb = item % nblk, k0 = 64 * kb, n0 = 32 * nb;
    float v[32]; const float* src = W + (size_t)(k0 + (lane >> 5)) * N + n0 + (lane & 31);
#pragma unroll
    for (int i = 0; i < 32; ++i) v[i] = src[(size_t)(2 * i) * N];
    if (gk) {
#pragma unroll
        for (int i = 0; i < 32; ++i) v[i] *= gk[k0 + 2 * i + (lane >> 5)]; }
#pragma unroll
    for (int i = 0; i < 32; ++i) scr[(2 * i + (lane >> 5)) * 33 + (lane & 31)] = v[i];
    LDS_WAIT(); asm volatile("" ::: "memory");
    const int c = lane & 7;
#pragma unroll
    for (int j = 0; j < 4; ++j) { const int n = (lane >> 3) + 8 * j; const LAS float* s = scr + (8 * c) * 33 + n;
        v4u o; o.x = pk2(s[0 * 33], s[1 * 33]); o.y = pk2(s[2 * 33], s[3 * 33]); o.z = pk2(s[4 * 33], s[5 * 33]); o.w = pk2(s[6 * 33], s[7 * 33]);
        *(GAS v4u*)(WT + (size_t)(n0 + n) * K + k0 + 8 * c) = o; }
    LDS_WAIT(); asm volatile("" ::: "memory");
}

__device__ __forceinline__ void p0_prologue(Frame& F) {
    LAS float* scr = (LAS float*)(F.lds + RING_OFF + F.wave * 16384);
    const int gw = F.vcu * NWAVES + F.wave, NGW = F.G * NWAVES;
    const float* mixg = F.in[1]; const float* mlpg = F.in[2];
    { const float* x = F.in[0]; bf16* xn = (bf16*)(F.ws + WS_XN); const GAS f32x4* gr = (const GAS f32x4*)mixg + F.lane;
      f32x4 g[4];
#pragma unroll
      for (int j = 0; j < 4; ++j) g[j] = gr[64 * j];
      for (int m0 = gw * 4; m0 < M; m0 += NGW * 4) { f32x4 v[4][4];
#pragma unroll
          for (int i = 0; i < 4; ++i) { const GAS f32x4* xr = (const GAS f32x4*)(x + (size_t)(m0 + i) * DM) + F.lane;
#pragma unroll
              for (int j = 0; j < 4; ++j) v[i][j] = xr[64 * j]; }
#pragma unroll
          for (int i = 0; i < 4; ++i) { float s = 0.f;
#pragma unroll
              for (int j = 0; j < 4; ++j) s += (v[i][j].x * v[i][j].x + v[i][j].y * v[i][j].y) + (v[i][j].z * v[i][j].z + v[i][j].w * v[i][j].w);
              const float rstd = 1.0f / sqrtf(wave_sum(s) * (1.f / DM) + EPS);
              GAS unsigned long long* o8 = (GAS unsigned long long*)(xn + (size_t)(m0 + i) * DM) + F.lane;
#pragma unroll
              for (int j = 0; j < 4; ++j) o8[64 * j] = (unsigned long long)pk2(v[i][j].x * rstd * g[j].x, v[i][j].y * rstd * g[j].y) | ((unsigned long long)pk2(v[i][j].z * rstd * g[j].z, v[i][j].w * rstd * g[j].w) << 32); } } }
    constexpr int I_ABIN = (DM / 64) * (AB_IN / 32), I_W1 = (DM / 64) * (FF / 32), I_W2 = (FF / 64) * (DM / 32), I_CDIN = (DM / 64) * (CD_IN / 32), I_CDOUT = (DM / 64) * (DM / 32);
    constexpr int NITEMS = I_ABIN + 2 * I_W1 + 2 * I_W2 + I_CDIN + I_CDOUT;
    for (int it = gw; it < NITEMS; it += NGW) {
        int r = it;
        if (r < I_ABIN) { transpose_item(F.in[3], nullptr, DM, AB_IN, (bf16*)(F.ws + WS_WABIN), scr, r, F.lane); continue; } r -= I_ABIN;
        if (r < I_W1) { transpose_item(F.in[15], mlpg, DM, FF, (bf16*)(F.ws + WS_W1), scr, r, F.lane); continue; } r -= I_W1;
        if (r < I_W1) { transpose_item(F.in[15] + (size_t)DM * FF, mlpg + DM, DM, FF, (bf16*)(F.ws + WS_W1 + 8 * MiB), scr, r, F.lane); continue; } r -= I_W1;
        if (r < I_W2) { transpose_item(F.in[16], nullptr, FF, DM, (bf16*)(F.ws + WS_W2), scr, r, F.lane); continue; } r -= I_W2;
        if (r < I_W2) { transpose_item(F.in[16] + (size_t)FF * DM, nullptr, FF, DM, (bf16*)(F.ws + WS_W2 + 8 * MiB), scr, r, F.lane); continue; } r -= I_W2;
        if (r < I_CDIN) { transpose_item(F.in[9], mixg + DM, DM, CD_IN, (bf16*)(F.ws + WS_WCDIN), scr, r, F.lane); continue; } r -= I_CDIN;
        transpose_item(F.in[14], nullptr, DM, DM, (bf16*)(F.ws + WS_WCDOUT), scr, r, F.lane);
    }
    { const float* pw = F.in[4]; const float* psc = F.in[5]; const float* wo = F.in[8]; float* tmp = (float*)(F.ws + WS_TMPF);
      for (int it = gw; it < 128 * 16; it += NGW) { const int k0 = (it >> 4) * 4, n = (it & 15) * 64 + F.lane, g = k0 >> 7;
          const float* pwr = pw + (size_t)k0 * 128; const float* scr_ = psc + g * 128; const float* wor = wo + (size_t)(g * 128) * DM + n; float a[4] = {0.f, 0.f, 0.f, 0.f};
#pragma unroll 16
          for (int d = 0; d < 128; ++d) { const float wv = wor[(size_t)d * DM] * scr_[d];
#pragma unroll
              for (int j = 0; j < 4; ++j) a[j] += pwr[j * 128 + d] * wv; }
#pragma unroll
          for (int j = 0; j < 4; ++j) tmp[(size_t)(k0 + j) * DM + n] = a[j]; } }
    { float* z = (float*)(F.ws + WS_SS); for (int i = gw * 64 + F.lane; i < 3 * M; i += NGW * 64) z[i] = 0.f; }
    { const float* sw = F.in[12]; bf16* wc = (bf16*)(F.ws + WS_WSGU);
      for (int it = gw * 64 + F.lane; it < 4 * 128 * 16; it += NGW * 64) { const int tt = (it >> 4) & 127, s0 = (it & 15) * 8; float f[8];
#pragma unroll
          for (int e = 0; e < 8; ++e) f[e] = (s0 + e <= tt) ? sw[(size_t)it * 8 + e] : 0.f;
          *(GAS v4u*)(wc + (size_t)it * 8) = pack8(f); } }
}

template <int W> __device__ __forceinline__ void pool_task(const bf16* P, bf16* MX, size_t rb, int t0, int c0) {
    v4u r[W + 7];
#pragma unroll
    for (int j = 0; j < W + 7; ++j) { const int t = t0 - (W - 1) + j; r[j] = (t >= 0) ? *(const GAS v4u*)(P + (rb + t) * AB_IN + c0) : (v4u){0u, 0u, 0u, 0u}; }
    float sum[8], a[8];
#pragma unroll
    for (int e = 0; e < 8; ++e) sum[e] = 0.f;
#pragma unroll
    for (int j = 0; j < W - 1; ++j) { unpack8(r[j], a);
#pragma unroll
        for (int e = 0; e < 8; ++e) sum[e] += a[e]; }
#pragma unroll
    for (int i = 0; i < 8; ++i) { const int t = t0 + i; unpack8(r[W - 1 + i], a);
        const float inv = __builtin_amdgcn_rcpf((float)(t + 1 < W ? t + 1 : W)); float o[8];
#pragma unroll
        for (int e = 0; e < 8; ++e) { sum[e] += a[e]; o[e] = sum[e] * inv - a[e]; }
        *(GAS v4u*)(MX + (rb + t) * DM + c0) = pack8(o);
        unpack8(r[i], a);
#pragma unroll
        for (int e = 0; e < 8; ++e) sum[e] -= a[e]; }
}
__device__ __forceinline__ void p2_mixer_ab(Frame& F) {
    { LAS float* scr = (LAS float*)(F.lds + RING_OFF + F.wave * 16384); const int gw = F.vcu * NWAVES + F.wave, NGW = F.G * NWAVES;
      bf16* wt = (bf16*)(F.ws + WS_WABOUT);
      for (int it = gw; it < (DM / 64) * (DM / 32); it += NGW) {
          const int kb = it / (DM / 32);
          transpose_item(kb < 8 ? (const float*)(F.ws + WS_TMPF) : F.in[8], nullptr, DM, DM, wt, scr, it, F.lane); } }
    const bf16* P = (const bf16*)(F.ws + WS_BIG); bf16* MX = (bf16*)(F.ws + WS_MIX);
    const float* cw = F.in[6]; const float* cb = F.in[7];
    const int w = F.wave, lane = F.lane;
    for (int u = F.vcu; u < BATCH * 32; u += F.G) {
        const int b = u >> 5, seg = u & 31; const size_t rb = (size_t)b * SEQ;
        { const int g = w >> 1, c0 = g * 128 + (lane & 15) * 8, t0 = seg * 64 + ((w & 1) * 4 + (lane >> 4)) * 8;
          if (g == 0) pool_task<2>(P, MX, rb, t0, c0); else if (g == 1) pool_task<4>(P, MX, rb, t0, c0); else if (g == 2) pool_task<8>(P, MX, rb, t0, c0); else pool_task<16>(P, MX, rb, t0, c0); }
        const int cc = lane * 8; float w0[8], w1[8], w2[8], bb[8];
#pragma unroll
        for (int e = 0; e < 8; ++e) { w0[e] = cw[cc + e]; w1[e] = cw[512 + cc + e]; w2[e] = cw[1024 + cc + e]; bb[e] = cb[cc + e]; }
#pragma unroll
        for (int j = 0; j < 2; ++j) {
            const int t0 = seg * 64 + (w * 2 + j) * 4; v4u rx[6], rc[6], rg[4];
#pragma unroll
            for (int i = 0; i < 6; ++i) { const int t = t0 - 2 + i; const bool ok = t >= 0; const bf16* pr = P + (rb + (ok ? t : 0)) * AB_IN;
                rx[i] = ok ? *(const GAS v4u*)(pr + 512 + cc) : (v4u){0u, 0u, 0u, 0u}; rc[i] = ok ? *(const GAS v4u*)(pr + 1536 + cc) : (v4u){0u, 0u, 0u, 0u}; }
#pragma unroll
            for (int i = 0; i < 4; ++i) rg[i] = *(const GAS v4u*)(P + (rb + t0 + i) * AB_IN + 1024 + cc);
            float gx[6][8];
#pragma unroll
            for (int i = 0; i < 6; ++i) { float xb[8], gc[8]; unpack8(rx[i], xb); unpack8(rc[i], gc);
#pragma unroll
                for (int e = 0; e < 8; ++e) gx[i][e] = gc[e] * xb[e]; }
#pragma unroll
            for (int i = 0; i < 4; ++i) { float gb[8], o[8]; unpack8(rg[i], gb);
#pragma unroll
                for (int e = 0; e < 8; ++e) o[e] = gb[e] * (w0[e] * gx[i][e] + w1[e] * gx[i + 1][e] + w2[e] * gx[i + 2][e] + bb[e]);
                *(GAS v4u*)(MX + (rb + t0 + i) * DM + 512 + cc) = pack8(o); }
        }
    }
}
namespace sba {
using bf16x8 = __attribute__((ext_vector_type(8))) short;
using f16x8 = __attribute__((ext_vector_type(8))) _Float16;
using s16x4 = __attribute__((ext_vector_type(4))) short;
using f32x16 = __attribute__((ext_vector_type(16))) float;
using u32x4 = __attribute__((ext_vector_type(4))) unsigned;
typedef short v4i16_t __attribute__((ext_vector_type(4)));
typedef float f32x2_t __attribute__((ext_vector_type(2))); typedef __bf16 bf16x2_t __attribute__((ext_vector_type(2))); typedef _Float16 f16x2_t __attribute__((ext_vector_type(2)));
typedef __attribute__((address_space(3))) const char* lds_cptr;
typedef __attribute__((address_space(3))) char* lds_ptr;
__device__ __forceinline__ unsigned pk_bf16(float lo, float hi) { f32x2_t v = {lo, hi}; bf16x2_t b = __builtin_convertvector(v, bf16x2_t); return __builtin_bit_cast(unsigned, b); }
__device__ __forceinline__ unsigned pk_f16(float lo, float hi) { f32x2_t v = {lo, hi}; f16x2_t b = __builtin_convertvector(v, f16x2_t); return __builtin_bit_cast(unsigned, b); }
__device__ __forceinline__ s16x4 vtr(lds_cptr p) { return __builtin_bit_cast(s16x4, __builtin_amdgcn_ds_read_tr16_b64_v4i16((__attribute__((address_space(3))) v4i16_t*)p)); }
#define SB_MFMA_BF16(a, b, c) __builtin_amdgcn_mfma_f32_32x32x16_bf16((a), (b), (c), 0, 0, 0)
#define SB_MFMA_F16(a, b, c) __builtin_amdgcn_mfma_f32_32x32x16_f16((a), (b), (c), 0, 0, 0)
constexpr int KV = 64, SLOT = 16384;

template <bool DIAG>
__device__ __forceinline__ void tile(lds_cptr Kb, lds_cptr Vb, const bf16x8 (&qf)[4], f32x16& o0, f32x16& o1, f32x16& carry,
                                     const f16x8 T0, const f16x8 T1, const f16x8 ONES, int r, int hi, int lane, int limA) {
    f32x16 p0, p1;
#pragma unroll
    for (int i = 0; i < 16; ++i) { p0[i] = 0.f; p1[i] = 0.f; }
    const lds_cptr kp = Kb + hi * 1024 + r * 16;
#pragma unroll
    for (int d0 = 0; d0 < 4; ++d0) {
        const bf16x8 a0 = *(const __attribute__((address_space(3))) bf16x8*)(kp + d0 * 2048);
        const bf16x8 a1 = *(const __attribute__((address_space(3))) bf16x8*)(kp + d0 * 2048 + 512);
        p0 = SB_MFMA_BF16(a0, qf[d0], p0); p1 = SB_MFMA_BF16(a1, qf[d0], p1); }
    unsigned l0p[8], l1p[8];
#pragma unroll
    for (int i = 0; i < 16; i += 2) {
        float n0[2], n1[2];
#pragma unroll
        for (int e = 0; e < 2; ++e) { const int ci = ((i + e) & 3) + 8 * ((i + e) >> 2);
            { const float S = p0[i + e]; const float ex = __builtin_amdgcn_exp2f(-__builtin_fabsf(S)), l = __builtin_amdgcn_logf(1.0f + ex); float nsp = __builtin_fminf(-S, 0.f) - l;
              if (DIAG) nsp = (ci < limA) ? nsp : 0.f; n0[e] = nsp; p0[i + e] = S + nsp; }
            { const float S = p1[i + e]; const float ex = __builtin_amdgcn_exp2f(-__builtin_fabsf(S)), l = __builtin_amdgcn_logf(1.0f + ex); float nsp = __builtin_fminf(-S, 0.f) - l;
              if (DIAG) nsp = (ci + 32 < limA) ? nsp : 0.f; n1[e] = nsp; p1[i + e] = S + nsp; } }
        l0p[i >> 1] = pk_f16(n0[0], n0[1]); l1p[i >> 1] = pk_f16(n1[0], n1[1]); }
    const f16x8 l0a = __builtin_bit_cast(f16x8, (u32x4){l0p[0], l0p[1], l0p[2], l0p[3]}), l0b = __builtin_bit_cast(f16x8, (u32x4){l0p[4], l0p[5], l0p[6], l0p[7]});
    const f16x8 l1a = __builtin_bit_cast(f16x8, (u32x4){l1p[0], l1p[1], l1p[2], l1p[3]}), l1b = __builtin_bit_cast(f16x8, (u32x4){l1p[4], l1p[5], l1p[6], l1p[7]});
    f32x16 u1 = SB_MFMA_F16(ONES, l1a, carry); u1 = SB_MFMA_F16(ONES, l1b, u1);
    f32x16 y0 = SB_MFMA_F16(T0, l0a, u1); y0 = SB_MFMA_F16(T1, l0b, y0);
    f32x16 y1 = SB_MFMA_F16(T0, l1a, carry); y1 = SB_MFMA_F16(T1, l1b, y1);
    carry = SB_MFMA_F16(ONES, l0a, u1); carry = SB_MFMA_F16(ONES, l0b, carry);
    unsigned w0p[8], w1p[8];
#pragma unroll
    for (int i = 0; i < 16; i += 2) {
        float a[2], b[2];
#pragma unroll
        for (int e = 0; e < 2; ++e) { const int ci = ((i + e) & 3) + 8 * ((i + e) >> 2);
            a[e] = __builtin_amdgcn_exp2f(p0[i + e] + y0[i + e]); b[e] = __builtin_amdgcn_exp2f(p1[i + e] + y1[i + e]);
            if (DIAG) { a[e] = (ci < limA) ? a[e] : 0.f; b[e] = (ci + 32 < limA) ? b[e] : 0.f; } }
        w0p[i >> 1] = pk_bf16(a[0], a[1]); w1p[i >> 1] = pk_bf16(b[0], b[1]); }
    const bf16x8 pa0 = __builtin_bit_cast(bf16x8, (u32x4){w0p[0], w0p[1], w0p[2], w0p[3]}), pa1 = __builtin_bit_cast(bf16x8, (u32x4){w0p[4], w0p[5], w0p[6], w0p[7]});
    const bf16x8 pa2 = __builtin_bit_cast(bf16x8, (u32x4){w1p[0], w1p[1], w1p[2], w1p[3]}), pa3 = __builtin_bit_cast(bf16x8, (u32x4){w1p[4], w1p[5], w1p[6], w1p[7]});
    const lds_cptr vp = Vb + ((lane >> 4) & 1) * 32 + (lane & 3) * 8 + (4 * hi + ((lane & 15) >> 2)) * 64;
#pragma unroll
    for (int d0 = 0; d0 < 2; ++d0) {
        s16x4 lo[4], hh[4];
#pragma unroll
        for (int ks = 0; ks < 4; ++ks) { lo[ks] = vtr(vp + d0 * 4096 + ks * 1024); hh[ks] = vtr(vp + d0 * 4096 + ks * 1024 + 512); }
#define SB_PK(k) (bf16x8){lo[k][0], lo[k][1], lo[k][2], lo[k][3], hh[k][0], hh[k][1], hh[k][2], hh[k][3]}
        f32x16 o = d0 == 0 ? o0 : o1;
        o = SB_MFMA_BF16(pa0, SB_PK(0), o); o = SB_MFMA_BF16(pa1, SB_PK(1), o); o = SB_MFMA_BF16(pa2, SB_PK(2), o); o = SB_MFMA_BF16(pa3, SB_PK(3), o);
        if (d0 == 0) o0 = o; else o1 = o;
#undef SB_PK
    }
}
}

__device__ __forceinline__ void p7_attention_mfma(Frame& F) {
    using namespace sba;
    const bf16* QKV = (const bf16*)(F.ws + WS_QKV); bf16* MX = (bf16*)(F.ws + WS_MIX);
    const lds_ptr L = (lds_ptr)(F.lds + RING_OFF);
    volatile LAS unsigned* dflag = (volatile LAS unsigned*)(F.lds + RING_OFF + 2 * sba::SLOT);
    const int lane = F.lane, r = lane & 31, hi = lane >> 5, w = F.wave;
    unsigned t0w[4], t1w[4];
#pragma unroll
    for (int jj = 0; jj < 4; ++jj) { const int j = 2 * jj; const int k0 = 8 * (j >> 2) + 4 * hi + (j & 3), k1 = k0 + 1;
        t0w[jj] = (k0 > r ? 0x3C00u : 0u) | (k1 > r ? 0x3C000000u : 0u); t1w[jj] = (k0 + 16 > r ? 0x3C00u : 0u) | (k1 + 16 > r ? 0x3C000000u : 0u); }
    const f16x8 T0 = __builtin_bit_cast(f16x8, (u32x4){t0w[0], t0w[1], t0w[2], t0w[3]}), T1 = __builtin_bit_cast(f16x8, (u32x4){t1w[0], t1w[1], t1w[2], t1w[3]});
    const f16x8 ONES = __builtin_bit_cast(f16x8, (u32x4){0x3C003C00u, 0x3C003C00u, 0x3C003C00u, 0x3C003C00u});
    const int limA = 32 * (w & 1) + r - 4 * hi;
    const int skv = F.tid & 63, sch = F.tid >> 6;
    const int kdst = sch * 1024 + skv * 16, vdst = 8192 + (sch >> 2) * 4096 + skv * 64 + (sch & 3) * 16;
    for (int u = F.vcu; u < 1024; u += F.G) {
        const int bh = (u & 255) >> 1, ii = (u >> 8) & 3, odd = u & 1;
        const int qb = odd ? (ii == 0 ? 1 : ii == 1 ? 6 : ii == 2 ? 2 : 5) : (ii == 0 ? 0 : ii == 1 ? 7 : ii == 2 ? 3 : 4);
        const int b = bh >> 3, h = bh & 7; const size_t rb = (size_t)b * SEQ;
        const bf16* kbase = QKV + rb * 1536 + 512 + h * 64 + sch * 8;
        bf16x8 qf[4];
        { const bf16* qp = QKV + (rb + 256 * qb + 32 * w + r) * 1536 + h * 64 + hi * 8;
#pragma unroll
          for (int d0 = 0; d0 < 4; ++d0) qf[d0] = *(const bf16x8*)(qp + d0 * 16); }
        f32x16 o0, o1, carry;
#pragma unroll
        for (int i = 0; i < 16; ++i) { o0[i] = 0.f; o1[i] = 0.f; carry[i] = 0.f; }
        const int ttd = 4 * qb + (w >> 1), ntile = 4 * qb + 4;
        __syncthreads();
        { const bf16* kp = kbase + (size_t)((ntile - 1) * KV + skv) * 1536; const v4u kr = *(const GAS v4u*)kp, vr = *(const GAS v4u*)(kp + 512);
          *(__attribute__((address_space(3))) v4u*)(L + kdst) = kr; *(__attribute__((address_space(3))) v4u*)(L + vdst) = vr; }
        __syncthreads();
        int cur = 0; bool wdone = false;
        for (int tt = ntile - 1; tt >= 0; --tt) {
            v4u kr, vr;
            if (tt > 0) { const bf16* kp = kbase + (size_t)((tt - 1) * KV + skv) * 1536; kr = *(const GAS v4u*)kp; vr = *(const GAS v4u*)(kp + 512); }
            const lds_cptr Kb = (lds_cptr)(L + cur * SLOT), Vb = Kb + 8192;
            if (!wdone) {
                if (tt < ttd) { tile<false>(Kb, Vb, qf, o0, o1, carry, T0, T1, ONES, r, hi, lane, limA); wdone = __all(carry[0] < -150.0f) != 0; }
                else if (tt == ttd) { tile<true>(Kb, Vb, qf, o0, o1, carry, T0, T1, ONES, r, hi, lane, limA); wdone = __all(carry[0] < -150.0f) != 0; }
            }
            if (tt > 0) { *(__attribute__((address_space(3))) v4u*)(L + (cur ^ 1) * SLOT + kdst) = kr; *(__attribute__((address_space(3))) v4u*)(L + (cur ^ 1) * SLOT + vdst) = vr; }
            if (lane == 0) dflag[(tt & 1) * 8 + w] = wdone ? 1u : 0u;
            __syncthreads();
            { const unsigned f = dflag[(tt & 1) * 8 + (lane & 7)]; if (__all(f != 0u)) break; }
            cur ^= 1;
        }
        { bf16* op = MX + (rb + 256 * qb + 32 * w) * DM + 512 + h * 64 + r;
#pragma unroll
          for (int i = 0; i < 16; ++i) { const int q = (i & 3) + 8 * (i >> 2) + 4 * hi;
              op[(size_t)q * DM] = (bf16)f2bf(o0[i]); op[(size_t)q * DM + 32] = (bf16)f2bf(o1[i]); } }
    }
    __syncthreads();
}

__device__ __forceinline__ void p7_attention(Frame& F) {
    typedef float f4 __attribute__((ext_vector_type(4)));
    LAS f4* Ks = (LAS f4*)(F.lds + RING_OFF); LAS f4* Vs = Ks + 1024;
    const bf16* QKV = (const bf16*)(F.ws + WS_QKV); bf16* MX = (bf16*)(F.ws + WS_MIX);
    for (int u = F.vcu; u < 512; u += F.G) {
        const int bh = (u & 255) >> 1, q01 = u & 1, qq = (u >> 8) ? 3 - q01 : q01, b = bh >> 3, h = bh & 7;
        const int t = 512 * qq + F.tid; const size_t rb = (size_t)b * SEQ;
        float q[64], o[64];
        { const bf16* qp = QKV + (rb + t) * 1536 + h * 64;
#pragma unroll
          for (int c = 0; c < 8; ++c) unpack8(*(const GAS v4u*)(qp + c * 8), q + c * 8); }
#pragma unroll
        for (int d = 0; d < 64; ++d) o[d] = 0.f;
        float carry = 0.f;
        const int wave_tmax = 512 * qq + 64 * F.wave + 63;
        for (int tt = 8 * qq + 7; tt >= 0; --tt) {
            __syncthreads();
            { const int kk = F.tid >> 3, c8 = F.tid & 7; const bf16* kp = QKV + (rb + tt * 64 + kk) * 1536 + 512 + h * 64 + c8 * 8; float f[8];
              unpack8(*(const GAS v4u*)kp, f); Ks[kk * 16 + c8 * 2] = (f4){f[0], f[1], f[2], f[3]}; Ks[kk * 16 + c8 * 2 + 1] = (f4){f[4], f[5], f[6], f[7]};
              unpack8(*(const GAS v4u*)(kp + 512), f); Vs[kk * 16 + c8 * 2] = (f4){f[0], f[1], f[2], f[3]}; Vs[kk * 16 + c8 * 2 + 1] = (f4){f[4], f[5], f[6], f[7]}; }
            __syncthreads();
            if (tt * 64 < wave_tmax) {
                for (int s = 63; s >= 0; --s) {
                    float d0 = 0.f, d1 = 0.f;
#pragma unroll
                    for (int c = 0; c < 16; c += 2) { const f4 k0 = Ks[s * 16 + c], k1 = Ks[s * 16 + c + 1];
                        d0 += q[4 * c] * k0.x + q[4 * c + 1] * k0.y + q[4 * c + 2] * k0.z + q[4 * c + 3] * k0.w;
                        d1 += q[4 * c + 4] * k1.x + q[4 * c + 5] * k1.y + q[4 * c + 6] * k1.z + q[4 * c + 7] * k1.w; }
                    const float S = d0 + d1; const bool valid = (tt * 64 + s) < t;
                    const float e = __builtin_amdgcn_exp2f(-fabsf(S)), l = __builtin_amdgcn_logf(1.0f + e), nsp = fminf(-S, 0.f) - l, lb = S + nsp;
                    const float w = valid ? __builtin_amdgcn_exp2f(lb + carry) : 0.f; carry += valid ? nsp : 0.f;
#pragma unroll
                    for (int c = 0; c < 16; ++c) { const f4 v = Vs[s * 16 + c]; o[4 * c] += w * v.x; o[4 * c + 1] += w * v.y; o[4 * c + 2] += w * v.z; o[4 * c + 3] += w * v.w; }
                }
            }
        }
        { bf16* op = MX + (rb + t) * DM + 512 + h * 64;
#pragma unroll
          for (int c = 0; c < 8; ++c) *(GAS v4u*)(op + c * 8) = pack8(o + c * 8); }
    }
    __syncthreads();
}
__device__ __forceinline__ void p7_sgu_mfma(Frame& F) {
    typedef __attribute__((address_space(3))) unsigned short lds_u16;
    constexpr int PITCH = 136;
    LAS float* st = (LAS float*)(F.lds + RING_OFF); LAS unsigned char* VT = F.lds + RING_OFF + 1024;
    const bf16* UV = (const bf16*)(F.ws + WS_BIG); bf16* MX = (bf16*)(F.ws + WS_MIX); const bf16* WC = (const bf16*)(F.ws + WS_WSGU);
    const float* gam = F.in[10]; const float* bet = F.in[11]; const float* sb = F.in[13];
    const int lane = F.lane, w = F.wave, fr = lane & 15, fq = lane >> 4;
    for (int u = F.vcu; u < 256; u += F.G) {
        const size_t row0 = (size_t)(u >> 4) * SEQ + (size_t)(u & 15) * 128;
        __syncthreads();
        for (int i = 0; i < 16; ++i) { const int s = 16 * w + i; float f[8]; unpack8(*(const GAS v4u*)(UV + (row0 + s) * 1024 + 512 + lane * 8), f);
            float a = 0.f;
#pragma unroll
            for (int e = 0; e < 8; ++e) a += f[e];
            const float mean = wave_sum(a) * (1.0f / 512.0f); float qv = 0.f;
#pragma unroll
            for (int e = 0; e < 8; ++e) { const float d = f[e] - mean; qv += d * d; }
            const float rstd = 1.0f / sqrtf(wave_sum(qv) * (1.0f / 512.0f) + EPS);
            if (lane == 0) { st[s] = mean; st[128 + s] = rstd; } }
        __syncthreads();
        for (int g = 0; g < 4; ++g) {
            { const int s = 64 * (w & 1) + lane, cq = w >> 1; const float mean = st[s], rstd = st[128 + s];
#pragma unroll
              for (int j = 0; j < 4; ++j) { const int c0 = (4 * cq + j) * 8; float f[8]; unpack8(*(const GAS v4u*)(UV + (row0 + s) * 1024 + 512 + g * 128 + c0), f);
#pragma unroll
                  for (int e = 0; e < 8; ++e) { const float vn = (f[e] - mean) * rstd * gam[g * 128 + c0 + e] + bet[g * 128 + c0 + e];
                      *(lds_u16*)(VT + ((c0 + e) * PITCH + s) * 2) = (unsigned short)f2bf(vn); } } }
            __syncthreads();
            { pg8::f32x4 acc[8];
#pragma unroll
              for (int ct = 0; ct < 8; ++ct) acc[ct] = (pg8::f32x4){0.f, 0.f, 0.f, 0.f};
              const int t = 16 * w + fr; const bf16* wrow = WC + ((size_t)g * 128 + t) * 128 + 8 * fq;
              for (int ks = 0; ks <= (w >> 1); ++ks) {
                  const bf16x8 bfr = *(const bf16x8*)(wrow + 32 * ks);
#pragma unroll
                  for (int ct = 0; ct < 8; ++ct) { const bf16x8 afr = *(const LAS bf16x8*)(VT + ((16 * ct + fr) * PITCH + 32 * ks + 8 * fq) * 2);
                      acc[ct] = __builtin_amdgcn_mfma_f32_16x16x32_bf16(afr, bfr, acc[ct], 0, 0, 0); } }
              const float bias = sb[g * 128 + t]; const size_t ro = (row0 + t) * 1024 + g * 128 + 4 * fq;
#pragma unroll
              for (int ct = 0; ct < 8; ++ct) { const unsigned long long uu = *(const GAS unsigned long long*)(UV + ro + 16 * ct);
                  const float u0 = __builtin_bit_cast(float, (unsigned)(uu << 16)), u1 = __builtin_bit_cast(float, (unsigned)uu & 0xffff0000u), u2 = __builtin_bit_cast(float, (unsigned)(uu >> 32) << 16), u3 = __builtin_bit_cast(float, (unsigned)(uu >> 32) & 0xffff0000u);
                  const unsigned long long o = (unsigned long long)pk2(u0 * (acc[ct][0] + bias), u1 * (acc[ct][1] + bias)) | ((unsigned long long)pk2(u2 * (acc[ct][2] + bias), u3 * (acc[ct][3] + bias)) << 32);
                  *(GAS unsigned long long*)(MX + ro + 16 * ct) = o; } }
            __syncthreads();
        }
    }
}

__device__ __forceinline__ void p7_sgu(Frame& F) {
    LAS float* st = (LAS float*)(F.lds + RING_OFF); LAS float* VN = st + 256;
    const bf16* UV = (const bf16*)(F.ws + WS_BIG); bf16* MX = (bf16*)(F.ws + WS_MIX);
    const float* gam = F.in[10]; const float* bet = F.in[11]; const float* sw = F.in[12]; const float* sb = F.in[13];
    for (int u = F.vcu; u < 256; u += F.G) {
        const size_t row0 = (size_t)(u >> 4) * SEQ + (size_t)(u & 15) * 128;
        __syncthreads();
        for (int i = 0; i < 16; ++i) { const int s = 16 * F.wave + i; float f[8]; unpack8(*(const GAS v4u*)(UV + (row0 + s) * 1024 + 512 + F.lane * 8), f);
            float a = 0.f;
#pragma unroll
            for (int e = 0; e < 8; ++e) a += f[e];
            const float mean = wave_sum(a) * (1.0f / 512.0f); float qv = 0.f;
#pragma unroll
            for (int e = 0; e < 8; ++e) { const float d = f[e] - mean; qv += d * d; }
            const float rstd = 1.0f / sqrtf(wave_sum(qv) * (1.0f / 512.0f) + EPS);
            if (F.lane == 0) { st[s] = mean; st[128 + s] = rstd; } }
        __syncthreads();
        for (int g = 0; g < 4; ++g) {
            { const int s = F.tid >> 2, cq = F.tid & 3; const float mean = st[s], rstd = st[128 + s];
#pragma unroll
              for (int j = 0; j < 4; ++j) { const int c = cq * 32 + j * 8; float f[8]; unpack8(*(const GAS v4u*)(UV + (row0 + s) * 1024 + 512 + g * 128 + c), f);
#pragma unroll
                  for (int e = 0; e < 8; ++e) VN[s * 128 + c + e] = (f[e] - mean) * rstd * gam[g * 128 + c + e] + bet[g * 128 + c + e]; } }
            __syncthreads();
            { const int c = F.tid & 127, tq = F.tid >> 7;
              for (int i = 0; i < 32; ++i) { const int t = tq * 32 + i; const float* wr = sw + ((size_t)g * 128 + t) * 128; float a = 0.f;
                  for (int s = 0; s <= t; ++s) a += wr[s] * VN[s * 128 + c];
                  const float uu = bf2f(UV[(row0 + t) * 1024 + g * 128 + c]);
                  MX[(row0 + t) * DM + g * 128 + c] = (bf16)f2bf(uu * (a + sb[g * 128 + t])); } }
            __syncthreads();
        }
    }
}
__device__ __forceinline__ void p11_final(Frame& F) {
    const int gw = F.vcu * NWAVES + F.wave, NGW = F.G * NWAVES; const bf16* HB = (const bf16*)(F.ws + WS_XN); const float* gf = F.in[17];
    f32x4 g[4];
#pragma unroll
    for (int j = 0; j < 4; ++j) g[j] = *(const GAS f32x4*)(gf + (j >> 1) * 512 + F.lane * 8 + (j & 1) * 4);
    for (int m0 = gw * 2; m0 < M; m0 += NGW * 2) {
        v4u r[2][2];
#pragma unroll
        for (int i = 0; i < 2; ++i) { r[i][0] = *(const GAS v4u*)(HB + (size_t)(m0 + i) * DM + F.lane * 8); r[i][1] = *(const GAS v4u*)(HB + (size_t)(m0 + i) * DM + 512 + F.lane * 8); }
#pragma unroll
        for (int i = 0; i < 2; ++i) { float f[16]; unpack8(r[i][0], f); unpack8(r[i][1], f + 8); float s = 0.f;
#pragma unroll
            for (int e = 0; e < 16; ++e) s += f[e] * f[e];
            const float rstd = 1.0f / sqrtf(wave_sum(s) * (1.f / DM) + EPS); float* op = F.out + (size_t)(m0 + i) * DM + F.lane * 8;
#pragma unroll
            for (int j = 0; j < 4; ++j) *(GAS f32x4*)(op + (j >> 1) * 512 + (j & 1) * 4) = (f32x4){f[4 * j] * rstd * g[j].x, f[4 * j + 1] * rstd * g[j].y, f[4 * j + 2] * rstd * g[j].z, f[4 * j + 3] * rstd * g[j].w}; } }
}

struct Args { const float* in[18]; float* out; unsigned char* ws; int ph_lo, ph_hi, li, pad; };
__global__ void __launch_bounds__(NWAVES * 64, 2) trunk_fwd(Args args) {
    extern __shared__ __attribute__((aligned(16))) unsigned char lds[];
    Frame F;
    F.lds = (LAS unsigned char*)lds;
    F.MISC = (volatile LAS unsigned*)(F.lds + MISC_OFF);
    F.tid = threadIdx.x; F.lane = F.tid & 63; F.wave = __builtin_amdgcn_readfirstlane(F.tid >> 6);
    F.G = gridDim.x; { const int bx = blockIdx.x; F.vcu = (F.G % 8 == 0) ? (bx % 8) * (F.G / 8) + bx / 8 : bx; }
#pragma unroll
    for (int i = 0; i < 18; ++i) F.in[i] = args.in[i];
    F.out = args.out; F.ws = args.ws; F.ctl = (gu32*)(args.ws + WS_CTL);
    for (int u = F.tid; u < (LDS_BYTES - LDSCTL_OFF) / 4; u += NWAVES * 64) ((LAS unsigned*)(F.lds + LDSCTL_OFF))[u] = 0u;
    __syncthreads();
    XcdBarrier bar = xcd_barrier_post((unsigned*)(F.ctl + CW_BAR) + args.li * XCD_BAR_WORDS, F.MISC + 8);
    const int lo = args.ph_lo, hi = args.ph_hi;
#define IN(k) (lo <= (k) && (k) < hi)
#define SEAM(k) do { if (IN(k) && IN((k) + 1)) xcd_barrier(bar); } while (0)
    bf16* XN = (bf16*)(F.ws + WS_XN); bf16* MIX = (bf16*)(F.ws + WS_MIX); bf16* BIG = (bf16*)(F.ws + WS_BIG); bf16* QKV = (bf16*)(F.ws + WS_QKV); float* SS = (float*)(F.ws + WS_SS);
    if (IN(0)) { p0_prologue(F); SEAM(0); }
    if (IN(1)) { pg8::Gemm g{XN, (const bf16*)(F.ws + WS_WABIN), M, AB_IN, DM}; pg8::StaticOrder S; S.init(M, AB_IN, F.G, (int)blockIdx.x);
        pg8::EpiStore E{BIG, AB_IN};
        pg8::gemm_phase<pg8::EpiStore, pg8::StaticOrder, true, true>(F.lds + RING_OFF, g, S, E); SEAM(1); }
    if (IN(2)) { p2_mixer_ab(F); SEAM(2); }
    if (IN(3)) { pg8::Gemm g{MIX, (const bf16*)(F.ws + WS_WABOUT), M, DM, DM}; pg8::StaticOrder S; S.init(M, DM, F.G, (int)blockIdx.x);
        pg8::EpiResid<true, true> E{F.in[0], XN, SS};
        pg8::gemm_phase<pg8::EpiResid<true, true>, pg8::StaticOrder, true, true>(F.lds + RING_OFF, g, S, E); SEAM(3); }
    if (IN(4)) { pg8::Gemm g{XN, (const bf16*)(F.ws + WS_W1), M, FF, DM}; pg8::StaticOrder S; S.init(M, FF, F.G, (int)blockIdx.x);
        pg8::EpiUp E{BIG, SS};
        pg8::gemm_phase<pg8::EpiUp, pg8::StaticOrder, true, true>(F.lds + RING_OFF, g, S, E); SEAM(4); }
    if (IN(5)) { pg8::Gemm g{BIG, (const bf16*)(F.ws + WS_W2), M, DM, FF}; pg8::StaticOrder S; S.init(M, DM, F.G, (int)blockIdx.x);
        pg8::EpiResid<false, true> E{nullptr, XN, SS + M};
        pg8::gemm_phase<pg8::EpiResid<false, true>, pg8::StaticOrder, true, true>(F.lds + RING_OFF, g, S, E); SEAM(5); }
    if (IN(6)) { pg8::Gemm g{XN, (const bf16*)(F.ws + WS_WCDIN), M, CD_IN, DM}; pg8::StaticOrder S; S.init(M, CD_IN, F.G, (int)blockIdx.x);
        pg8::EpiCdIn E{BIG, QKV, SS + M, QSCALE};
        pg8::gemm_phase<pg8::EpiCdIn, pg8::StaticOrder, true, true>(F.lds + RING_OFF, g, S, E); SEAM(6); }
    if (IN(7)) { p7_attention_mfma(F); p7_sgu_mfma(F); SEAM(7); }
    if (IN(8)) { pg8::Gemm g{MIX, (const bf16*)(F.ws + WS_WCDOUT), M, DM, DM}; pg8::StaticOrder S; S.init(M, DM, F.G, (int)blockIdx.x);
        pg8::EpiResid<false, true> E{nullptr, XN, SS + 2 * M};
        pg8::gemm_phase<pg8::EpiResid<false, true>, pg8::StaticOrder, true, true>(F.lds + RING_OFF, g, S, E); SEAM(8); }
    if (IN(9)) { pg8::Gemm g{XN, (const bf16*)(F.ws + WS_W1 + 8 * MiB), M, FF, DM}; pg8::StaticOrder S; S.init(M, FF, F.G, (int)blockIdx.x);
        pg8::EpiUp E{BIG, SS + 2 * M};
        pg8::gemm_phase<pg8::EpiUp, pg8::StaticOrder, true, true>(F.lds + RING_OFF, g, S, E); SEAM(9); }
    if (IN(10)) { pg8::Gemm g{BIG, (const bf16*)(F.ws + WS_W2 + 8 * MiB), M, DM, FF}; pg8::StaticOrder S; S.init(M, DM, F.G, (int)blockIdx.x);
        pg8::EpiResid<false, false> E{nullptr, XN, SS};
        pg8::gemm_phase<pg8::EpiResid<false, false>, pg8::StaticOrder, true, true>(F.lds + RING_OFF, g, S, E); SEAM(10); }
    if (IN(11)) { p11_final(F); }
#undef IN
#undef SEAM
}

extern "C" void kernel_launch(void* const* d_in, const int* in_sizes, int n_in, void* d_out, int out_size, void* d_ws, size_t ws_size, hipStream_t stream) {
    static int grid = 0;
    if (grid == 0) {
        if (n_in != 18 || in_sizes[0] != M * DM || out_size != M * DM || ws_size < WS_END) { fprintf(stderr, "kernel_launch: unexpected shapes (n_in %d in0 %d out %d ws %zu); nothing launched\n", n_in, n_in > 0 ? in_sizes[0] : -1, out_size, ws_size); grid = -1; return; }
        int dev = 0, cus = 0, per_cu = 0;
        if (hipGetDevice(&dev) != hipSuccess || hipDeviceGetAttribute(&cus, hipDeviceAttributeMultiprocessorCount, dev) != hipSuccess) { grid = -1; return; }
        if (hipFuncSetAttribute((const void*)trunk_fwd, hipFuncAttributeMaxDynamicSharedMemorySize, LDS_BYTES) != hipSuccess) { fprintf(stderr, "kernel_launch: hipFuncSetAttribute failed\n"); grid = -1; return; }
        if (hipOccupancyMaxActiveBlocksPerMultiprocessor(&per_cu, (const void*)trunk_fwd, NWAVES * 64, LDS_BYTES) != hipSuccess || per_cu < 1) { fprintf(stderr, "kernel_launch: occupancy query reports %d workgroups per CU\n", per_cu); }
        (void)hipGetLastError();
        grid = cus;
    }
    if (grid < 0) return;
    if (hipMemsetAsync((char*)d_ws + WS_CTL, 0, CTL_ZERO_BYTES, stream) != hipSuccess) return;
    Args a{};
    for (int i = 0; i < 18; ++i) a.in[i] = (const float*)d_in[i];
    a.out = (float*)d_out; a.ws = (unsigned char*)d_ws;
#if PROBE_REPEAT >= 0
    const int plan[2][2] = {{0, PROBE_REPEAT + 1}, {PROBE_REPEAT, N_PHASES}}; const int nl = 2;
#else
    const int plan[1][2] = {{0, N_PHASES}}; const int nl = 1;
#endif
    for (int li = 0; li < nl; ++li) {
        a.ph_lo = plan[li][0]; a.ph_hi = plan[li][1]; a.li = li;
        hipLaunchKernelGGL(trunk_fwd, dim3(grid), dim3(NWAVES * 64), LDS_BYTES, stream, a);
    }
}
```
